# Optimizing an MI355X kernel written in HIP

```python
import jax, jax.numpy as jnp
from jax import lax
import numpy as np

D_MODEL = 1024
BATCH = 8
SEQ = 2048
DEPTH = 2

GRID_W = 64
CTX_LEN = 256
EPS = 1e-6

F_GROUPS = 4
F_GROUP_DIM = D_MODEL // 16
F_WIDTH = F_GROUPS * F_GROUP_DIM
M_HEADS = 4
M_HEAD_DIM = 3 * D_MODEL // 32
M_WIDTH = M_HEADS * M_HEAD_DIM
M_CHUNK = 64
K_CONV = 5
A_HEADS = 4
A_NOPE = 64
A_ROPE = 32
A_V = 3 * D_MODEL // 32
A_WIDTH = A_HEADS * A_V
Q_LORA = D_MODEL // 4
KV_LORA = D_MODEL // 8
Q_BLOCK = 128
ROPE_THETA = 10000.0
MLP_HIDDEN = 4 * D_MODEL
IN_WIDTHS = (F_WIDTH, M_WIDTH, M_WIDTH, M_WIDTH, M_WIDTH, 4 * M_HEADS, Q_LORA, KV_LORA, A_ROPE)
IN_WIDTH = F_WIDTH + 4 * M_WIDTH + 4 * M_HEADS + Q_LORA + KV_LORA + A_ROPE
MIX_WIDTH = F_WIDTH + M_WIDTH + A_WIDTH

kernel_name = "hybrid_fourier_mlstm_mla_dit_block"


def rmsnorm(x, g):
    xf = x.astype(jnp.float32)
    y = xf * lax.rsqrt(jnp.mean(xf * xf, axis=-1, keepdims=True) + EPS)
    return (y * g.astype(jnp.float32)).astype(x.dtype)


def modulate(h, shift, scale):
    return h * (1 + scale) + shift


def split_proj(p):
    out, off = [], 0
    for w in IN_WIDTHS:
        out.append(p[..., off:off + w])
        off += w
    return out


def axial_rope(n):
    rows = n // GRID_W
    row = jnp.repeat(jnp.arange(rows, dtype=jnp.float32), GRID_W)
    col = jnp.tile(jnp.arange(GRID_W, dtype=jnp.float32), rows)
    nf = A_ROPE // 4
    freqs = ROPE_THETA ** (-jnp.arange(nf, dtype=jnp.float32) / nf)
    ang = jnp.stack([row[:, None] * freqs, col[:, None] * freqs], axis=1)
    return jnp.cos(ang), jnp.sin(ang)


def apply_rope(x, cos, sin):
    xs = x.reshape(x.shape[:-1] + (2, 2, A_ROPE // 4)).astype(jnp.float32)
    x1, x2 = xs[..., 0, :], xs[..., 1, :]
    out = jnp.stack([x1 * cos - x2 * sin, x1 * sin + x2 * cos], axis=-2)
    return out.reshape(x.shape).astype(x.dtype)


def fourier_mix(u):
    B, N, _ = u.shape
    ug = u.astype(jnp.float32).reshape(B, N, F_GROUPS, F_GROUP_DIM)
    y = jnp.fft.fft2(ug, axes=(1, 3), norm="ortho").real
    return y.reshape(B, N, F_WIDTH).astype(u.dtype)


def dwconv_centred(u, w):
    C = u.shape[-1]
    pad = w.shape[0] // 2
    return lax.conv_general_dilated(u, w[:, None, :].astype(u.dtype), (1,), [(pad, pad)],
                                    dimension_numbers=("NWC", "WIO", "NWC"), feature_group_count=C)


def mlstm_inputs(mq, mk, mv, mg, conv_w, b_g):
    B, N, _ = mq.shape
    qk = jax.nn.silu(dwconv_centred(jnp.concatenate([mq, mk], axis=-1), conv_w))
    heads = lambda a: a.reshape(B, N, M_HEADS, M_HEAD_DIM).transpose(0, 2, 1, 3).astype(jnp.float32)
    q = heads(qk[..., :M_WIDTH]) * (M_HEAD_DIM ** -0.5)
    k = heads(qk[..., M_WIDTH:])
    v = heads(mv)
    g = (mg.astype(jnp.float32) + b_g.astype(jnp.float32)).reshape(B, N, 4, M_HEADS).transpose(2, 0, 3, 1)
    fwd = (q, k, v, g[0], jax.nn.log_sigmoid(g[1]))
    bwd = (q, k, v, g[2], jax.nn.log_sigmoid(g[3]))
    return fwd, bwd


def mlstm_zero_state(B):
    return (jnp.zeros((B, M_HEADS, M_HEAD_DIM, M_HEAD_DIM), jnp.float32),
            jnp.zeros((B, M_HEADS, M_HEAD_DIM), jnp.float32),
            jnp.zeros((B, M_HEADS), jnp.float32))


def mlstm_chunkwise(q, k, v, li, lf, state):
    B, H, N, _ = q.shape
    L = M_CHUNK
    nc = N // L
    to_chunks = lambda a: jnp.moveaxis(a.reshape((B, H, nc, L) + a.shape[3:]), 2, 0)
    tri = jnp.tril(jnp.ones((L, L), dtype=bool))

    def step(carry, inp):
        C, n, m = carry
        qb, kb, vb, ib, fb = inp
        b = jnp.cumsum(fb, axis=-1)
        dmat = jnp.where(tri, b[..., :, None] - b[..., None, :] + ib[..., None, :], -jnp.inf)
        inter = b + m[..., None]
        m_t = jnp.maximum(inter, dmat.max(axis=-1))
        w_intra = jnp.exp(dmat - m_t[..., None])
        w_inter = jnp.exp(inter - m_t)
        s = jnp.einsum("bhtd,bhsd->bhts", qb, kb) * w_intra
        num = jnp.einsum("bhts,bhsv->bhtv", s, vb) + w_inter[..., None] * jnp.einsum("bhtd,bhdv->bhtv", qb, C)
        den = s.sum(axis=-1) + w_inter * jnp.einsum("bhtd,bhd->bht", qb, n)
        h = num / jnp.maximum(jnp.abs(den), jnp.exp(-m_t))[..., None]
        b_last = b[..., -1]
        g = b_last[..., None] - b + ib
        m_new = jnp.maximum(b_last + m, g.max(axis=-1))
        decay = jnp.exp(b_last + m - m_new)
        wk = jnp.exp(g - m_new[..., None])
        C_new = decay[..., None, None] * C + jnp.einsum("bhs,bhsd,bhsv->bhdv", wk, kb, vb)
        n_new = decay[..., None] * n + jnp.einsum("bhs,bhsd->bhd", wk, kb)
        return (C_new, n_new, m_new), h

    state, hc = lax.scan(step, state, tuple(to_chunks(a) for a in (q, k, v, li, lf)))
    h = jnp.moveaxis(hc, 0, 2).reshape(B, H, N, -1)
    return h, state


def mlstm_direction(seq, state, reverse):
    if reverse:
        seq = tuple(jnp.flip(a, axis=2) for a in seq)
    h, state = mlstm_chunkwise(*seq, state)
    if reverse:
        h = jnp.flip(h, axis=2)
    return h, state


def mlstm_output(h_f, h_b, mo, g_m):
    B, H, N, dv = h_f.shape
    h = (h_f + h_b).transpose(0, 2, 1, 3)
    h = h * lax.rsqrt(jnp.mean(h * h, axis=-1, keepdims=True) + EPS)
    h = h.reshape(B, N, M_WIDTH) * g_m.astype(jnp.float32) * jax.nn.sigmoid(mo.astype(jnp.float32))
    return h.astype(mo.dtype)


def mla_queries(cq, g_qn, w_uq, rope):
    B, N, _ = cq.shape
    q = (rmsnorm(cq, g_qn) @ w_uq).reshape(B, N, A_HEADS, A_NOPE + A_ROPE).transpose(0, 2, 1, 3)
    qn, qr = q[..., :A_NOPE], q[..., A_NOPE:]
    if rope is not None:
        qr = apply_rope(qr, *rope)
    return qn, qr


def mla_keys(ckv, kr, g_kvn, w_ukv, rope):
    B, N, _ = ckv.shape
    kv = (rmsnorm(ckv, g_kvn) @ w_ukv).reshape(B, N, A_HEADS, A_NOPE + A_V).transpose(0, 2, 1, 3)
    kn, v = kv[..., :A_NOPE], kv[..., A_NOPE:]
    if rope is not None:
        kr = apply_rope(kr, *rope)
    return kn, kr, v


def softmax_attend(qn, qr, key_sets):
    scale = (A_NOPE + A_ROPE) ** -0.5
    s = jnp.concatenate([jnp.einsum("bhqd,bhkd->bhqk", qn, kn) + jnp.einsum("bhqr,bkr->bhqk", qr, kr)
                         for kn, kr, _ in key_sets], axis=-1)
    p = jax.nn.softmax(s.astype(jnp.float32) * scale, axis=-1)
    out, off = None, 0
    for _, _, v in key_sets:
        nk = v.shape[2]
        o = jnp.einsum("bhqk,bhkd->bhqd", p[..., off:off + nk].astype(v.dtype), v)
        out = o if out is None else out + o
        off += nk
    return out


def blocked_attend(qn, qr, key_sets):
    B, H, N, _ = qn.shape
    nb = N // Q_BLOCK
    blk = lambda a: jnp.moveaxis(a.reshape(B, H, nb, Q_BLOCK, a.shape[-1]), 2, 0)
    out = lax.map(lambda qs: softmax_attend(qs[0], qs[1], key_sets), (blk(qn), blk(qr)))
    return jnp.moveaxis(out, 0, 2).reshape(B, H, N, -1)


def merge_heads(y):
    B, H, N, dv = y.shape
    return y.transpose(0, 2, 1, 3).reshape(B, N, H * dv)


def sqrelu_mlp(h, w_up, w_down):
    return jnp.square(jax.nn.relu(h @ w_up)) @ w_down


def setup_inputs(seed: int = 0) -> dict:
    key = jax.random.key(seed)
    ks = jax.random.split(key, 24)
    nrm = lambda k, shape, s: jax.random.normal(k, shape, jnp.float32) * s
    gain = lambda k, shape: 1.0 + 0.02 * jax.random.normal(k, shape, jnp.float32)
    f_bias = jnp.linspace(3.0, 6.0, M_HEADS, dtype=jnp.float32)
    z = jnp.zeros((M_HEADS,), jnp.float32)
    gate_base = jnp.concatenate([z, f_bias, z, f_bias])
    return {
        "x": nrm(ks[0], (BATCH, SEQ, D_MODEL), 1.0),
        "c": nrm(ks[1], (BATCH, D_MODEL), 1.0),
        "ctx": nrm(ks[2], (BATCH, CTX_LEN, D_MODEL), 1.0),
        "c_ctx": nrm(ks[3], (D_MODEL,), 1.0),
        "w_mod": nrm(ks[4], (DEPTH, D_MODEL, 6 * D_MODEL), 0.5 * D_MODEL ** -0.5),
        "b_mod": nrm(ks[5], (DEPTH, 6 * D_MODEL), 0.01),
        "g_norm1": gain(ks[6], (DEPTH, D_MODEL)),
        "g_norm2": gain(ks[7], (DEPTH, D_MODEL)),
        "w_in": nrm(ks[8], (DEPTH, D_MODEL, IN_WIDTH), D_MODEL ** -0.5),
        "b_gates": gate_base[None, :] + nrm(ks[9], (DEPTH, 4 * M_HEADS), 0.1),
        "conv_qk": nrm(ks[10], (DEPTH, K_CONV, 2 * M_WIDTH), K_CONV ** -0.5),
        "g_mlstm": gain(ks[11], (DEPTH, M_WIDTH)),
        "g_q_norm": gain(ks[12], (DEPTH, Q_LORA)),
        "g_kv_norm": gain(ks[13], (DEPTH, KV_LORA)),
        "w_uq": nrm(ks[14], (DEPTH, Q_LORA, A_HEADS * (A_NOPE + A_ROPE)), Q_LORA ** -0.5),
        "w_ukv": nrm(ks[15], (DEPTH, KV_LORA, A_HEADS * (A_NOPE + A_V)), KV_LORA ** -0.5),
        "w_out": nrm(ks[16], (DEPTH, MIX_WIDTH, D_MODEL), MIX_WIDTH ** -0.5),
        "w_up": nrm(ks[17], (DEPTH, D_MODEL, MLP_HIDDEN), D_MODEL ** -0.5),
        "w_down": nrm(ks[18], (DEPTH, MLP_HIDDEN, D_MODEL), MLP_HIDDEN ** -0.5),
        "g_final": gain(ks[19], (D_MODEL,)),
    }


def reference(x, c, ctx, c_ctx, w_mod, b_mod, g_norm1, g_norm2, w_in, b_gates, conv_qk, g_mlstm,
              g_q_norm, g_kv_norm, w_uq, w_ukv, w_out, w_up, w_down, g_final):
    B, S, _ = x.shape
    rope_lat = axial_rope(S)
    xc = ctx
    for l in range(DEPTH):
        last = l == DEPTH - 1
        mod = (jax.nn.silu(c) @ w_mod[l] + b_mod[l])[:, None, :]
        mod_c = jax.nn.silu(c_ctx) @ w_mod[l] + b_mod[l]
        sh1, sc1, ga1, sh2, sc2, ga2 = jnp.split(mod, 6, axis=-1)
        sh1c, sc1c, ga1c, sh2c, sc2c, ga2c = jnp.split(mod_c, 6, axis=-1)

        h = modulate(rmsnorm(x, g_norm1[l]), sh1, sc1)
        hc = modulate(rmsnorm(xc, g_norm1[l]), sh1c, sc1c)
        pf, mq, mk, mv, mo, mg, cq, ckv, kr = split_proj(h @ w_in[l])
        pfc, mqc, mkc, mvc, moc, mgc, cqc, ckvc, krc = split_proj(hc @ w_in[l])

        y_f = fourier_mix(pf)

        fwd_c, bwd_c = mlstm_inputs(mqc, mkc, mvc, mgc, conv_qk[l], b_gates[l])
        fwd, bwd = mlstm_inputs(mq, mk, mv, mg, conv_qk[l], b_gates[l])
        zero = mlstm_zero_state(B)
        hcf, st_f = mlstm_direction(fwd_c, zero, False)
        hcb, st_b = mlstm_direction(bwd_c, zero, True)
        hf, _ = mlstm_direction(fwd, st_f, False)
        hb, _ = mlstm_direction(bwd, st_b, True)
        y_m = mlstm_output(hf, hb, mo, g_mlstm[l])

        ctx_keys = mla_keys(ckvc, krc, g_kv_norm[l], w_ukv[l], None)
        lat_keys = mla_keys(ckv, kr, g_kv_norm[l], w_ukv[l], rope_lat)
        qn, qr = mla_queries(cq, g_q_norm[l], w_uq[l], rope_lat)
        y_a = merge_heads(blocked_attend(qn, qr, (lat_keys, ctx_keys)))

        x = x + ga1 * (jnp.concatenate([y_f, y_m, y_a], axis=-1) @ w_out[l])
        x = x + ga2 * sqrelu_mlp(modulate(rmsnorm(x, g_norm2[l]), sh2, sc2), w_up[l], w_down[l])

        if not last:
            y_fc = fourier_mix(pfc)
            y_mc = mlstm_output(hcf, hcb, moc, g_mlstm[l])
            qn_c, qr_c = mla_queries(cqc, g_q_norm[l], w_uq[l], None)
            y_ac = merge_heads(softmax_attend(qn_c, qr_c, (ctx_keys,)))
            xc = xc + ga1c * (jnp.concatenate([y_fc, y_mc, y_ac], axis=-1) @ w_out[l])
            xc = xc + ga2c * sqrelu_mlp(modulate(rmsnorm(xc, g_norm2[l]), sh2c, sc2c), w_up[l], w_down[l])

    return rmsnorm(x, g_final)
```

```cpp
#include <hip/hip_runtime.h>
#include <hip/hip_cooperative_groups.h>
#include <cstdio>
namespace cg = cooperative_groups;
namespace pg8 {
#define PG8_LAS __attribute__((address_space(3)))
typedef unsigned short bf16_t;
typedef short bf16x8 __attribute__((ext_vector_type(8)));
typedef float f32x4 __attribute__((ext_vector_type(4)));
typedef unsigned u32x4 __attribute__((ext_vector_type(4)));
constexpr int BM = 256, BK = 64, HALF = 128, HTB = HALF * BK * 2  , STAGE_BYTES = 8 * HTB, NXCD = 8, WGM = 8;

__host__ __device__ __forceinline__ int lds_byte(int r, int c) { const int st = (r >> 4) * 2 + (c >> 5), rr = r & 15, cc = c & 31, ob = rr * 64 + cc * 2; return st * 1024 + (ob ^ (((ob >> 9) & 1) << 5)); }
__host__ __device__ __forceinline__ void stage_rc(int b, int& R, int& C) { const int st = b / 1024, sb = b % 1024, swz = sb ^ (((sb >> 9) & 1) << 5); R = (st >> 1) * 16 + swz / 64; C = (st & 1) * 32 + (swz % 64) / 2; }
__host__ __device__ __forceinline__ int perm32(int rho) { const int n = rho >> 4, i = rho & 15; return 8 * (i >> 2) + 4 * n + (i & 3); }

struct Unit { int pm, pn; };
struct Gemm { const bf16_t* A; const bf16_t* Bt; int M, N, K; };

struct StaticOrder {
    int nM, nN, nwg, G, c;
    __host__ __device__ void init(int M, int N, int G_, int c_) { nM = M / BM; nN = N / BM; nwg = nM * nN; G = G_; c = c_; }
    __host__ __device__ bool next(int i, Unit& u) const {
        const long L = (long)i * G + c; if (L >= nwg) return false;
        int wgid = (int)L; { const int q = nwg / NXCD, r = nwg % NXCD, xcd = wgid % NXCD, off = wgid / NXCD; wgid = (xcd < r ? xcd * (q + 1) : r * (q + 1) + (xcd - r) * q) + off; }
        const int nig = WGM * nN, gid = wgid / nig, fm = gid * WGM, gsz = (nM - fm) < WGM ? (nM - fm) : WGM;
        u.pm = fm + ((wgid % nig) % gsz); u.pn = (wgid % nig) / gsz; return true;
    }
    __device__ __forceinline__ void a_ready(const Unit&) const {}
    __device__ __forceinline__ void done(const Unit&) const {}
};
__device__ __forceinline__ unsigned cvt_pk_bf16(float lo, float hi) { unsigned r; asm volatile("v_cvt_pk_bf16_f32 %0, %1, %2" : "=v"(r) : "v"(lo), "v"(hi)); return r; }
template <class Epi, class Sched, bool STAMP = false>
__device__ __forceinline__ void gemm_phase(PG8_LAS unsigned char* lds, const Gemm g, const Sched& S, const Epi& E, unsigned long long* stamps) {
    int tid_l = threadIdx.x; asm volatile("" : "+v"(tid_l)); const int tid = tid_l, wid = __builtin_amdgcn_readfirstlane(tid >> 6), lane = tid & 63, wr = wid >> 2, wc = wid & 3, fr = lane & 15, fq = lane >> 4;
    const int K = g.K, nt = K / BK;
    int ts_lo = 0, ts_hi = 0, nts = 0; const unsigned long long rt_entry = STAMP ? (unsigned long long)wall_clock64() : 0ull;
#define PG8_STAMP() do { if (STAMP && wid == 0 && nts < 64) { const unsigned long long _c = (unsigned long long)clock64(); \
        ts_lo = (lane == nts) ? (int)(unsigned)_c : ts_lo; ts_hi = (lane == nts) ? (int)(unsigned)(_c >> 32) : ts_hi; ++nts; } } while (0)
    PG8_STAMP();
    unsigned voffA[2], voffB[2];
#pragma unroll
    for (int i = 0; i < 2; ++i) { int R, C; stage_rc(tid * 16 + i * 8192, R, C); const int Rb = Epi::PERM ? ((R & ~31) + perm32(R & 31)) : R;
        voffA[i] = (unsigned)(R * K + C) * 2u; voffB[i] = (unsigned)(Rb * K + C) * 2u; }
    const size_t kstep = (size_t)(BK * 2);
    const size_t hstep = (size_t)HALF * K * 2;
    const size_t tstep = 2 * hstep;
    const unsigned ldsw = (unsigned)wid * 1024u;
    const int aoff = lds_byte(wr * 64 + fr, fq * 8), boff = lds_byte(wc * 32 + fr, fq * 8);
#define PG8_SA(b, h) (((b) * 2 + (h)) * HTB)
#define PG8_SB(b, h) ((4 + (b) * 2 + (h)) * HTB)
#define PG8_STAGE(bufoff, gbase, voff) do { _Pragma("unroll") for (int _i = 0; _i < 2; ++_i) \
        __builtin_amdgcn_global_load_lds((const unsigned*)((const char*)(gbase) + (voff)[_i]), (PG8_LAS unsigned*)(lds + (bufoff) + ldsw + _i * 8192), 16, 0, 0); } while (0)
#define PG8_LDA(dst, b, h) do { _Pragma("unroll") for (int m = 0; m < 4; ++m) _Pragma("unroll") for (int k = 0; k < 2; ++k) dst[m][k] = *(const PG8_LAS bf16x8*)(lds + PG8_SA(b, h) + aoff + m * 2048 + k * 1024); } while (0)
#define PG8_LDB(dst, b, h) do { _Pragma("unroll") for (int n = 0; n < 2; ++n) _Pragma("unroll") for (int k = 0; k < 2; ++k) dst[n][k] = *(const PG8_LAS bf16x8*)(lds + PG8_SB(b, h) + boff + n * 2048 + k * 1024); } while (0)
#define PG8_MMA(ai, bj, At, Bt) do { __builtin_amdgcn_s_setprio(1); _Pragma("unroll") for (int m = 0; m < 4; ++m) _Pragma("unroll") for (int n = 0; n < 2; ++n) _Pragma("unroll") for (int k = 0; k < 2; ++k) \
        acc[ai][bj][m][n] = __builtin_amdgcn_mfma_f32_16x16x32_bf16(Bt[n][k], At[m][k], acc[ai][bj][m][n], 0, 0, 0); __builtin_amdgcn_s_setprio(0); } while (0)
#define PG8_WAIT_V(n) asm volatile("s_waitcnt vmcnt(" #n ")" ::: "memory")
#define PG8_WAIT_L(n) asm volatile("s_waitcnt lgkmcnt(" #n ")" ::: "memory")
#define PG8_BAR __builtin_amdgcn_s_barrier()
#define PG8_SCHED __builtin_amdgcn_sched_barrier(0)
    Unit cur, nxt; int ui = 0;
    if (!S.next(0, cur)) return;
    f32x4 acc[2][2][4][2];
#pragma unroll
    for (int a = 0; a < 2; ++a)
#pragma unroll
        for (int b = 0; b < 2; ++b)
#pragma unroll
            for (int m = 0; m < 4; ++m)
#pragma unroll
                for (int n = 0; n < 2; ++n) acc[a][b][m][n] = (f32x4){0.f, 0.f, 0.f, 0.f};
    bf16x8 At[4][2], B0[2][2], B1[2][2];
    const char* cA = (const char*)g.A + (size_t)cur.pm * tstep; const char* cB = (const char*)g.Bt + (size_t)cur.pn * tstep;
    S.a_ready(cur);
    PG8_STAGE(PG8_SB(0, 0), cB, voffB); PG8_STAGE(PG8_SA(0, 0), cA, voffA); PG8_STAGE(PG8_SB(0, 1), cB + hstep, voffB); PG8_STAGE(PG8_SA(0, 1), cA + hstep, voffA);
    if (wr == 1) PG8_BAR;
    PG8_WAIT_V(4); PG8_BAR;
    PG8_STAGE(PG8_SB(1, 0), cB + kstep, voffB); PG8_STAGE(PG8_SA(1, 0), cA + kstep, voffA); PG8_STAGE(PG8_SB(1, 1), cB + hstep + kstep, voffB);
    PG8_WAIT_V(6); PG8_BAR;
    PG8_STAMP();
    for (;;) {
        const bool has_next = S.next(ui + 1, nxt);
        const char* nA = has_next ? (const char*)g.A + (size_t)nxt.pm * tstep : cA; const char* nB = has_next ? (const char*)g.Bt + (size_t)nxt.pn * tstep : cB;
        for (int t = 0; t < nt; t += 2) {
            const bool last = (t == nt - 2);
            const char* a1 = cA + (size_t)(t + 1) * kstep;
            const char* a2 = last ? nA : cA + (size_t)(t + 2) * kstep; const char* b2 = last ? nB : cB + (size_t)(t + 2) * kstep;
            const char* a3 = a2 + kstep; const char* b3 = b2 + kstep;
            if (last && has_next) S.a_ready(nxt);
            PG8_LDB(B0, 0, 0); PG8_SCHED; PG8_LDA(At, 0, 0); PG8_STAGE(PG8_SA(1, 1), a1 + hstep, voffA);
            PG8_WAIT_L(8); PG8_BAR; PG8_WAIT_L(0); PG8_MMA(0, 0, At, B0); PG8_BAR; PG8_SCHED;
            PG8_LDB(B1, 0, 1); PG8_STAGE(PG8_SB(0, 0), b2, voffB);
            PG8_BAR; PG8_WAIT_L(0); PG8_MMA(0, 1, At, B1); PG8_BAR;
            PG8_LDA(At, 0, 1); PG8_STAGE(PG8_SA(0, 0), a2, voffA);
            PG8_BAR; PG8_WAIT_L(0); PG8_MMA(1, 0, At, B0); PG8_BAR; PG8_SCHED;
            PG8_STAGE(PG8_SB(0, 1), b2 + hstep, voffB);
            PG8_WAIT_V(6); PG8_BAR; PG8_MMA(1, 1, At, B1); PG8_BAR;
            PG8_LDB(B0, 1, 0); PG8_SCHED; PG8_LDA(At, 1, 0); PG8_STAGE(PG8_SA(0, 1), a2 + hstep, voffA);
            PG8_WAIT_L(8); PG8_BAR; PG8_WAIT_L(0); PG8_MMA(0, 0, At, B0); PG8_BAR; PG8_SCHED;
            PG8_LDB(B1, 1, 1); PG8_STAGE(PG8_SB(1, 0), b3, voffB);
            PG8_BAR; PG8_WAIT_L(0); PG8_MMA(0, 1, At, B1); PG8_BAR;
            PG8_LDA(At, 1, 1); PG8_STAGE(PG8_SA(1, 0), a3, voffA);
            PG8_BAR; PG8_WAIT_L(0); PG8_MMA(1, 0, At, B0); PG8_BAR; PG8_SCHED;
            PG8_STAGE(PG8_SB(1, 1), b3 + hstep, voffB);
            PG8_WAIT_V(6); PG8_BAR; PG8_MMA(1, 1, At, B1); PG8_BAR;
        }
        PG8_STAMP();
        if constexpr (!Epi::AFTER_DRAIN) { E(acc, cur, wr, wc, fr, fq); S.done(cur); }
        PG8_STAMP();
        if (!has_next) break;
#pragma unroll
        for (int a = 0; a < 2; ++a)
#pragma unroll
            for (int b = 0; b < 2; ++b)
#pragma unroll
                for (int m = 0; m < 4; ++m)
#pragma unroll
                    for (int n = 0; n < 2; ++n) acc[a][b][m][n] = (f32x4){0.f, 0.f, 0.f, 0.f};
        cur = nxt; cA = nA; cB = nB; ++ui;
    }
    PG8_WAIT_V(0);
    if (wr == 0) PG8_BAR;
    PG8_BAR;
    if constexpr (Epi::AFTER_DRAIN) { E.fused(acc, cur, wr, wc, fr, fq, lds, wid, lane); S.done(cur); }
    PG8_STAMP();
    if (STAMP && wid == 0) { stamps[lane] = lane < nts ? (((unsigned long long)(unsigned)ts_hi << 32) | (unsigned)ts_lo) : 0ull;
        if (lane == 62) stamps[62] = rt_entry; if (lane == 63) stamps[63] = (unsigned long long)wall_clock64(); }
#undef PG8_STAMP
#undef PG8_SA
#undef PG8_SB
#undef PG8_STAGE
#undef PG8_LDA
#undef PG8_LDB
#undef PG8_MMA
#undef PG8_WAIT_V
#undef PG8_WAIT_L
#undef PG8_BAR
#undef PG8_SCHED
}
}

using pg8::bf16_t; using pg8::bf16x8; using pg8::f32x4; using pg8::u32x4;
typedef unsigned u32x2 __attribute__((ext_vector_type(2)));
#define MFMA16(a, b, c) __builtin_amdgcn_mfma_f32_16x16x32_bf16((a), (b), (c), 0, 0, 0)

constexpr int D = 1024, NB = 8, SEQ = 2048, CL = 256, TL = NB * SEQ, TC = NB * CL, TT = TL + TC;
constexpr int NIN = 2560;
constexpr int PW = 2048;
constexpr int C_MQ = 0, C_MK = 384, C_MV = 768, C_MO = 1152, C_CQ = 1552, C_CKV = 1808, C_KR = 1936;
constexpr int KEYS = SEQ + CL;
constexpr int LCH = 128, NCH = 18;
constexpr int VC = 112, STSZ = VC * 96;
constexpr int LDS_BYTES = 147456;
constexpr float EPS = 1e-6f;
#ifndef PHMASK
#define PHMASK 0xFFFF
#endif

constexpr size_t WS_MOD = 0;
constexpr size_t WS_WIN = WS_MOD + 442368;
constexpr size_t WS_WOUT = WS_WIN + 5242880;
constexpr size_t WS_WUP = WS_WOUT + 2097152;
constexpr size_t WS_WDOWN = WS_WUP + 8388608;
constexpr size_t WS_WUQ = WS_WDOWN + 8388608;
constexpr size_t WS_WUKV = WS_WUQ + 196608;
constexpr size_t WS_FDFT = WS_WUKV + 163840;
constexpr size_t WS_FDFTC = WS_FDFT + 16777216;
constexpr size_t WS_XCTX = WS_FDFTC + 262144;
constexpr size_t WS_S0 = WS_XCTX + 8388608;
constexpr size_t WS_HBUF = WS_S0;
constexpr size_t WS_HID = WS_S0 + 37748736;
constexpr size_t WS_MIX = WS_S0;
constexpr size_t WS_PROJ = WS_S0 + 37748736;
constexpr size_t WS_GATES = WS_PROJ + 75497472;
constexpr size_t WS_QB = WS_GATES + 1179648;
constexpr size_t WS_KB = WS_QB + 14155776;
constexpr size_t WS_VT = WS_KB + 14155776;
constexpr size_t WS_DC = WS_VT + 14155776;
constexpr size_t WS_DEC = WS_DC + 24772608;
constexpr size_t WS_ZT = WS_DEC + 8192;
constexpr size_t WS_ZTC = WS_ZT + 16777216;
constexpr size_t WS_CST = WS_ZT;
constexpr size_t WS_END_MIX = WS_CST + 24772608;
constexpr size_t WS_END_MLP = WS_HID + 150994944;
constexpr size_t WS_NEED = WS_END_MIX > WS_END_MLP ? WS_END_MIX : WS_END_MLP;

struct KP { const float* in[20]; float* out; unsigned char* ws; int ph_lo, ph_hi; };
enum { I_X, I_C, I_CTX, I_CCTX, I_WMOD, I_BMOD, I_G1, I_G2, I_WIN, I_BG, I_CONV, I_GM, I_GQN, I_GKVN, I_WUQ, I_WUKV, I_WOUT, I_WUP, I_WDOWN, I_GFIN };

__device__ __forceinline__ int ltid() { int t = threadIdx.x; asm volatile("" : "+v"(t)); return t; }
__device__ __forceinline__ int lbid() { int t = blockIdx.x; asm volatile("" : "+s"(t)); return t; }
__device__ __forceinline__ float bf2f(bf16_t v) { return __uint_as_float(((unsigned)v) << 16); }
__device__ __forceinline__ bf16_t f2bf(float f) { unsigned u = __float_as_uint(f); u += 0x7FFFu + ((u >> 16) & 1u); return (bf16_t)(u >> 16); }
__device__ __forceinline__ unsigned pk2(float lo, float hi) { unsigned r; asm("v_cvt_pk_bf16_f32 %0, %1, %2" : "=v"(r) : "v"(lo), "v"(hi)); return r; }
__device__ __forceinline__ float lo_bf(unsigned u) { return __uint_as_float(u << 16); }
__device__ __forceinline__ float hi_bf(unsigned u) { return __uint_as_float(u & 0xFFFF0000u); }
__device__ __forceinline__ float wave_sum(float v) {
#pragma unroll
    for (int o = 1; o < 64; o <<= 1) v += __shfl_xor(v, o);
    return v;
}
__device__ __forceinline__ float logsig(float f) { return f < 0.f ? f - log1pf(__expf(f)) : -log1pf(__expf(-f)); }
__device__ __forceinline__ float siluf(float v) { return v / (1.f + __expf(-v)); }
__device__ __forceinline__ bf16x8 mk8(u32x2 lo, u32x2 hi) { u32x4 t = {lo.x, lo.y, hi.x, hi.y}; return __builtin_bit_cast(bf16x8, t); }

struct EpiIn {
    static constexpr bool PERM = true, AFTER_DRAIN = false;
    bf16_t* proj; float* gates; bf16_t* zt; bf16_t* ztc;
    __device__ __forceinline__ void operator()(const f32x4 (&acc)[2][2][4][2], const pg8::Unit& u, int wr, int wc, int fr, int fq) const {
        const int row0 = u.pm * 256 + wr * 64 + fr;
        if (u.pn < 2) {
            const bool latu = u.pm < 64;
            unsigned char* zb = latu ? (unsigned char*)zt : (unsigned char*)ztc;
            const unsigned ldzb = latu ? 8192u : 1024u;
            const unsigned cofs = (unsigned)(wc * 32 + 8 * fq) * ldzb;
#pragma unroll
            for (int ai = 0; ai < 2; ++ai)
#pragma unroll
                for (int m = 0; m < 4; ++m) {
                    const int r = row0 + ai * 128 + m * 16;
                    unsigned off;
                    if (latu) { const int b = r >> 11, n = r & 2047; off = (unsigned)((b * 256) * 4096 + u.pn * 2048 + n) * 2u + cofs; }
                    else { const int rc = r - TL, b = rc >> 8, n = rc & 255; off = (unsigned)((b * 256) * 512 + u.pn * 256 + n) * 2u + cofs; }
#pragma unroll
                    for (int bj = 0; bj < 2; ++bj)
#pragma unroll
                        for (int n2 = 0; n2 < 2; ++n2) {
                            const f32x4 v = acc[ai][bj][m][n2];
#pragma unroll
                            for (int j = 0; j < 4; ++j) *(bf16_t*)(zb + (off + (unsigned)(bj * 128 + 4 * n2 + j) * ldzb)) = f2bf(v[j]);
                        }
                    asm volatile("" ::: "memory");
                }
        } else {
            const int colbase = (u.pn - 2) * 256 + wc * 32 + 8 * fq;
            const bool isg = (u.pn == 8) && (wc == 0) && (fq < 2);
#pragma unroll
            for (int ai = 0; ai < 2; ++ai)
#pragma unroll
                for (int m = 0; m < 4; ++m) {
                    const int r = row0 + ai * 128 + m * 16;
                    bf16_t* rowp = proj + (size_t)r * PW + colbase;
#pragma unroll
                    for (int bj = 0; bj < 2; ++bj) {
                        const f32x4 v0 = acc[ai][bj][m][0], v1 = acc[ai][bj][m][1];
                        u32x4 o; o.x = pk2(v0[0], v0[1]); o.y = pk2(v0[2], v0[3]); o.z = pk2(v1[0], v1[1]); o.w = pk2(v1[2], v1[3]);
                        *(u32x4*)(rowp + bj * 128) = o;
                    }
                    if (isg) { float* gp = gates + (size_t)r * 16 + 8 * fq; *(f32x4*)gp = acc[ai][0][m][0]; *(f32x4*)(gp + 4) = acc[ai][0][m][1]; }
                    asm volatile("" ::: "memory");
                }
        }
    }
};
struct EpiRes {
    static constexpr bool PERM = false, AFTER_DRAIN = false;
    const float* xol; const float* xoc; float* xnl; float* xnc; const float* ga;
    __device__ __forceinline__ void operator()(const f32x4 (&acc)[2][2][4][2], const pg8::Unit& u, int wr, int wc, int fr, int fq) const {
        const int row0 = u.pm * 256 + wr * 64 + fr, col0 = u.pn * 256 + wc * 32 + 4 * fq;
#pragma unroll
        for (int ai = 0; ai < 2; ++ai)
#pragma unroll
            for (int m = 0; m < 4; ++m) {
                const int r = row0 + ai * 128 + m * 16;
                const float* xo; float* xn; int b;
                if (r < TL) { xo = xol + (size_t)r * D; xn = xnl + (size_t)r * D; b = r >> 11; } else { xo = xoc + (size_t)(r - TL) * D; xn = xnc + (size_t)(r - TL) * D; b = 8; }
                const float* gp = ga + (size_t)b * 6144;
#pragma unroll
                for (int bj = 0; bj < 2; ++bj)
#pragma unroll
                    for (int n = 0; n < 2; ++n) {
                        const int c = col0 + bj * 128 + n * 16;
                        const f32x4 g = *(const f32x4*)(gp + c), xv = *(const f32x4*)(xo + c);
                        *(f32x4*)(xn + c) = xv + g * acc[ai][bj][m][n];
                    }
            }
    }
};
struct EpiUp {
    static constexpr bool PERM = true, AFTER_DRAIN = false;
    bf16_t* hid;
    __device__ __forceinline__ void operator()(const f32x4 (&acc)[2][2][4][2], const pg8::Unit& u, int wr, int wc, int fr, int fq) const {
        const int row0 = u.pm * 256 + wr * 64 + fr, col0 = u.pn * 256 + wc * 32 + 8 * fq;
#pragma unroll
        for (int ai = 0; ai < 2; ++ai)
#pragma unroll
            for (int m = 0; m < 4; ++m) {
                bf16_t* rowp = hid + (size_t)(row0 + ai * 128 + m * 16) * 4096 + col0;
#pragma unroll
                for (int bj = 0; bj < 2; ++bj) {
                    f32x4 v0 = acc[ai][bj][m][0], v1 = acc[ai][bj][m][1];
#pragma unroll
                    for (int j = 0; j < 4; ++j) { float a = fmaxf(v0[j], 0.f); v0[j] = a * a; float b = fmaxf(v1[j], 0.f); v1[j] = b * b; }
                    u32x4 o; o.x = pk2(v0[0], v0[1]); o.y = pk2(v0[2], v0[3]); o.z = pk2(v1[0], v1[1]); o.w = pk2(v1[2], v1[3]);
                    *(u32x4*)(rowp + bj * 128) = o;
                }
            }
    }
};
struct EpiFou {
    static constexpr bool PERM = true, AFTER_DRAIN = false;
    bf16_t* mix; int rows_per_b; int row_off; float scale;
    __device__ __forceinline__ void operator()(const f32x4 (&acc)[2][2][4][2], const pg8::Unit& u, int wr, int wc, int fr, int fq) const {
        const int row0 = u.pm * 256 + wr * 64 + fr, col0 = wc * 32 + 8 * fq;
        const size_t rb = (size_t)row_off + (size_t)u.pn * rows_per_b;
#pragma unroll
        for (int ai = 0; ai < 2; ++ai)
#pragma unroll
            for (int m = 0; m < 4; ++m) {
                bf16_t* rowp = mix + (rb + row0 + ai * 128 + m * 16) * D + col0;
#pragma unroll
                for (int bj = 0; bj < 2; ++bj) {
                    const f32x4 v0 = acc[ai][bj][m][0] * scale, v1 = acc[ai][bj][m][1] * scale;
                    u32x4 o; o.x = pk2(v0[0], v0[1]); o.y = pk2(v0[2], v0[3]); o.z = pk2(v1[0], v1[1]); o.w = pk2(v1[2], v1[3]);
                    *(u32x4*)(rowp + bj * 128) = o;
                }
            }
    }
};

template <class Epi>
__device__ __forceinline__ void run_gemm(unsigned char* shm, const bf16_t* A, const bf16_t* Bt, int M, int N, int K, int G, int c, const Epi& E) {
    pg8::Gemm g; g.A = A; g.Bt = Bt; g.M = M; g.N = N; g.K = K;
    pg8::StaticOrder S; S.init(M, N, G, c);
    pg8::gemm_phase<Epi, pg8::StaticOrder, false>((PG8_LAS unsigned char*)shm, g, S, E, nullptr);
}

__device__ __forceinline__ void build_costab(float* tab) {
    for (int i = ltid(); i < 2048; i += 512) tab[i] = cospif((float)i * (1.0f / 1024.0f));
    __syncthreads();
}
__device__ __forceinline__ void tr_load(const float* __restrict__ src, int ldn, int nmax, int k0, int nsrc0, float* tile) {
    const int tid = ltid(), r = tid >> 4, c4 = (tid & 15) * 4;
#pragma unroll
    for (int h = 0; h < 2; ++h) {
        const int rr = r + 32 * h, nc = nsrc0 + c4;
        f32x4 v = {0.f, 0.f, 0.f, 0.f};
        if (nc < nmax) v = *(const f32x4*)(src + (size_t)(k0 + rr) * ldn + nc);
        float* t = tile + rr * 65 + c4; t[0] = v[0]; t[1] = v[1]; t[2] = v[2]; t[3] = v[3];
    }
    __syncthreads();
}
__device__ __forceinline__ void tr_tile(const float* __restrict__ src, int ldn, int nmax, int k0, int nsrc0, bf16_t* __restrict__ dst, int ldk, int ndst0, float* tile) {
    tr_load(src, ldn, nmax, k0, nsrc0, tile);
    const int tid = ltid(), n = tid >> 3, kq = tid & 7;
    const float* s = tile + (kq * 8) * 65 + n;
    u32x4 o; o.x = pk2(s[0], s[65]); o.y = pk2(s[130], s[195]); o.z = pk2(s[260], s[325]); o.w = pk2(s[390], s[455]);
    *(u32x4*)(dst + (size_t)(ndst0 + n) * ldk + k0 + kq * 8) = o;
    __syncthreads();
}
__device__ __forceinline__ void fold_tile(const float* __restrict__ win, int k0, int g, bf16_t* __restrict__ dst, float* tile, const float* tab) {
    tr_load(win, 2224, 2224, k0, g * 64, tile);
    const int tid = ltid(), cp = tid >> 3, kq = tid & 7;
    float ac[8], as[8];
#pragma unroll
    for (int i = 0; i < 8; ++i) { ac[i] = 0.f; as[i] = 0.f; }
    for (int c = 0; c < 64; ++c) {
        const int idx = ((c * cp) & 63) * 32;
        const float cs = tab[idx], sn = tab[(idx - 512) & 2047];
#pragma unroll
        for (int i = 0; i < 8; ++i) { const float v = tile[(kq * 8 + i) * 65 + c]; ac[i] += v * cs; as[i] += v * sn; }
    }
    u32x4 o; o.x = pk2(ac[0], ac[1]); o.y = pk2(ac[2], ac[3]); o.z = pk2(ac[4], ac[5]); o.w = pk2(ac[6], ac[7]);
    *(u32x4*)(dst + (size_t)(g * 64 + cp) * 1024 + k0 + kq * 8) = o;
    u32x4 q; q.x = pk2(as[0], as[1]); q.y = pk2(as[2], as[3]); q.z = pk2(as[4], as[5]); q.w = pk2(as[6], as[7]);
    *(u32x4*)(dst + (size_t)(256 + g * 64 + cp) * 1024 + k0 + kq * 8) = q;
    __syncthreads();
}
constexpr int NW_ITEMS = 512 + 64 + 256 + 1024 + 1024 + 24 + 20;
__device__ __forceinline__ void prep_weight_item(const KP& p, int l, int it, float* tile, const float* tab) {
    unsigned char* ws = p.ws;
    if (it < 512) { const int ct = it & 31, kt = it >> 5;
        tr_tile(p.in[I_WIN] + (size_t)l * 1024 * 2224, 2224, 2224, kt * 64, 256 + ct * 64, (bf16_t*)(ws + WS_WIN), 1024, 512 + ct * 64, tile); return; }
    it -= 512;
    if (it < 64) { fold_tile(p.in[I_WIN] + (size_t)l * 1024 * 2224, (it >> 2) * 64, it & 3, (bf16_t*)(ws + WS_WIN), tile, tab); return; }
    it -= 64;
    if (it < 256) { tr_tile(p.in[I_WOUT] + (size_t)l * 1024 * 1024, 1024, 1024, (it >> 4) * 64, (it & 15) * 64, (bf16_t*)(ws + WS_WOUT), 1024, (it & 15) * 64, tile); return; }
    it -= 256;
    if (it < 1024) { tr_tile(p.in[I_WUP] + (size_t)l * 1024 * 4096, 4096, 4096, (it >> 6) * 64, (it & 63) * 64, (bf16_t*)(ws + WS_WUP), 1024, (it & 63) * 64, tile); return; }
    it -= 1024;
    if (it < 1024) { tr_tile(p.in[I_WDOWN] + (size_t)l * 4096 * 1024, 1024, 1024, (it >> 4) * 64, (it & 15) * 64, (bf16_t*)(ws + WS_WDOWN), 4096, (it & 15) * 64, tile); return; }
    it -= 1024;
    if (it < 24) { tr_tile(p.in[I_WUQ] + (size_t)l * 256 * 384, 384, 384, (it / 6) * 64, (it % 6) * 64, (bf16_t*)(ws + WS_WUQ), 256, (it % 6) * 64, tile); return; }
    it -= 24;
    tr_tile(p.in[I_WUKV] + (size_t)l * 128 * 640, 640, 640, (it / 10) * 64, (it % 10) * 64, (bf16_t*)(ws + WS_WUKV), 128, (it % 10) * 64, tile);
}
__device__ __forceinline__ void prep_mod_item(const KP& p, int it, float* sl) {
    const int tid = ltid(), l = it / 96, cgp = it % 96;
    for (int i = tid; i < 9216; i += 512) { const int r = i >> 10, k = i & 1023; const float v = r < 8 ? p.in[I_C][r * 1024 + k] : p.in[I_CCTX][k]; sl[i] = siluf(v); }
    __syncthreads();
    const int jl = tid & 63, ks = tid >> 6;
    float acc[9];
#pragma unroll
    for (int r = 0; r < 9; ++r) acc[r] = 0.f;
    const float* w = p.in[I_WMOD] + (size_t)l * 1024 * 6144 + cgp * 64 + jl;
    for (int k = ks * 128; k < ks * 128 + 128; ++k) {
        const float wv = w[(size_t)k * 6144];
#pragma unroll
        for (int r = 0; r < 9; ++r) acc[r] += sl[r * 1024 + k] * wv;
    }
    float* red = sl + 9216;
#pragma unroll
    for (int r = 0; r < 9; ++r) red[(ks * 9 + r) * 64 + jl] = acc[r];
    __syncthreads();
    for (int o = tid; o < 576; o += 512) { const int r = o >> 6; float s = 0.f;
#pragma unroll
        for (int q = 0; q < 8; ++q) s += red[(q * 9 + r) * 64 + jl];
        ((float*)(p.ws + WS_MOD))[(size_t)(l * 9 + r) * 6144 + cgp * 64 + jl] = s + p.in[I_BMOD][l * 6144 + cgp * 64 + jl]; }
    __syncthreads();
}
__device__ __forceinline__ void prep_dft_row(const KP& p, int rowid, const float* tab) {
    const int tid = ltid();
    if (rowid < 2048) {
        const int k = rowid; unsigned o[4];
#pragma unroll
        for (int i = 0; i < 4; ++i) { float v[2];
#pragma unroll
            for (int e = 0; e < 2; ++e) { const int np = tid * 8 + i * 2 + e, n = np & 2047, j = (k * n) & 2047; v[e] = (np >> 11) ? -tab[(j - 512) & 2047] : tab[j]; }
            o[i] = pk2(v[0], v[1]); }
        u32x4 ov = {o[0], o[1], o[2], o[3]};
        *(u32x4*)((bf16_t*)(p.ws + WS_FDFT) + (size_t)k * 4096 + tid * 8) = ov;
    } else if (tid < 64) {
        const int k = rowid - 2048; unsigned o[4];
#pragma unroll
        for (int i = 0; i < 4; ++i) { float v[2];
#pragma unroll
            for (int e = 0; e < 2; ++e) { const int np = tid * 8 + i * 2 + e, n = np & 255, j = ((k * n) & 255) * 8; v[e] = (np >> 8) ? -tab[(j - 512) & 2047] : tab[j]; }
            o[i] = pk2(v[0], v[1]); }
        u32x4 ov = {o[0], o[1], o[2], o[3]};
        *(u32x4*)((bf16_t*)(p.ws + WS_FDFTC) + (size_t)k * 512 + tid * 8) = ov;
    }
}
__device__ __forceinline__ void step_prep0(const KP& p, unsigned char* shm) {
    float* tab = (float*)shm; float* work = (float*)(shm + 8192);
    build_costab(tab);
    const int NT = 192 + 2304 + NW_ITEMS;
    for (int it = lbid(); it < NT; it += gridDim.x) {
        if (it < 192) prep_mod_item(p, it, work);
        else if (it < 192 + 2304) prep_dft_row(p, it - 192, tab);
        else prep_weight_item(p, 0, it - 192 - 2304, work, tab);
    }
}

__device__ __forceinline__ void norm_rows(const float* xl, const float* xc, int nrows, const float* g, const float* modl, int shoff, int scoff, bf16_t* dst) {
    const int tid = ltid(), lane = tid & 63, gw = lbid() * 8 + (tid >> 6), NW = gridDim.x * 8;
    for (int r = gw; r < nrows; r += NW) {
        const float* xr = r < TL ? xl + (size_t)r * D : xc + (size_t)(r - TL) * D; const int b = r < TL ? (r >> 11) : 8;
        f32x4 v[4]; float ss = 0.f;
#pragma unroll
        for (int j = 0; j < 4; ++j) { v[j] = *(const f32x4*)(xr + lane * 4 + 256 * j); ss += v[j][0] * v[j][0] + v[j][1] * v[j][1] + v[j][2] * v[j][2] + v[j][3] * v[j][3]; }
        ss = wave_sum(ss); const float rstd = rsqrtf(ss * (1.f / D) + EPS);
        const float* mp = modl + (size_t)b * 6144;
#pragma unroll
        for (int j = 0; j < 4; ++j) { const int c = lane * 4 + 256 * j;
            const f32x4 gg = *(const f32x4*)(g + c), sc = *(const f32x4*)(mp + scoff + c), sh = *(const f32x4*)(mp + shoff + c);
            const f32x4 y = v[j] * rstd * gg, hh = y * (sc + 1.f) + sh;
            u32x2 o; o.x = pk2(hh[0], hh[1]); o.y = pk2(hh[2], hh[3]);
            *(u32x2*)(dst + (size_t)r * D + c) = o; }
    }
}
__device__ __forceinline__ void step_final(const KP& p) {
    const int tid = ltid(), lane = tid & 63, gw = lbid() * 8 + (tid >> 6), NW = gridDim.x * 8;
    const float* g = p.in[I_GFIN];
    for (int r = gw; r < TL; r += NW) {
        float* xr = p.out + (size_t)r * D;
        f32x4 v[4]; float ss = 0.f;
#pragma unroll
        for (int j = 0; j < 4; ++j) { v[j] = *(const f32x4*)(xr + lane * 4 + 256 * j); ss += v[j][0] * v[j][0] + v[j][1] * v[j][1] + v[j][2] * v[j][2] + v[j][3] * v[j][3]; }
        ss = wave_sum(ss); const float rstd = rsqrtf(ss * (1.f / D) + EPS);
#pragma unroll
        for (int j = 0; j < 4; ++j) { const int c = lane * 4 + 256 * j; *(f32x4*)(xr + c) = v[j] * rstd * *(const f32x4*)(g + c); }
    }
}

constexpr int ML_GA = 0;
constexpr int ML_CW = 3072;
constexpr int ML_Q = 7168;
constexpr int ML_K = 33792;
constexpr int ML_VT = 60416;
constexpr int ML_RAW = 90880;
__device__ __forceinline__ int ml_rowbase(int b, int jc) { return jc < 2 ? TL + b * CL + jc * LCH : b * SEQ + (jc - 2) * LCH; }

__device__ __forceinline__ void ml_stage(const KP& p, int l, int b, int h, int jc, unsigned char* shm) {
    const int tid = ltid();
    const bf16_t* proj = (const bf16_t*)(p.ws + WS_PROJ);
    const float* gates = (const float*)(p.ws + WS_GATES);
    float* GA = (float*)(shm + ML_GA); float* CW = (float*)(shm + ML_CW);
    bf16_t* vT = (bf16_t*)(shm + ML_VT); bf16_t* RAW = (bf16_t*)(shm + ML_RAW);
    const int rowbase = ml_rowbase(b, jc);
    const int t0 = jc < 2 ? jc * LCH : (jc - 2) * LCH, slen = jc < 2 ? CL : SEQ;
    float i_f = 0.f, i_b = 0.f;
    if (tid < 128) {
        const float* gp = gates + (size_t)(rowbase + tid) * 16; const float* bg = p.in[I_BG] + l * 16;
        i_f = gp[h] + bg[h]; i_b = gp[8 + h] + bg[8 + h];
        GA[4 * 128 + tid] = logsig(gp[4 + h] + bg[4 + h]); GA[5 * 128 + tid] = logsig(gp[12 + h] + bg[12 + h]);
    }
    for (int i = tid; i < 5 * 192; i += 512) { const int k = i / 192, ch = i % 192; CW[i] = p.in[I_CONV][(size_t)l * 5 * 768 + k * 768 + (ch < 96 ? h * 96 + ch : 384 + h * 96 + (ch - 96))]; }
    for (int i = tid; i < 132 * 24; i += 512) { const int rr = i / 24, ck = i % 24, t = t0 - 2 + rr;
        u32x4 v = {0u, 0u, 0u, 0u};
        if (t >= 0 && t < slen) { const int col = ck < 12 ? C_MQ + h * 96 + ck * 8 : C_MK + h * 96 + (ck - 12) * 8; v = *(const u32x4*)(proj + (size_t)(rowbase - 2 + rr) * PW + col); }
        *(u32x4*)(RAW + rr * 192 + ck * 8) = v; }
    for (int i = tid; i < 128 * 12; i += 512) { const int s = i / 12, ck = i % 12;
        const u32x4 v = *(const u32x4*)(proj + (size_t)(rowbase + s) * PW + C_MV + h * 96 + ck * 8);
        bf16_t* d = vT + (ck * 8) * 136 + s;
        d[0] = (bf16_t)(v.x & 0xFFFF); d[136] = (bf16_t)(v.x >> 16); d[2 * 136] = (bf16_t)(v.y & 0xFFFF); d[3 * 136] = (bf16_t)(v.y >> 16);
        d[4 * 136] = (bf16_t)(v.z & 0xFFFF); d[5 * 136] = (bf16_t)(v.z >> 16); d[6 * 136] = (bf16_t)(v.w & 0xFFFF); d[7 * 136] = (bf16_t)(v.w >> 16); }
    for (int i = tid; i < 16 * 128; i += 512) { const int r = i >> 7, s = i & 127; vT[(96 + r) * 136 + s] = r == 0 ? (bf16_t)0x3F80 : (bf16_t)0; }
    __syncthreads();
    if (tid < 128) {
        float bf = 0.f, bb = 0.f;
        for (int r = 0; r < 128; ++r) { const float a = GA[4 * 128 + r], c = GA[5 * 128 + r]; bf += (r <= tid) ? a : 0.f; bb += (r >= tid) ? c : 0.f; }
        GA[0 * 128 + tid] = i_f; GA[1 * 128 + tid] = bf; GA[2 * 128 + tid] = i_b; GA[3 * 128 + tid] = bb;
    }
    __syncthreads();
}

__device__ __forceinline__ void mlstm_a_item(const KP& p, int l, int item, unsigned char* shm) {
    const int tid = ltid(), w = tid >> 6, lane = tid & 63, fr = lane & 15, fq = lane >> 4;
    const int jc = item % NCH, bh = item / NCH, h = bh & 3, b = bh >> 2;
    ml_stage(p, l, b, h, jc, shm);
    float* GA = (float*)(shm + ML_GA); const float* CW = (const float*)(shm + ML_CW);
    bf16_t* kwf = (bf16_t*)(shm + ML_Q); bf16_t* kwb = (bf16_t*)(shm + ML_K);
    const bf16_t* vT = (const bf16_t*)(shm + ML_VT); const bf16_t* RAW = (const bf16_t*)(shm + ML_RAW);
    const float Bf = GA[1 * 128 + 127], Bb = GA[3 * 128 + 0];
    if (tid < 128) { GA[4 * 128 + tid] = __expf(Bf - GA[1 * 128 + tid] + GA[0 * 128 + tid]); GA[5 * 128 + tid] = __expf(Bb - GA[3 * 128 + tid] + GA[2 * 128 + tid]); }
    if (tid == 0) { float* dec = (float*)(p.ws + WS_DEC); dec[(bh * 2 + 0) * NCH + jc] = __expf(Bf); dec[(bh * 2 + 1) * NCH + jc] = __expf(Bb); }
    __syncthreads();
    for (int idx = tid; idx < 128 * 48; idx += 512) { const int s = idx / 48, ch = 96 + 2 * (idx % 48);
        float a0 = 0.f, a1 = 0.f;
#pragma unroll
        for (int i = 0; i < 5; ++i) { const unsigned rv = *(const unsigned*)(RAW + (s + i) * 192 + ch); a0 += lo_bf(rv) * CW[i * 192 + ch]; a1 += hi_bf(rv) * CW[i * 192 + ch + 1]; }
        a0 = siluf(a0); a1 = siluf(a1);
        const float wf = GA[4 * 128 + s], wb = GA[5 * 128 + s]; const int dk = ch - 96;
        kwf[dk * 136 + s] = f2bf(a0 * wf); kwf[(dk + 1) * 136 + s] = f2bf(a1 * wf);
        kwb[dk * 136 + s] = f2bf(a0 * wb); kwb[(dk + 1) * 136 + s] = f2bf(a1 * wb); }
    __syncthreads();
    bf16_t* dC = (bf16_t*)(p.ws + WS_DC);
    for (int tix = w; tix < 84; tix += 8) { const int dir = tix / 42, tt = tix % 42, vt = tt / 6, nt = tt % 6;
        const bf16_t* kw = dir ? kwb : kwf;
        f32x4 acc = {0.f, 0.f, 0.f, 0.f};
#pragma unroll
        for (int ks = 0; ks < 4; ++ks) { const bf16x8 a = *(const bf16x8*)(vT + (16 * vt + fr) * 136 + 32 * ks + 8 * fq), bfr = *(const bf16x8*)(kw + (16 * nt + fr) * 136 + 32 * ks + 8 * fq); acc = MFMA16(a, bfr, acc); }
        bf16_t* o = dC + ((size_t)(bh * 2 + dir) * NCH + jc) * STSZ + (16 * vt + 4 * fq) * 96 + 16 * nt + fr;
        o[0] = f2bf(acc[0]); o[96] = f2bf(acc[1]); o[192] = f2bf(acc[2]); o[288] = f2bf(acc[3]); }
    __syncthreads();
}

__device__ __forceinline__ void mlstm_scan(const KP& p) {
    const bf16_t* dC = (const bf16_t*)(p.ws + WS_DC); bf16_t* Cst = (bf16_t*)(p.ws + WS_CST); const float* dec = (const float*)(p.ws + WS_DEC);
    const int nthr = gridDim.x * 512;
    for (int wi = lbid() * 512 + ltid(); wi < 64 * (STSZ / 8); wi += nthr) {
        const int chain = wi / (STSZ / 8), e = (wi % (STSZ / 8)) * 8, dir = chain & 1;
        float S[8];
#pragma unroll
        for (int i = 0; i < 8; ++i) S[i] = 0.f;
        for (int pz = 0; pz < NCH; ++pz) {
            const int jc = dir == 0 ? pz : (pz < 2 ? 1 - pz : NCH + 1 - pz);
            const size_t off = ((size_t)chain * NCH + jc) * STSZ + e;
            u32x4 o; o.x = pk2(S[0], S[1]); o.y = pk2(S[2], S[3]); o.z = pk2(S[4], S[5]); o.w = pk2(S[6], S[7]);
            *(u32x4*)(Cst + off) = o;
            const u32x4 d = *(const u32x4*)(dC + off); const float dd = dec[chain * NCH + jc];
            S[0] = S[0] * dd + lo_bf(d.x); S[1] = S[1] * dd + hi_bf(d.x); S[2] = S[2] * dd + lo_bf(d.y); S[3] = S[3] * dd + hi_bf(d.y);
            S[4] = S[4] * dd + lo_bf(d.z); S[5] = S[5] * dd + hi_bf(d.z); S[6] = S[6] * dd + lo_bf(d.w); S[7] = S[7] * dd + hi_bf(d.w);
        }
    }
}

__device__ __forceinline__ void mlstm_c_item(const KP& p, int l, int b, int h, int jc, unsigned char* shm) {
    const int tid = ltid(), w = tid >> 6, lane = tid & 63, fr = lane & 15, fq = lane >> 4;
    const int bh = b * 4 + h;
    ml_stage(p, l, b, h, jc, shm);
    const float* GA = (const float*)(shm + ML_GA); const float* CW = (const float*)(shm + ML_CW);
    bf16_t* qL = (bf16_t*)(shm + ML_Q); bf16_t* kL = (bf16_t*)(shm + ML_K);
    const bf16_t* vT = (const bf16_t*)(shm + ML_VT); const bf16_t* RAW = (const bf16_t*)(shm + ML_RAW);
    bf16_t* CsL = (bf16_t*)(shm + ML_RAW);
    const float qscale = 0.10206207261596577f;
    for (int idx = tid; idx < 128 * 96; idx += 512) { const int s = idx / 96, ch = 2 * (idx % 96);
        float a0 = 0.f, a1 = 0.f;
#pragma unroll
        for (int i = 0; i < 5; ++i) { const unsigned rv = *(const unsigned*)(RAW + (s + i) * 192 + ch); a0 += lo_bf(rv) * CW[i * 192 + ch]; a1 += hi_bf(rv) * CW[i * 192 + ch + 1]; }
        a0 = siluf(a0); a1 = siluf(a1);
        if (ch < 96) *(unsigned*)(qL + s * 104 + ch) = pk2(a0 * qscale, a1 * qscale); else *(unsigned*)(kL + s * 104 + (ch - 96)) = pk2(a0, a1); }
    __syncthreads();
    {
        const bf16_t* Cst = (const bf16_t*)(p.ws + WS_CST);
        for (int i = tid; i < 2 * 112 * 12; i += 512) { const int dir = i / 1344, r = (i % 1344) / 12, ck = i % 12;
            *(u32x4*)(CsL + dir * (112 * 104) + r * 104 + ck * 8) = *(const u32x4*)(Cst + ((size_t)(bh * 2 + dir) * NCH + jc) * STSZ + r * 96 + ck * 8); }
    }
    __syncthreads();
    const int t = 16 * w + fr;
    bf16x8 qf[3];
#pragma unroll
    for (int ks = 0; ks < 3; ++ks) qf[ks] = *(const bf16x8*)(qL + t * 104 + 32 * ks + 8 * fq);
    const float bft = GA[128 + t], bbt = GA[3 * 128 + t];
    bf16x8 PF[4], PB[4];
#pragma unroll
    for (int kk = 0; kk < 4; ++kk) {
        unsigned pf[4], pb[4];
#pragma unroll
        for (int hh = 0; hh < 2; ++hh) { const int st = 2 * kk + hh;
            f32x4 sa = {0.f, 0.f, 0.f, 0.f};
#pragma unroll
            for (int ks = 0; ks < 3; ++ks) { const bf16x8 a = *(const bf16x8*)(kL + (16 * st + fr) * 104 + 32 * ks + 8 * fq); sa = MFMA16(a, qf[ks], sa); }
            const int s0 = 16 * st + 4 * fq;
            const f32x4 gif = *(const f32x4*)(GA + s0), gbf = *(const f32x4*)(GA + 128 + s0), gib = *(const f32x4*)(GA + 256 + s0), gbb = *(const f32x4*)(GA + 384 + s0);
            float vf[4], vb[4];
#pragma unroll
            for (int j = 0; j < 4; ++j) { const int s = s0 + j;
                vf[j] = (s <= t) ? sa[j] * __expf(bft - gbf[j] + gif[j]) : 0.f;
                vb[j] = (s >= t) ? sa[j] * __expf(bbt - gbb[j] + gib[j]) : 0.f; }
            pf[2 * hh] = pk2(vf[0], vf[1]); pf[2 * hh + 1] = pk2(vf[2], vf[3]); pb[2 * hh] = pk2(vb[0], vb[1]); pb[2 * hh + 1] = pk2(vb[2], vb[3]); }
        u32x4 tf = {pf[0], pf[1], pf[2], pf[3]}, tb = {pb[0], pb[1], pb[2], pb[3]};
        PF[kk] = __builtin_bit_cast(bf16x8, tf); PB[kk] = __builtin_bit_cast(bf16x8, tb);
    }
    const float ebf = __expf(bft), ebb = __expf(bbt);
    f32x4 nf[7], nb[7];
#pragma unroll
    for (int vt = 0; vt < 7; ++vt) {
        f32x4 af = {0.f, 0.f, 0.f, 0.f}, ab = {0.f, 0.f, 0.f, 0.f};
#pragma unroll
        for (int ks = 0; ks < 3; ++ks) { const bf16x8 cf = *(const bf16x8*)(CsL + (16 * vt + fr) * 104 + 32 * ks + 8 * fq), cb = *(const bf16x8*)(CsL + 112 * 104 + (16 * vt + fr) * 104 + 32 * ks + 8 * fq);
            af = MFMA16(cf, qf[ks], af); ab = MFMA16(cb, qf[ks], ab); }
        af *= ebf; ab *= ebb;
#pragma unroll
        for (int kk = 0; kk < 4; ++kk) { const u32x2 lo = *(const u32x2*)(vT + (16 * vt + fr) * 136 + 32 * kk + 4 * fq), hi = *(const u32x2*)(vT + (16 * vt + fr) * 136 + 32 * kk + 16 + 4 * fq);
            const bf16x8 a = mk8(lo, hi); af = MFMA16(a, PF[kk], af); ab = MFMA16(a, PB[kk], ab); }
        nf[vt] = af; nb[vt] = ab;
    }
    const float denf = __shfl(nf[6][0], fr), denb = __shfl(nb[6][0], fr);
    const float rf = 1.f / fmaxf(fabsf(denf), 1.f), rb = 1.f / fmaxf(fabsf(denb), 1.f);
    float ss = 0.f;
#pragma unroll
    for (int vt = 0; vt < 6; ++vt) { nf[vt] = nf[vt] * rf + nb[vt] * rb; ss += nf[vt][0] * nf[vt][0] + nf[vt][1] * nf[vt][1] + nf[vt][2] * nf[vt][2] + nf[vt][3] * nf[vt][3]; }
    ss += __shfl_xor(ss, 16); ss += __shfl_xor(ss, 32);
    const float rn = rsqrtf(ss * (1.f / 96.f) + EPS);
    const int row = ml_rowbase(b, jc) + t;
    const bf16_t* proj = (const bf16_t*)(p.ws + WS_PROJ); bf16_t* mix = (bf16_t*)(p.ws + WS_MIX);
    const float* gm = p.in[I_GM] + l * 384 + h * 96;
#pragma unroll
    for (int vt = 0; vt < 6; ++vt) { const int vc = 16 * vt + 4 * fq;
        const u32x2 mo = *(const u32x2*)(proj + (size_t)row * PW + C_MO + h * 96 + vc); const f32x4 g = *(const f32x4*)(gm + vc);
        const float m0 = lo_bf(mo.x), m1 = hi_bf(mo.x), m2 = lo_bf(mo.y), m3 = hi_bf(mo.y);
        const float y0 = nf[vt][0] * rn * g[0] / (1.f + __expf(-m0)), y1 = nf[vt][1] * rn * g[1] / (1.f + __expf(-m1));
        const float y2 = nf[vt][2] * rn * g[2] / (1.f + __expf(-m2)), y3 = nf[vt][3] * rn * g[3] / (1.f + __expf(-m3));
        u32x2 o; o.x = pk2(y0, y1); o.y = pk2(y2, y3);
        *(u32x2*)(mix + (size_t)row * D + 256 + h * 96 + vc) = o; }
    __syncthreads();
}

__device__ __forceinline__ void rope_cs(int tpos, int seg, int f, float& cs, float& sn) {
    const float pos = (float)(seg == 0 ? (tpos >> 6) : (tpos & 63));
    const float fr = exp2f(-(float)f * 1.6609640474436813f);
    sincosf(pos * fr, &sn, &cs);
}
__device__ __forceinline__ void qkv_item(const KP& p, int l, int item, unsigned char* shm) {
    const int tid = ltid(), w = tid >> 6, lane = tid & 63, fr = lane & 15, fq = lane >> 4;
    const int r0 = item * 64; const bool lat = r0 < TL;
    const int b = lat ? (r0 >> 11) : ((r0 - TL) >> 8), tl0 = lat ? (r0 & 2047) : ((r0 - TL) & 255), key0 = lat ? tl0 : SEQ + tl0;
    const bf16_t* proj = (const bf16_t*)(p.ws + WS_PROJ);
    bf16_t* aq = (bf16_t*)shm; bf16_t* akv = (bf16_t*)(shm + 64 * 264 * 2);
    {
        const int tk = tid >> 3, sub = tid & 7; const bf16_t* pr = proj + (size_t)(r0 + tk) * PW;
        u32x4 cq[4], ck[2]; float sq = 0.f, sk = 0.f;
#pragma unroll
        for (int i = 0; i < 4; ++i) { cq[i] = *(const u32x4*)(pr + C_CQ + sub * 32 + i * 8);
#pragma unroll
            for (int e = 0; e < 4; ++e) { const float a = lo_bf(cq[i][e]), c = hi_bf(cq[i][e]); sq += a * a + c * c; } }
#pragma unroll
        for (int i = 0; i < 2; ++i) { ck[i] = *(const u32x4*)(pr + C_CKV + sub * 16 + i * 8);
#pragma unroll
            for (int e = 0; e < 4; ++e) { const float a = lo_bf(ck[i][e]), c = hi_bf(ck[i][e]); sk += a * a + c * c; } }
        sq += __shfl_xor(sq, 1); sq += __shfl_xor(sq, 2); sq += __shfl_xor(sq, 4);
        sk += __shfl_xor(sk, 1); sk += __shfl_xor(sk, 2); sk += __shfl_xor(sk, 4);
        const float rq = rsqrtf(sq * (1.f / 256.f) + EPS), rk = rsqrtf(sk * (1.f / 128.f) + EPS);
        const float* gq = p.in[I_GQN] + l * 256 + sub * 32; const float* gk = p.in[I_GKVN] + l * 128 + sub * 16;
#pragma unroll
        for (int i = 0; i < 4; ++i) { u32x4 o;
#pragma unroll
            for (int e = 0; e < 4; ++e) o[e] = pk2(lo_bf(cq[i][e]) * rq * gq[i * 8 + 2 * e], hi_bf(cq[i][e]) * rq * gq[i * 8 + 2 * e + 1]);
            *(u32x4*)(aq + tk * 264 + sub * 32 + i * 8) = o; }
#pragma unroll
        for (int i = 0; i < 2; ++i) { u32x4 o;
#pragma unroll
            for (int e = 0; e < 4; ++e) o[e] = pk2(lo_bf(ck[i][e]) * rk * gk[i * 8 + 2 * e], hi_bf(ck[i][e]) * rk * gk[i * 8 + 2 * e + 1]);
            *(u32x4*)(akv + tk * 136 + sub * 16 + i * 8) = o; }
    }
    bf16_t* Qb = (bf16_t*)(p.ws + WS_QB); bf16_t* Kb = (bf16_t*)(p.ws + WS_KB); bf16_t* Vt = (bf16_t*)(p.ws + WS_VT);
    {
        const int tk = tid >> 3, i0 = (tid & 7) * 4, seg = i0 >> 4, half = (i0 >> 3) & 1, f0 = i0 & 7;
        const bf16_t* pr = proj + (size_t)(r0 + tk) * PW + C_KR;
        const u32x2 me = *(const u32x2*)(pr + i0), pa = *(const u32x2*)(pr + (i0 ^ 8));
        float mv[4] = {lo_bf(me.x), hi_bf(me.x), lo_bf(me.y), hi_bf(me.y)}, pv[4] = {lo_bf(pa.x), hi_bf(pa.x), lo_bf(pa.y), hi_bf(pa.y)}, ov[4];
#pragma unroll
        for (int j = 0; j < 4; ++j) {
            if (lat) { float cs, sn; rope_cs(tl0 + tk, seg, f0 + j, cs, sn); ov[j] = half ? (pv[j] * sn + mv[j] * cs) : (mv[j] * cs - pv[j] * sn); }
            else ov[j] = mv[j]; }
        u32x2 o; o.x = pk2(ov[0], ov[1]); o.y = pk2(ov[2], ov[3]);
#pragma unroll
        for (int hh = 0; hh < 4; ++hh) *(u32x2*)(Kb + ((size_t)(b * 4 + hh) * KEYS + key0 + tk) * 96 + 64 + i0) = o;
    }
    __syncthreads();
    const bf16_t* WuqT = (const bf16_t*)(p.ws + WS_WUQ); const bf16_t* WukvT = (const bf16_t*)(p.ws + WS_WUKV);
    const float qs = 0.10206207261596577f * 1.4426950408889634f;
    for (int ct = w; ct < 24; ct += 8) {
        f32x4 acc[4];
#pragma unroll
        for (int tt = 0; tt < 4; ++tt) acc[tt] = (f32x4){0.f, 0.f, 0.f, 0.f};
#pragma unroll
        for (int ks = 0; ks < 8; ++ks) { const bf16x8 a = *(const bf16x8*)(WuqT + (size_t)(16 * ct + fr) * 256 + 32 * ks + 8 * fq);
#pragma unroll
            for (int tt = 0; tt < 4; ++tt) { const bf16x8 bb = *(const bf16x8*)(aq + (16 * tt + fr) * 264 + 32 * ks + 8 * fq); acc[tt] = MFMA16(a, bb, acc[tt]); } }
        const int hq = ct / 6, dt = ct % 6;
#pragma unroll
        for (int tt = 0; tt < 4; ++tt) { const int tk = 16 * tt + fr; f32x4 v = acc[tt];
            if (dt >= 4 && lat) { const int seg = dt - 4, half = fq >> 1;
#pragma unroll
                for (int j = 0; j < 4; ++j) { const float pa = __shfl_xor(v[j], 32); float cs, sn; rope_cs(tl0 + tk, seg, 4 * (fq & 1) + j, cs, sn);
                    v[j] = half ? (pa * sn + v[j] * cs) : (v[j] * cs - pa * sn); } }
            u32x2 o; o.x = pk2(v[0] * qs, v[1] * qs); o.y = pk2(v[2] * qs, v[3] * qs);
            *(u32x2*)(Qb + ((size_t)(b * 4 + hq) * KEYS + key0 + tk) * 96 + 16 * dt + 4 * fq) = o; }
    }
    for (int ct = w; ct < 40; ct += 8) {
        const int hk = ct / 10, dt = ct % 10;
        f32x4 acc[4];
#pragma unroll
        for (int tt = 0; tt < 4; ++tt) acc[tt] = (f32x4){0.f, 0.f, 0.f, 0.f};
#pragma unroll
        for (int ks = 0; ks < 4; ++ks) { const bf16x8 a = *(const bf16x8*)(WukvT + (size_t)(16 * ct + fr) * 128 + 32 * ks + 8 * fq);
#pragma unroll
            for (int tt = 0; tt < 4; ++tt) { const bf16x8 bb = *(const bf16x8*)(akv + (16 * tt + fr) * 136 + 32 * ks + 8 * fq);
                acc[tt] = dt < 4 ? MFMA16(a, bb, acc[tt]) : MFMA16(bb, a, acc[tt]); } }
#pragma unroll
        for (int tt = 0; tt < 4; ++tt) { const f32x4 v = acc[tt]; u32x2 o; o.x = pk2(v[0], v[1]); o.y = pk2(v[2], v[3]);
            if (dt < 4) *(u32x2*)(Kb + ((size_t)(b * 4 + hk) * KEYS + key0 + 16 * tt + fr) * 96 + 16 * dt + 4 * fq) = o;
            else *(u32x2*)(Vt + ((size_t)(b * 4 + hk) * 96 + 16 * (dt - 4) + fr) * KEYS + key0 + 16 * tt + 4 * fq) = o; }
    }
    __syncthreads();
}

__device__ __forceinline__ void attn_item(const KP& p, int item, unsigned char* shm) {
    const int tid = ltid(), w = tid >> 6, lane = tid & 63, fr = lane & 15, fq = lane >> 4;
    const int qb = item % 9, bh = item / 9, b = bh >> 2, h = bh & 3;
    const int kbeg = qb < 8 ? 0 : SEQ, ntile = qb < 8 ? KEYS / 64 : CL / 64;
    const bf16_t* Qb = (const bf16_t*)(p.ws + WS_QB) + (size_t)bh * KEYS * 96;
    const bf16_t* Kb = (const bf16_t*)(p.ws + WS_KB) + (size_t)bh * KEYS * 96;
    const bf16_t* Vt = (const bf16_t*)(p.ws + WS_VT) + (size_t)bh * 96 * KEYS;
    bf16_t* Kl = (bf16_t*)shm; bf16_t* Vl = (bf16_t*)(shm + 64 * 104 * 2);
    const int q0 = qb * 256 + 32 * w;
    bf16x8 qf[2][3];
#pragma unroll
    for (int qt = 0; qt < 2; ++qt)
#pragma unroll
        for (int ks = 0; ks < 3; ++ks) qf[qt][ks] = *(const bf16x8*)(Qb + (size_t)(q0 + 16 * qt + fr) * 96 + 32 * ks + 8 * fq);
    f32x4 O[6][2];
#pragma unroll
    for (int dt = 0; dt < 6; ++dt) { O[dt][0] = (f32x4){0.f, 0.f, 0.f, 0.f}; O[dt][1] = (f32x4){0.f, 0.f, 0.f, 0.f}; }
    float mrow[2] = {-1e30f, -1e30f}, lrow[2] = {0.f, 0.f};
    u32x4 pre[3];
    auto gload = [&](int kt) {
        const int key0 = kbeg + kt * 64;
#pragma unroll
        for (int i = 0; i < 3; ++i) { const int c = tid + 512 * i;
            if (c < 768) pre[i] = *(const u32x4*)(Kb + (size_t)key0 * 96 + c * 8);
            else { const int cc = c - 768, dv = cc >> 3, part = cc & 7; pre[i] = *(const u32x4*)(Vt + (size_t)dv * KEYS + key0 + part * 8); } }
    };
    auto lstore = [&]() {
#pragma unroll
        for (int i = 0; i < 3; ++i) { const int c = tid + 512 * i;
            if (c < 768) { const int key = c / 12, part = c % 12; *(u32x4*)(Kl + key * 104 + part * 8) = pre[i]; }
            else { const int cc = c - 768, dv = cc >> 3, part = cc & 7; *(u32x4*)(Vl + dv * 72 + part * 8) = pre[i]; } }
    };
    gload(0);
    for (int kt = 0; kt < ntile; ++kt) {
        __syncthreads();
        lstore();
        __syncthreads();
        if (kt + 1 < ntile) gload(kt + 1);
        f32x4 S[4][2];
#pragma unroll
        for (int kk = 0; kk < 4; ++kk) { S[kk][0] = (f32x4){0.f, 0.f, 0.f, 0.f}; S[kk][1] = (f32x4){0.f, 0.f, 0.f, 0.f};
#pragma unroll
            for (int ks = 0; ks < 3; ++ks) { const bf16x8 a = *(const bf16x8*)(Kl + (16 * kk + fr) * 104 + 32 * ks + 8 * fq);
                S[kk][0] = MFMA16(a, qf[0][ks], S[kk][0]); S[kk][1] = MFMA16(a, qf[1][ks], S[kk][1]); } }
        bf16x8 P[2][2];
#pragma unroll
        for (int qt = 0; qt < 2; ++qt) {
            float mx = S[0][qt][0];
#pragma unroll
            for (int kk = 0; kk < 4; ++kk)
#pragma unroll
                for (int j = 0; j < 4; ++j) mx = fmaxf(mx, S[kk][qt][j]);
            mx = fmaxf(mx, __shfl_xor(mx, 16)); mx = fmaxf(mx, __shfl_xor(mx, 32));
            const float mn = fmaxf(mrow[qt], mx), alpha = exp2f(mrow[qt] - mn); mrow[qt] = mn;
            float ps = 0.f; unsigned pk[8];
#pragma unroll
            for (int kk = 0; kk < 4; ++kk) { const float e0 = exp2f(S[kk][qt][0] - mn), e1 = exp2f(S[kk][qt][1] - mn), e2 = exp2f(S[kk][qt][2] - mn), e3 = exp2f(S[kk][qt][3] - mn);
                ps += (e0 + e1) + (e2 + e3); pk[2 * kk] = pk2(e0, e1); pk[2 * kk + 1] = pk2(e2, e3); }
            lrow[qt] = lrow[qt] * alpha + ps;
#pragma unroll
            for (int dt = 0; dt < 6; ++dt) O[dt][qt] *= alpha;
            u32x4 t0 = {pk[0], pk[1], pk[2], pk[3]}, t1 = {pk[4], pk[5], pk[6], pk[7]};
            P[qt][0] = __builtin_bit_cast(bf16x8, t0); P[qt][1] = __builtin_bit_cast(bf16x8, t1);
        }
#pragma unroll
        for (int dt = 0; dt < 6; ++dt)
#pragma unroll
            for (int k2 = 0; k2 < 2; ++k2) { const u32x2 lo = *(const u32x2*)(Vl + (16 * dt + fr) * 72 + 32 * k2 + 4 * fq), hi = *(const u32x2*)(Vl + (16 * dt + fr) * 72 + 32 * k2 + 16 + 4 * fq);
                const bf16x8 a = mk8(lo, hi); O[dt][0] = MFMA16(a, P[0][k2], O[dt][0]); O[dt][1] = MFMA16(a, P[1][k2], O[dt][1]); }
    }
    bf16_t* mix = (bf16_t*)(p.ws + WS_MIX);
#pragma unroll
    for (int qt = 0; qt < 2; ++qt) { float lt = lrow[qt]; lt += __shfl_xor(lt, 16); lt += __shfl_xor(lt, 32); const float inv = 1.f / lt;
        const int q = q0 + 16 * qt + fr; const size_t row = q < SEQ ? (size_t)b * SEQ + q : (size_t)TL + b * CL + (q - SEQ);
#pragma unroll
        for (int dt = 0; dt < 6; ++dt) { const f32x4 v = O[dt][qt] * inv; u32x2 o; o.x = pk2(v[0], v[1]); o.y = pk2(v[2], v[3]);
            *(u32x2*)(mix + row * D + 640 + h * 96 + 16 * dt + 4 * fq) = o; } }
    __syncthreads();
}


#ifdef DIAG
__device__ __forceinline__ float block_max(float v, float* red) {
    const int tid = ltid();
#pragma unroll
    for (int o = 1; o < 64; o <<= 1) v = fmaxf(v, __shfl_xor(v, o));
    __syncthreads(); if ((tid & 63) == 0) red[tid >> 6] = v; __syncthreads();
    float r = red[0];
#pragma unroll
    for (int i = 1; i < 8; ++i) r = fmaxf(r, red[i]);
    __syncthreads(); return r;
}
__device__ __forceinline__ float block_sum(float v, float* red) {
    const int tid = ltid();
    v = wave_sum(v);
    __syncthreads(); if ((tid & 63) == 0) red[tid >> 6] = v; __syncthreads();
    float r = 0.f;
#pragma unroll
    for (int i = 0; i < 8; ++i) r += red[i];
    __syncthreads(); return r;
}
__device__ __forceinline__ float dg_conv(const KP& p, int l, int rbase, int slen, int t, int chg) {
    const bf16_t* proj = (const bf16_t*)(p.ws + WS_PROJ); float a = 0.f;
    for (int i = 0; i < 5; ++i) { const int tt = t - 2 + i; if (tt < 0 || tt >= slen) continue;
        a += bf2f(proj[(size_t)(rbase + tt) * PW + chg]) * p.in[I_CONV][(size_t)l * 5 * 768 + i * 768 + chg]; }
    return siluf(a);
}
__device__ __forceinline__ float diag_mlstm(const KP& p, int l, int b, int h, int tsel, unsigned char* shm) {
    const int tid = ltid();
    float* Ff = (float*)shm; float* Gb = Ff + 2304; float* If = Gb + 2304; float* Ib = If + 2304; float* Wf = Ib + 2304; float* Wb = Wf + 2304; float* qt = Wb + 2304; float* red = qt + 96; float* yr = red + 16;
    const float* gates = (const float*)(p.ws + WS_GATES); const float* bg = p.in[I_BG] + l * 16;
    const bf16_t* proj = (const bf16_t*)(p.ws + WS_PROJ);
    for (int pos = tid; pos < 2304; pos += 512) { const int row = pos < 256 ? TL + b * CL + pos : b * SEQ + (pos - 256); const float* gp = gates + (size_t)row * 16;
        const int pb = pos < 256 ? 2048 + pos : pos - 256;
        If[pos] = gp[h] + bg[h]; Ff[pos] = logsig(gp[4 + h] + bg[4 + h]); Ib[pb] = gp[8 + h] + bg[8 + h]; Gb[pb] = logsig(gp[12 + h] + bg[12 + h]); }
    __syncthreads();
    if (tid == 0) { float a = 0.f; for (int i = 0; i < 2304; ++i) { a += Ff[i]; Ff[i] = a; } a = 0.f; for (int i = 2303; i >= 0; --i) { a += Gb[i]; Gb[i] = a; } }
    if (tid < 96) qt[tid] = dg_conv(p, l, b * SEQ, SEQ, tsel, h * 96 + tid) * 0.10206207261596577f;
    __syncthreads();
    const int tf = 256 + tsel, tb = tsel;
    for (int pos = tid; pos < 2304; pos += 512) { const bool isc = pos < 256; const int rbase = isc ? TL + b * CL : b * SEQ, slen = isc ? CL : SEQ, t = isc ? pos : pos - 256;
        float dot = 0.f; for (int d = 0; d < 96; ++d) dot += qt[d] * dg_conv(p, l, rbase, slen, t, 384 + h * 96 + d);
        const int pb = isc ? 2048 + pos : pos - 256;
        Wf[pos] = pos <= tf ? dot * __expf(Ff[tf] - Ff[pos] + If[pos]) : 0.f;
        Wb[pos] = pb >= tb ? dot * __expf(Gb[tb] - Gb[pb] + Ib[pb]) : 0.f; }
    __syncthreads();
    float hv = 0.f;
    if (tid < 96) { float nf = 0.f, nb = 0.f, df = 0.f, db = 0.f;
        for (int pos = 0; pos < 2304; ++pos) { const int row = pos < 256 ? TL + b * CL + pos : b * SEQ + (pos - 256); const float v = bf2f(proj[(size_t)row * PW + C_MV + h * 96 + tid]);
            nf += Wf[pos] * v; nb += Wb[pos] * v; df += Wf[pos]; db += Wb[pos]; }
        hv = nf / fmaxf(fabsf(df), 1.f) + nb / fmaxf(fabsf(db), 1.f); }
    const float ss = block_sum(tid < 96 ? hv * hv : 0.f, red);
    float diff = 0.f;
    if (tid < 96) { const int row = b * SEQ + tsel; const float mo = bf2f(proj[(size_t)row * PW + C_MO + h * 96 + tid]);
        const float y = hv * rsqrtf(ss * (1.f / 96.f) + EPS) * p.in[I_GM][l * 384 + h * 96 + tid] / (1.f + __expf(-mo));
        const float yf = bf2f(((const bf16_t*)(p.ws + WS_MIX))[(size_t)row * D + 256 + h * 96 + tid]);
        diff = fabsf(y - yf); }
    return block_max(diff, red);
}
__device__ __forceinline__ float diag_attn(const KP& p, int l, int b, int h, int qsel, unsigned char* shm) {
    const int tid = ltid();
    float* sc = (float*)shm; float* qv = sc + 2304; float* red = qv + 96; float* nq = red + 16;
    float* Vs = (float*)(p.ws + WS_HID + 100000000);
    const bf16_t* proj = (const bf16_t*)(p.ws + WS_PROJ);
    const float* wuq = p.in[I_WUQ] + (size_t)l * 256 * 384; const float* wukv = p.in[I_WUKV] + (size_t)l * 128 * 640;
    const int qrow = b * SEQ + qsel;
    { float v = tid < 256 ? bf2f(proj[(size_t)qrow * PW + C_CQ + tid]) : 0.f; const float ss = block_sum(v * v, red);
      if (tid < 256) nq[tid] = v * rsqrtf(ss * (1.f / 256.f) + EPS) * p.in[I_GQN][l * 256 + tid]; }
    __syncthreads();
    if (tid < 96) { float a = 0.f; for (int k = 0; k < 256; ++k) a += nq[k] * wuq[(size_t)k * 384 + h * 96 + tid]; qv[tid] = a; }
    __syncthreads();
    if (tid < 16) {
        const int seg = tid >> 3, f = tid & 7; float cs, sn; rope_cs(qsel, seg, f, cs, sn);
        const float x1 = qv[64 + seg * 16 + f], x2 = qv[64 + seg * 16 + 8 + f]; qv[64 + seg * 16 + f] = x1 * cs - x2 * sn; qv[64 + seg * 16 + 8 + f] = x1 * sn + x2 * cs; }
    __syncthreads();
    for (int key = tid; key < 2304; key += 512) { const bool lat = key < SEQ; const int row = lat ? b * SEQ + key : TL + b * CL + (key - SEQ);
        const bf16_t* pr = proj + (size_t)row * PW;
        float ss = 0.f; for (int k = 0; k < 128; ++k) { const float v = bf2f(pr[C_CKV + k]); ss += v * v; }
        const float rk = rsqrtf(ss * (1.f / 128.f) + EPS);
        float s = 0.f;
        for (int c = 0; c < 160; ++c) { float a = 0.f; for (int k = 0; k < 128; ++k) a += bf2f(pr[C_CKV + k]) * rk * p.in[I_GKVN][l * 128 + k] * wukv[(size_t)k * 640 + h * 160 + c];
            if (c < 64) s += qv[c] * a; else Vs[(size_t)key * 96 + (c - 64)] = a; }
        for (int seg = 0; seg < 2; ++seg) for (int f = 0; f < 8; ++f) { float x1 = bf2f(pr[C_KR + seg * 16 + f]), x2 = bf2f(pr[C_KR + seg * 16 + 8 + f]);
            if (lat) { float cs, sn; rope_cs(key, seg, f, cs, sn); const float o1 = x1 * cs - x2 * sn, o2 = x1 * sn + x2 * cs; x1 = o1; x2 = o2; }
            s += qv[64 + seg * 16 + f] * x1 + qv[64 + seg * 16 + 8 + f] * x2; }
        sc[key] = s * 0.10206207261596577f; }
    __syncthreads();
    float mx = -1e30f; for (int key = tid; key < 2304; key += 512) mx = fmaxf(mx, sc[key]); mx = block_max(mx, red);
    float sm = 0.f; for (int key = tid; key < 2304; key += 512) { const float e = __expf(sc[key] - mx); sc[key] = e; sm += e; } sm = block_sum(sm, red);
    __threadfence(); __syncthreads();
    float diff = 0.f;
    if (tid < 96) { float a = 0.f; for (int key = 0; key < 2304; ++key) a += sc[key] * Vs[(size_t)key * 96 + tid]; a /= sm;
        const float yf = bf2f(((const bf16_t*)(p.ws + WS_MIX))[(size_t)qrow * D + 640 + h * 96 + tid]); diff = fabsf(a - yf); }
    return block_max(diff, red);
}

__device__ __forceinline__ float diag_fourier(const KP& p, int b, int g, unsigned char* shm) {
    const int tid = ltid();
    float* hrow = (float*)shm; float* red = hrow + 1024;
    float* pf = (float*)(p.ws + WS_HID + 100000000);
    const float* mod = (const float*)(p.ws + WS_MOD) + (size_t)b * 6144;
    for (int n = 0; n < 2048; ++n) {
        const float* xr = p.in[I_X] + ((size_t)b * SEQ + n) * D;
        const float x0 = xr[tid], x1 = xr[tid + 512];
        const float ss = block_sum(x0 * x0 + x1 * x1, red); const float rstd = rsqrtf(ss * (1.f / D) + EPS);
        hrow[tid] = x0 * rstd * p.in[I_G1][tid] * (1.f + mod[1024 + tid]) + mod[tid];
        hrow[tid + 512] = x1 * rstd * p.in[I_G1][tid + 512] * (1.f + mod[1024 + tid + 512]) + mod[tid + 512];
        __syncthreads();
        { const int c = tid & 63, ks = tid >> 6; float a = 0.f;
          for (int k = ks * 128; k < ks * 128 + 128; ++k) a += hrow[k] * p.in[I_WIN][(size_t)k * 2224 + g * 64 + c];
          red[16 + ks * 64 + c] = a; }
        __syncthreads();
        if (tid < 64) { float a = 0.f; for (int q = 0; q < 8; ++q) a += red[16 + q * 64 + tid]; pf[n * 64 + tid] = a; }
        __syncthreads();
    }
    __threadfence(); __syncthreads();
    float worst = 0.f;
#pragma unroll 1
    for (int i = 0; i < 6; ++i) { const int k = i == 0 ? 0 : i == 1 ? 1 : i == 2 ? 5 : i == 3 ? 1000 : i == 4 ? 1024 : 2047;
        const int cp = tid & 63, ns = tid >> 6; float a = 0.f;
        for (int n = ns * 256; n < ns * 256 + 256; ++n) for (int c = 0; c < 64; ++c) { const int idx = (k * n + 32 * c * cp) & 2047; a += pf[n * 64 + c] * cospif((float)idx * (1.f / 1024.f)); }
        __syncthreads(); red[16 + ns * 64 + cp] = a; __syncthreads();
        float diff = 0.f;
        if (tid < 64) { float y = 0.f; for (int q = 0; q < 8; ++q) y += red[16 + q * 64 + tid]; y *= 0.00276213586400995f;
            const float yf = bf2f(((const bf16_t*)(p.ws + WS_MIX))[((size_t)b * SEQ + k) * D + g * 64 + tid]); diff = fabsf(y - yf); }
        worst = fmaxf(worst, block_max(diff, red));
    }
    return worst;
}

__device__ __forceinline__ int dg_row(int i) { return i == 0 ? 0 : i == 1 ? 1 : i == 2 ? 255 : i == 3 ? 256 : i == 4 ? 5000 : i == 5 ? 16383 : i == 6 ? 16384 : 18431; }
__device__ __forceinline__ float diag_g2(const KP& p, int i, unsigned char* shm) {
    const int tid = ltid(); float* red = (float*)shm;
    const int r = dg_row(i), b = r < TL ? r >> 11 : 8;
    const bf16_t* mr = (const bf16_t*)(p.ws + WS_MIX) + (size_t)r * D;
    const float* xo = r < TL ? p.in[I_X] + (size_t)r * D : p.in[I_CTX] + (size_t)(r - TL) * D;
    const float* xn = r < TL ? p.out + (size_t)r * D : (const float*)(p.ws + WS_XCTX) + (size_t)(r - TL) * D;
    const float* mod = (const float*)(p.ws + WS_MOD);
    float diff = 0.f;
    for (int c = tid; c < 1024; c += 512) { float a = 0.f; for (int j = 0; j < 1024; ++j) a += bf2f(mr[j]) * p.in[I_WOUT][(size_t)j * 1024 + c];
        diff = fmaxf(diff, fabsf(xo[c] + mod[(size_t)b * 6144 + 2048 + c] * a - xn[c])); }
#ifdef DIAG_MODONLY
    diff = 0.f;
#endif
#ifndef DIAG_G2ONLY
    { const int l = i & 1, j = (37 * tid + 11 * i) % 6144; float a = 0.f;
      for (int k = 0; k < 1024; ++k) { const float cv = b < 8 ? p.in[I_C][b * 1024 + k] : p.in[I_CCTX][k]; a += siluf(cv) * p.in[I_WMOD][(size_t)l * 1024 * 6144 + (size_t)k * 6144 + j]; }
      a += p.in[I_BMOD][l * 6144 + j]; diff = fmaxf(diff, fabsf(a - mod[(size_t)(l * 9 + b) * 6144 + j])); }
#endif
    return block_max(diff, red);
}
__device__ __forceinline__ float diag_g3(const KP& p, int i, unsigned char* shm) {
    const int tid = ltid(); float* red = (float*)shm; float* hr = red + 16;
    const int r = dg_row(i), b = r < TL ? r >> 11 : 8;
    const float* xr = r < TL ? p.out + (size_t)r * D : (const float*)(p.ws + WS_XCTX) + (size_t)(r - TL) * D;
    const float* mod = (const float*)(p.ws + WS_MOD) + (size_t)b * 6144;
    const bf16_t* hb = (const bf16_t*)(p.ws + WS_HBUF) + (size_t)r * D;
    const float x0 = xr[tid], x1 = xr[tid + 512];
    const float ss = block_sum(x0 * x0 + x1 * x1, red); const float rstd = rsqrtf(ss * (1.f / D) + EPS);
    float diff = 0.f;
    { const float h0 = x0 * rstd * p.in[I_G2][tid] * (1.f + mod[4096 + tid]) + mod[3072 + tid], h1 = x1 * rstd * p.in[I_G2][tid + 512] * (1.f + mod[4096 + tid + 512]) + mod[3072 + tid + 512];
      diff = fmaxf(fabsf(h0 - bf2f(hb[tid])), fabsf(h1 - bf2f(hb[tid + 512]))); hr[tid] = bf2f(hb[tid]); hr[tid + 512] = bf2f(hb[tid + 512]); }
    __syncthreads();
    const bf16_t* hid = (const bf16_t*)(p.ws + WS_HID) + (size_t)r * 4096;
    for (int j = tid; j < 4096; j += 512) { float a = 0.f; for (int k = 0; k < 1024; ++k) a += hr[k] * p.in[I_WUP][(size_t)k * 4096 + j];
        a = fmaxf(a, 0.f); a = a * a; diff = fmaxf(diff, fabsf(a - bf2f(hid[j])) / (1.f + fabsf(a))); }
    return block_max(diff, red);
}
#endif

__device__ __attribute__((noinline)) void grid_sync_fn() { cg::this_grid().sync(); }
__global__ __launch_bounds__(512, 2) void mega(KP p) {
    extern __shared__ __attribute__((aligned(16))) unsigned char shm[];
    for (int s = p.ph_lo; s < p.ph_hi; ++s) {
        const int G = gridDim.x, bid = lbid();
        unsigned char* ws = p.ws; asm volatile("" : "+s"(ws));
        float* outp = p.out; asm volatile("" : "+s"(outp));
        if (s == 0) { if (PHMASK & 512) step_prep0(p, shm); }
        else if (s == 19) { if (PHMASK & 1024) step_final(p); }
        else {
            const int l = (s - 1) / 9, ph = (s - 1) % 9; const bool last = l == 1;
            const float* modl = (const float*)(ws + WS_MOD) + (size_t)l * 9 * 6144;
            const float* xl = l == 0 ? p.in[I_X] : outp; const float* xc = l == 0 ? p.in[I_CTX] : (const float*)(ws + WS_XCTX);
            const int Mrows = last ? TL : TT;
            if (ph == 0) {
                if (PHMASK & 1) {
                if (l == 1) { float* tab = (float*)shm; build_costab(tab); for (int it = bid; it < NW_ITEMS; it += G) prep_weight_item(p, 1, it, (float*)(shm + 8192), tab); }
                norm_rows(xl, xc, TT, p.in[I_G1] + l * D, modl, 0, 1024, (bf16_t*)(ws + WS_HBUF)); }
            } else if (ph == 1) {
                if (PHMASK & 2) {
                EpiIn E; E.proj = (bf16_t*)(ws + WS_PROJ); E.gates = (float*)(ws + WS_GATES); E.zt = (bf16_t*)(ws + WS_ZT); E.ztc = (bf16_t*)(ws + WS_ZTC);
                run_gemm(shm, (const bf16_t*)(ws + WS_HBUF), (const bf16_t*)(ws + WS_WIN), TT, NIN, 1024, G, bid, E); }
            } else if (ph == 2) {
                if (PHMASK & 4) {
                const int nF = l == 0 ? 72 : 64;
                if (bid < nF) {
                    if (PHMASK & 2048) {
                    const bool fl = bid < 64;
                    EpiFou E; E.mix = (bf16_t*)(ws + WS_MIX); E.rows_per_b = fl ? SEQ : CL; E.row_off = fl ? 0 : TL; E.scale = fl ? 0.00276213586400995f : 0.0078125f;
                    run_gemm(shm, (const bf16_t*)(ws + (fl ? WS_FDFT : WS_FDFTC)), (const bf16_t*)(ws + (fl ? WS_ZT : WS_ZTC)), fl ? 2048 : 256, 2048, fl ? 4096 : 512, G, fl ? bid : bid - 64, E); }
                } else {
                    const int vb = bid - nF, nb = G - nF;
                    if (PHMASK & 4096) for (int it = vb; it < 32 * NCH; it += nb) mlstm_a_item(p, l, it, shm);
                    if (PHMASK & 8192) for (int it = vb; it < TT / 64; it += nb) qkv_item(p, l, it, shm);
                } }
            } else if (ph == 3) {
                if (PHMASK & 8) {
                mlstm_scan(p);
                for (int it = bid; it < 32 * 9; it += G) { if (last && (it % 9) == 8) continue; attn_item(p, it, shm); } }
            } else if (ph == 4) {
                if (PHMASK & 16) {
                for (int it = bid; it < 32 * NCH; it += G) { const int jc = it % NCH, bh = it / NCH; if (last && jc < 2) continue; mlstm_c_item(p, l, bh >> 2, bh & 3, jc, shm); } }
            } else if (ph == 6) {
                if (PHMASK & 64) norm_rows(outp, (const float*)(ws + WS_XCTX), Mrows, p.in[I_G2] + l * D, modl, 3072, 4096, (bf16_t*)(ws + WS_HBUF));
            } else if (ph == 7) {
                if (PHMASK & 128) {
                EpiUp E; E.hid = (bf16_t*)(ws + WS_HID);
                run_gemm(shm, (const bf16_t*)(ws + WS_HBUF), (const bf16_t*)(ws + WS_WUP), Mrows, 4096, 1024, G, bid, E); }
            } else {
                if (PHMASK & 32) {
                const bool g2 = ph == 5;
                EpiRes E; E.xol = g2 ? xl : outp; E.xoc = g2 ? xc : (const float*)(ws + WS_XCTX); E.xnl = outp; E.xnc = (float*)(ws + WS_XCTX); E.ga = modl + (g2 ? 2048 : 5120);
                run_gemm(shm, (const bf16_t*)(ws + (g2 ? WS_MIX : WS_HID)), (const bf16_t*)(ws + (g2 ? WS_WOUT : WS_WDOWN)), Mrows, 1024, g2 ? 1024 : 4096, G, bid, E); }
            }
        }
        if (s + 1 < p.ph_hi) grid_sync_fn();
    }
#ifdef DIAG
    grid_sync_fn();
    if (blockIdx.x == 0) {
        float worst = 0.f;
#pragma unroll 1
        for (int i = 0; i < 8; ++i) {
            const int tk = i == 0 ? 0 : i == 1 ? 1 : i == 2 ? 127 : i == 3 ? 128 : i == 4 ? 129 : i == 5 ? 1000 : i == 6 ? 2046 : 2047;
#if DIAG == 1
            const float d = diag_mlstm(p, 0, 3, 2, tk, shm);
#elif DIAG == 2
            const float d = diag_attn(p, 0, 3, 2, tk, shm);
#elif DIAG == 3
            const float d = i == 0 ? diag_fourier(p, 3, 2, shm) : 0.f;
#elif DIAG == 4
            const float d = fmaxf(diag_mlstm(p, 1, 5, 1, tk, shm), diag_attn(p, 1, 5, 1, tk, shm));
#elif DIAG == 5
            const float d = diag_g2(p, i, shm);
#else
            const float d = diag_g3(p, i, shm);
#endif
#ifdef DIAG_TOK
            if (i == DIAG_TOK) worst = d;
#else
            worst = fmaxf(worst, d);
#endif
        }
        if (threadIdx.x == 0) p.out[0] = 1e4f * worst;
    }
#endif
}

extern "C" void kernel_launch(void* const* d_in, const int* in_sizes, int n_in, void* d_out, int out_size, void* d_ws, size_t ws_size, hipStream_t stream) {
    static int grid_blocks = 0;
    if (grid_blocks == 0) {
        if (n_in != 20 || ws_size < WS_NEED) { fprintf(stderr, "kernel_launch: unexpected inputs (n_in %d, ws %zu, need %zu)\n", n_in, ws_size, (size_t)WS_NEED); grid_blocks = -1; return; }
        int dev = 0, cus = 0, per_cu = 0;
        hipGetDevice(&dev);
        hipDeviceGetAttribute(&cus, hipDeviceAttributeMultiprocessorCount, dev);
        hipFuncSetAttribute((const void*)mega, hipFuncAttributeMaxDynamicSharedMemorySize, LDS_BYTES);
        hipOccupancyMaxActiveBlocksPerMultiprocessor(&per_cu, (const void*)mega, 512, LDS_BYTES);
        if (per_cu < 1) per_cu = 1;
        grid_blocks = cus * per_cu;
        (void)hipGetLastError();
    }
    if (grid_blocks < 0) return;
    KP p{};
    for (int i = 0; i < 20; ++i) p.in[i] = (const float*)d_in[i];
    p.out = (float*)d_out; p.ws = (unsigned char*)d_ws; p.ph_lo = 0; p.ph_hi = 20;
#ifdef DIAG
    p.ph_hi = DIAG == 4 ? 15 : DIAG == 5 ? 7 : DIAG == 6 ? 9 : 6;
#endif
    void* args[] = {&p};
    hipError_t e = hipLaunchCooperativeKernel((const void*)mega, dim3(grid_blocks), dim3(512), args, LDS_BYTES, stream);
    if (e != hipSuccess) fprintf(stderr, "cooperative launch failed: %s (grid %d)\n", hipGetErrorString(e), grid_blocks);
}
```

```cpp
#include <hip/hip_runtime.h>
#include <hip/hip_cooperative_groups.h>
#include <cstdio>
namespace cg = cooperative_groups;
namespace pg8 {
#define PG8_LAS __attribute__((address_space(3)))
typedef unsigned short bf16_t;
typedef short bf16x8 __attribute__((ext_vector_type(8)));
typedef float f32x4 __attribute__((ext_vector_type(4)));
typedef unsigned u32x4 __attribute__((ext_vector_type(4)));
constexpr int BM = 256, BK = 64, HALF = 128, HTB = HALF * BK * 2  , STAGE_BYTES = 8 * HTB, NXCD = 8, WGM = 8;

__host__ __device__ __forceinline__ int lds_byte(int r, int c) { const int st = (r >> 4) * 2 + (c >> 5), rr = r & 15, cc = c & 31, ob = rr * 64 + cc * 2; return st * 1024 + (ob ^ (((ob >> 9) & 1) << 5)); }
__host__ __device__ __forceinline__ void stage_rc(int b, int& R, int& C) { const int st = b / 1024, sb = b % 1024, swz = sb ^ (((sb >> 9) & 1) << 5); R = (st >> 1) * 16 + swz / 64; C = (st & 1) * 32 + (swz % 64) / 2; }
__host__ __device__ __forceinline__ int perm32(int rho) { const int n = rho >> 4, i = rho & 15; return 8 * (i >> 2) + 4 * n + (i & 3); }

struct Unit { int pm, pn; };
struct Gemm { const bf16_t* A; const bf16_t* Bt; int M, N, K, ld; };

struct StaticOrder {
    int nM, nN, nwg, G, c;
    __host__ __device__ void init(int M, int N, int G_, int c_) { nM = M / BM; nN = N / BM; nwg = nM * nN; G = G_; c = c_; }
    __host__ __device__ bool next(int i, Unit& u) const {
        const long L = (long)i * G + c; if (L >= nwg) return false;
        int wgid = (int)L; { const int q = nwg / NXCD, r = nwg % NXCD, xcd = wgid % NXCD, off = wgid / NXCD; wgid = (xcd < r ? xcd * (q + 1) : r * (q + 1) + (xcd - r) * q) + off; }
        const int nig = WGM * nN, gid = wgid / nig, fm = gid * WGM, gsz = (nM - fm) < WGM ? (nM - fm) : WGM;
        u.pm = fm + ((wgid % nig) % gsz); u.pn = (wgid % nig) / gsz; return true;
    }
    __device__ __forceinline__ void a_ready(const Unit&) const {}
    __device__ __forceinline__ void done(const Unit&) const {}
};
__device__ __forceinline__ unsigned cvt_pk_bf16(float lo, float hi) { unsigned r; asm volatile("v_cvt_pk_bf16_f32 %0, %1, %2" : "=v"(r) : "v"(lo), "v"(hi)); return r; }
template <class Epi, class Sched, bool STAMP = false>
__device__ __forceinline__ void gemm_phase(PG8_LAS unsigned char* lds, const Gemm g, const Sched& S, const Epi& E, unsigned long long* stamps) {
    int tid_l = threadIdx.x; asm volatile("" : "+v"(tid_l)); const int tid = tid_l, wid = __builtin_amdgcn_readfirstlane(tid >> 6), lane = tid & 63, wr = wid >> 2, wc = wid & 3, fr = lane & 15, fq = lane >> 4;
    const int K = g.K, nt = K / BK, LD = g.ld;
    int ts_lo = 0, ts_hi = 0, nts = 0; const unsigned long long rt_entry = STAMP ? (unsigned long long)wall_clock64() : 0ull;
#define PG8_STAMP() do { if (STAMP && wid == 0 && nts < 64) { const unsigned long long _c = (unsigned long long)clock64(); \
        ts_lo = (lane == nts) ? (int)(unsigned)_c : ts_lo; ts_hi = (lane == nts) ? (int)(unsigned)(_c >> 32) : ts_hi; ++nts; } } while (0)
    PG8_STAMP();
    unsigned voffA[2], voffB[2];
#pragma unroll
    for (int i = 0; i < 2; ++i) { int R, C; stage_rc(tid * 16 + i * 8192, R, C); const int Rb = Epi::PERM ? ((R & ~31) + perm32(R & 31)) : R;
        voffA[i] = (unsigned)(R * LD + C) * 2u; voffB[i] = (unsigned)(Rb * LD + C) * 2u; }
    const size_t kstep = (size_t)(BK * 2);
    const size_t hstep = (size_t)HALF * LD * 2;
    const size_t tstep = 2 * hstep;
    const unsigned ldsw = (unsigned)wid * 1024u;
    const int aoff = lds_byte(wr * 64 + fr, fq * 8), boff = lds_byte(wc * 32 + fr, fq * 8);
#define PG8_SA(b, h) (((b) * 2 + (h)) * HTB)
#define PG8_SB(b, h) ((4 + (b) * 2 + (h)) * HTB)
#define PG8_STAGE(bufoff, gbase, voff) do { _Pragma("unroll") for (int _i = 0; _i < 2; ++_i) \
        __builtin_amdgcn_global_load_lds((const unsigned*)((const char*)(gbase) + (voff)[_i]), (PG8_LAS unsigned*)(lds + (bufoff) + ldsw + _i * 8192), 16, 0, 0); } while (0)
#define PG8_LDA(dst, b, h) do { _Pragma("unroll") for (int m = 0; m < 4; ++m) _Pragma("unroll") for (int k = 0; k < 2; ++k) dst[m][k] = *(const PG8_LAS bf16x8*)(lds + PG8_SA(b, h) + aoff + m * 2048 + k * 1024); } while (0)
#define PG8_LDB(dst, b, h) do { _Pragma("unroll") for (int n = 0; n < 2; ++n) _Pragma("unroll") for (int k = 0; k < 2; ++k) dst[n][k] = *(const PG8_LAS bf16x8*)(lds + PG8_SB(b, h) + boff + n * 2048 + k * 1024); } while (0)
#define PG8_MMA(ai, bj, At, Bt) do { __builtin_amdgcn_s_setprio(1); _Pragma("unroll") for (int m = 0; m < 4; ++m) _Pragma("unroll") for (int n = 0; n < 2; ++n) _Pragma("unroll") for (int k = 0; k < 2; ++k) \
        acc[ai][bj][m][n] = __builtin_amdgcn_mfma_f32_16x16x32_bf16(Bt[n][k], At[m][k], acc[ai][bj][m][n], 0, 0, 0); __builtin_amdgcn_s_setprio(0); } while (0)
#define PG8_WAIT_V(n) asm volatile("s_waitcnt vmcnt(" #n ")" ::: "memory")
#define PG8_WAIT_L(n) asm volatile("s_waitcnt lgkmcnt(" #n ")" ::: "memory")
#define PG8_BAR __builtin_amdgcn_s_barrier()
#define PG8_SCHED __builtin_amdgcn_sched_barrier(0)
    Unit cur, nxt; int ui = 0;
    if (!S.next(0, cur)) return;
    f32x4 acc[2][2][4][2];
#pragma unroll
    for (int a = 0; a < 2; ++a)
#pragma unroll
        for (int b = 0; b < 2; ++b)
#pragma unroll
            for (int m = 0; m < 4; ++m)
#pragma unroll
                for (int n = 0; n < 2; ++n) acc[a][b][m][n] = (f32x4){0.f, 0.f, 0.f, 0.f};
    bf16x8 At[4][2], B0[2][2], B1[2][2];
    const char* cA = (const char*)g.A + (size_t)cur.pm * tstep; const char* cB = (const char*)g.Bt + (size_t)cur.pn * tstep;
    S.a_ready(cur);
    PG8_STAGE(PG8_SB(0, 0), cB, voffB); PG8_STAGE(PG8_SA(0, 0), cA, voffA); PG8_STAGE(PG8_SB(0, 1), cB + hstep, voffB); PG8_STAGE(PG8_SA(0, 1), cA + hstep, voffA);
    if (wr == 1) PG8_BAR;
    PG8_WAIT_V(4); PG8_BAR;
    PG8_STAGE(PG8_SB(1, 0), cB + kstep, voffB); PG8_STAGE(PG8_SA(1, 0), cA + kstep, voffA); PG8_STAGE(PG8_SB(1, 1), cB + hstep + kstep, voffB);
    PG8_WAIT_V(6); PG8_BAR;
    PG8_STAMP();
    for (;;) {
        const bool has_next = S.next(ui + 1, nxt);
        const char* nA = has_next ? (const char*)g.A + (size_t)nxt.pm * tstep : cA; const char* nB = has_next ? (const char*)g.Bt + (size_t)nxt.pn * tstep : cB;
        for (int t = 0; t < nt; t += 2) {
            const bool last = (t == nt - 2);
            const char* a1 = cA + (size_t)(t + 1) * kstep;
            const char* a2 = last ? nA : cA + (size_t)(t + 2) * kstep; const char* b2 = last ? nB : cB + (size_t)(t + 2) * kstep;
            const char* a3 = a2 + kstep; const char* b3 = b2 + kstep;
            if (last && has_next) S.a_ready(nxt);
            PG8_LDB(B0, 0, 0); PG8_SCHED; PG8_LDA(At, 0, 0); PG8_STAGE(PG8_SA(1, 1), a1 + hstep, voffA);
            PG8_WAIT_L(8); PG8_BAR; PG8_WAIT_L(0); PG8_MMA(0, 0, At, B0); PG8_BAR; PG8_SCHED;
            PG8_LDB(B1, 0, 1); PG8_STAGE(PG8_SB(0, 0), b2, voffB);
            PG8_BAR; PG8_WAIT_L(0); PG8_MMA(0, 1, At, B1); PG8_BAR;
            PG8_LDA(At, 0, 1); PG8_STAGE(PG8_SA(0, 0), a2, voffA);
            PG8_BAR; PG8_WAIT_L(0); PG8_MMA(1, 0, At, B0); PG8_BAR; PG8_SCHED;
            PG8_STAGE(PG8_SB(0, 1), b2 + hstep, voffB);
            PG8_WAIT_V(6); PG8_BAR; PG8_MMA(1, 1, At, B1); PG8_BAR;
            PG8_LDB(B0, 1, 0); PG8_SCHED; PG8_LDA(At, 1, 0); PG8_STAGE(PG8_SA(0, 1), a2 + hstep, voffA);
            PG8_WAIT_L(8); PG8_BAR; PG8_WAIT_L(0); PG8_MMA(0, 0, At, B0); PG8_BAR; PG8_SCHED;
            PG8_LDB(B1, 1, 1); PG8_STAGE(PG8_SB(1, 0), b3, voffB);
            PG8_BAR; PG8_WAIT_L(0); PG8_MMA(0, 1, At, B1); PG8_BAR;
            PG8_LDA(At, 1, 1); PG8_STAGE(PG8_SA(1, 0), a3, voffA);
            PG8_BAR; PG8_WAIT_L(0); PG8_MMA(1, 0, At, B0); PG8_BAR; PG8_SCHED;
            PG8_STAGE(PG8_SB(1, 1), b3 + hstep, voffB);
            PG8_WAIT_V(6); PG8_BAR; PG8_MMA(1, 1, At, B1); PG8_BAR;
        }
        PG8_STAMP();
        if constexpr (!Epi::AFTER_DRAIN) { E(acc, cur, wr, wc, fr, fq); S.done(cur); }
        PG8_STAMP();
        if (!has_next) break;
#pragma unroll
        for (int a = 0; a < 2; ++a)
#pragma unroll
            for (int b = 0; b < 2; ++b)
#pragma unroll
                for (int m = 0; m < 4; ++m)
#pragma unroll
                    for (int n = 0; n < 2; ++n) acc[a][b][m][n] = (f32x4){0.f, 0.f, 0.f, 0.f};
        cur = nxt; cA = nA; cB = nB; ++ui;
    }
    PG8_WAIT_V(0);
    if (wr == 0) PG8_BAR;
    PG8_BAR;
    if constexpr (Epi::AFTER_DRAIN) { E.fused(acc, cur, wr, wc, fr, fq, lds, wid, lane); S.done(cur); }
    PG8_STAMP();
    if (STAMP && wid == 0) { stamps[lane] = lane < nts ? (((unsigned long long)(unsigned)ts_hi << 32) | (unsigned)ts_lo) : 0ull;
        if (lane == 62) stamps[62] = rt_entry; if (lane == 63) stamps[63] = (unsigned long long)wall_clock64(); }
#undef PG8_STAMP
#undef PG8_SA
#undef PG8_SB
#undef PG8_STAGE
#undef PG8_LDA
#undef PG8_LDB
#undef PG8_MMA
#undef PG8_WAIT_V
#undef PG8_WAIT_L
#undef PG8_BAR
#undef PG8_SCHED
}
}

using pg8::bf16_t; using pg8::bf16x8; using pg8::f32x4; using pg8::u32x4;
typedef unsigned u32x2 __attribute__((ext_vector_type(2)));
#define MFMA16(a, b, c) __builtin_amdgcn_mfma_f32_16x16x32_bf16((a), (b), (c), 0, 0, 0)

constexpr int D = 1024, NB = 8, SEQ = 2048, CL = 256, TL = NB * SEQ, TC = NB * CL, TT = TL + TC;
constexpr int NIN = 2560;
constexpr int PW = 2048;
constexpr int C_MQ = 0, C_MK = 384, C_MV = 768, C_MO = 1152, C_CQ = 1552, C_CKV = 1808, C_KR = 1936;
constexpr int KEYS = SEQ + CL;
constexpr int LCH = 128, NCH = 18;
constexpr int VC = 112, STSZ = VC * 96;
constexpr int LDS_BYTES = 147456;
constexpr float EPS = 1e-6f;
#ifndef ATT_REP
#define ATT_REP 1
#endif
#ifndef REPMASK
#define REPMASK 0
#endif
#ifndef PHMASK
#define PHMASK 0xFFFF
#endif

constexpr size_t WS_MOD = 0;
constexpr size_t WS_WIN = WS_MOD + 442368;
constexpr size_t WS_WOUT = WS_WIN + 5242880;
constexpr size_t WS_WUP = WS_WOUT + 2097152;
constexpr size_t WS_WDOWN = WS_WUP + 8388608;
constexpr size_t WS_WUQ = WS_WDOWN + 8388608;
constexpr size_t WS_WUKV = WS_WUQ + 196608;
constexpr size_t WS_FDFT = WS_WUKV + 163840;
constexpr size_t WS_FDFTC = WS_FDFT + 16777216;
constexpr size_t WS_XCTX = WS_FDFTC + 262144;
constexpr size_t WS_S0 = WS_XCTX + 8388608;
constexpr size_t WS_HBUF = WS_S0;
constexpr size_t WS_HID = WS_S0 + 37748736;
constexpr size_t WS_MIX = WS_S0;
constexpr size_t WS_PROJ = WS_S0 + 37748736;
constexpr size_t WS_GATES = WS_PROJ + 75497472;
constexpr size_t WS_QB = WS_GATES + 1179648;
constexpr size_t WS_KB = WS_QB + 14155776;
constexpr size_t WS_VT = WS_KB + 14155776;
constexpr size_t WS_DC = WS_VT + 14155776;
constexpr size_t WS_DEC = WS_DC + 24772608;
constexpr size_t WS_ZT = WS_DEC + 8192;
constexpr size_t WS_ZTC = WS_ZT + 16777216;
constexpr size_t WS_ZTF = WS_ZTC + 2097152;
constexpr size_t WS_CST = WS_DC;
constexpr size_t WS_END_MIX = WS_ZTF + 8388608;
constexpr size_t WS_END_MLP = WS_HID + 150994944;
constexpr size_t WS_PART = WS_HID + 150994944;
constexpr size_t WS_RSS = 268435456 - 16384 - 262144 - 262144;
constexpr size_t WS_RCNT = WS_RSS - 65536;
constexpr size_t WS_ROPE = 268435456 - 16384 - 262144;
constexpr size_t WS_BAR = 268435456 - 16384;
constexpr size_t WS_NEED = 268435456;
static_assert(WS_END_MIX <= WS_RCNT && WS_PART + 4 * 4194304 <= WS_RCNT, "workspace map");

struct KP { const float* in[20]; float* out; unsigned char* ws; int ph_lo, ph_hi; };
enum { I_X, I_C, I_CTX, I_CCTX, I_WMOD, I_BMOD, I_G1, I_G2, I_WIN, I_BG, I_CONV, I_GM, I_GQN, I_GKVN, I_WUQ, I_WUKV, I_WOUT, I_WUP, I_WDOWN, I_GFIN };

__device__ __forceinline__ int ltid() { int t = threadIdx.x; asm volatile("" : "+v"(t)); return t; }
__device__ __forceinline__ int lbid() { int t = blockIdx.x; asm volatile("" : "+s"(t)); return t; }
__device__ __forceinline__ float bf2f(bf16_t v) { return __uint_as_float(((unsigned)v) << 16); }
__device__ __forceinline__ bf16_t f2bf(float f) { unsigned u = __float_as_uint(f); u += 0x7FFFu + ((u >> 16) & 1u); return (bf16_t)(u >> 16); }
__device__ __forceinline__ unsigned pk2(float lo, float hi) { unsigned r; asm("v_cvt_pk_bf16_f32 %0, %1, %2" : "=v"(r) : "v"(lo), "v"(hi)); return r; }
__device__ __forceinline__ float lo_bf(unsigned u) { return __uint_as_float(u << 16); }
__device__ __forceinline__ float hi_bf(unsigned u) { return __uint_as_float(u & 0xFFFF0000u); }
__device__ __forceinline__ float wave_sum(float v) {
#pragma unroll
    for (int o = 1; o < 64; o <<= 1) v += __shfl_xor(v, o);
    return v;
}
__device__ __forceinline__ float max_over_fq(float x) {
    const unsigned u = __float_as_uint(x);
    const auto r = __builtin_amdgcn_permlane32_swap(u, u, false, false);
    const float m = fmaxf(__uint_as_float(r[0]), __uint_as_float(r[1]));
    const unsigned v = __float_as_uint(m);
    const auto s = __builtin_amdgcn_permlane16_swap(v, v, false, false);
    return fmaxf(__uint_as_float(s[0]), __uint_as_float(s[1]));
}
__device__ __forceinline__ float sum_over_fq(float x) {
    const unsigned u = __float_as_uint(x);
    const auto r = __builtin_amdgcn_permlane32_swap(u, u, false, false);
    const float m = __uint_as_float(r[0]) + __uint_as_float(r[1]);
    const unsigned v = __float_as_uint(m);
    const auto s = __builtin_amdgcn_permlane16_swap(v, v, false, false);
    return __uint_as_float(s[0]) + __uint_as_float(s[1]);
}
__device__ __forceinline__ float logsig(float f) { const float e = __expf(-fabsf(f)); return fminf(f, 0.f) - __logf(1.f + e); }
__device__ __forceinline__ float siluf(float v) { return v / (1.f + __expf(-v)); }
__device__ __forceinline__ bf16x8 mk8(u32x2 lo, u32x2 hi) { u32x4 t = {lo.x, lo.y, hi.x, hi.y}; return __builtin_bit_cast(bf16x8, t); }

struct EpiIn {
    static constexpr bool PERM = true, AFTER_DRAIN = false;
    bf16_t* proj; float* gates; bf16_t* zt; bf16_t* ztc;
    __device__ __forceinline__ void operator()(const f32x4 (&acc)[2][2][4][2], const pg8::Unit& u, int wr, int wc, int fr, int fq) const {
        const int row0 = u.pm * 256 + wr * 64 + fr;
        if (u.pn < 2) {
            const bool latu = u.pm < 64;
            unsigned char* zb = latu ? (unsigned char*)zt : (unsigned char*)ztc;
            const unsigned ldzb = latu ? 8192u : 1024u;
            const unsigned cofs = (unsigned)(wc * 32 + 8 * fq) * ldzb;
#pragma unroll
            for (int ai = 0; ai < 2; ++ai)
#pragma unroll
                for (int m = 0; m < 4; ++m) {
                    const int r = row0 + ai * 128 + m * 16;
                    unsigned off;
                    if (latu) { const int b = r >> 11, n = r & 2047; off = (unsigned)((b * 256) * 4096 + u.pn * 2048 + n) * 2u + cofs; }
                    else { const int rc = r - TL, b = rc >> 8, n = rc & 255; off = (unsigned)((b * 256) * 512 + u.pn * 256 + n) * 2u + cofs; }
#pragma unroll
                    for (int bj = 0; bj < 2; ++bj)
#pragma unroll
                        for (int n2 = 0; n2 < 2; ++n2) {
                            const f32x4 v = acc[ai][bj][m][n2];
#pragma unroll
                            for (int j = 0; j < 4; ++j) *(bf16_t*)(zb + (off + (unsigned)(bj * 128 + 4 * n2 + j) * ldzb)) = f2bf(v[j]);
                        }
                    asm volatile("" ::: "memory");
                }
        } else {
            const int colbase = (u.pn - 2) * 256 + wc * 32 + 8 * fq;
            const bool isg = (u.pn == 8) && (wc == 0) && (fq < 2);
#pragma unroll
            for (int ai = 0; ai < 2; ++ai)
#pragma unroll
                for (int m = 0; m < 4; ++m) {
                    const int r = row0 + ai * 128 + m * 16;
                    bf16_t* rowp = proj + (size_t)r * PW + colbase;
#pragma unroll
                    for (int bj = 0; bj < 2; ++bj) {
                        const f32x4 v0 = acc[ai][bj][m][0], v1 = acc[ai][bj][m][1];
                        u32x4 o; o.x = pk2(v0[0], v0[1]); o.y = pk2(v0[2], v0[3]); o.z = pk2(v1[0], v1[1]); o.w = pk2(v1[2], v1[3]);
                        *(u32x4*)(rowp + bj * 128) = o;
                    }
                    if (isg) { float* gp = gates + (size_t)r * 16 + 8 * fq; *(f32x4*)gp = acc[ai][0][m][0]; *(f32x4*)(gp + 4) = acc[ai][0][m][1]; }
                    asm volatile("" ::: "memory");
                }
        }
    }
};
struct EpiRes {
    static constexpr bool PERM = false, AFTER_DRAIN = false;
    const float* xol; const float* xoc; float* xnl; float* xnc; const float* ga;
    __device__ __forceinline__ void operator()(const f32x4 (&acc)[2][2][4][2], const pg8::Unit& u, int wr, int wc, int fr, int fq) const {
        const int row0 = u.pm * 256 + wr * 64 + fr, col0 = u.pn * 256 + wc * 32 + 4 * fq;
#pragma unroll
        for (int ai = 0; ai < 2; ++ai)
#pragma unroll
            for (int m = 0; m < 4; ++m) {
                const int r = row0 + ai * 128 + m * 16;
                const float* xo; float* xn; int b;
                if (r < TL) { xo = xol + (size_t)r * D; xn = xnl + (size_t)r * D; b = r >> 11; } else { xo = xoc + (size_t)(r - TL) * D; xn = xnc + (size_t)(r - TL) * D; b = 8; }
                const float* gp = ga + (size_t)b * 6144;
#pragma unroll
                for (int bj = 0; bj < 2; ++bj)
#pragma unroll
                    for (int n = 0; n < 2; ++n) {
                        const int c = col0 + bj * 128 + n * 16;
                        const f32x4 g = *(const f32x4*)(gp + c), xv = *(const f32x4*)(xo + c);
                        *(f32x4*)(xn + c) = xv + g * acc[ai][bj][m][n];
                    }
            }
    }
};
struct EpiResNorm {
    static constexpr bool PERM = false, AFTER_DRAIN = true;
    const float* xo; float* xn; const float* ga; float* rss; unsigned* cnt; int mode; const float* g; const float* sc; const float* sh; bf16_t* hb;
    __device__ __forceinline__ void fused(f32x4 (&acc)[2][2][4][2], const pg8::Unit& u, int wr, int wc, int fr, int fq, PG8_LAS unsigned char* lds, int wid, int lane) const {
        const int row0 = u.pm * 256 + wr * 64 + fr, col0 = u.pn * 256 + wc * 32 + 4 * fq, b = (u.pm * 256) >> 11;
        float ps[2][4];
        {   const float* gp = ga + (size_t)b * 6144 + col0;
            f32x4 gv[2][2];
#pragma unroll
            for (int bj = 0; bj < 2; ++bj)
#pragma unroll
                for (int n = 0; n < 2; ++n) gv[bj][n] = *(const f32x4*)(gp + bj * 128 + n * 16);
#pragma unroll
            for (int ai = 0; ai < 2; ++ai) {
                f32x4 xt[4][2][2];
#pragma unroll
                for (int m = 0; m < 4; ++m) { const float* xr = xo + (size_t)(row0 + ai * 128 + m * 16) * D + col0;
#pragma unroll
                    for (int bj = 0; bj < 2; ++bj)
#pragma unroll
                        for (int n = 0; n < 2; ++n) xt[m][bj][n] = *(const f32x4*)(xr + bj * 128 + n * 16); }
#pragma unroll
                for (int m = 0; m < 4; ++m) { float s = 0.f;
#pragma unroll
                    for (int bj = 0; bj < 2; ++bj)
#pragma unroll
                        for (int n = 0; n < 2; ++n) { const f32x4 v = xt[m][bj][n] + gv[bj][n] * acc[ai][bj][m][n]; acc[ai][bj][m][n] = v;
                            s += v[0] * v[0] + v[1] * v[1] + v[2] * v[2] + v[3] * v[3]; }
                    ps[ai][m] = sum_over_fq(s); }
                asm volatile("" ::: "memory");
            } }
        PG8_LAS float* red = (PG8_LAS float*)lds;
        if (fq == 0) {
#pragma unroll
            for (int ai = 0; ai < 2; ++ai)
#pragma unroll
                for (int m = 0; m < 4; ++m) red[wc * 256 + ai * 128 + wr * 64 + m * 16 + fr] = ps[ai][m]; }
        __syncthreads();
        const int tid = wid * 64 + lane;
        if (tid < 256) { const float tot = (red[tid] + red[256 + tid]) + (red[512 + tid] + red[768 + tid]);
            (void)__hip_atomic_fetch_add(rss + u.pm * 256 + tid, tot, __ATOMIC_RELAXED, __HIP_MEMORY_SCOPE_AGENT); }
        asm volatile("s_waitcnt vmcnt(0)" ::: "memory");
        __syncthreads();
        if (tid == 0) { unsigned* c = cnt + u.pm * 64;
            (void)__hip_atomic_fetch_add(c, 1u, __ATOMIC_RELAXED, __HIP_MEMORY_SCOPE_AGENT);
            unsigned spins = 0; while (__hip_atomic_load(c, __ATOMIC_RELAXED, __HIP_MEMORY_SCOPE_AGENT) < 4u && ++spins < (1u << 22)) __builtin_amdgcn_s_sleep(1); }
        __syncthreads();
        const size_t bo = (size_t)b * 6144;
        float rs[2][4];
#pragma unroll
        for (int ai = 0; ai < 2; ++ai)
#pragma unroll
            for (int m = 0; m < 4; ++m) rs[ai][m] = __hip_atomic_load(rss + row0 + ai * 128 + m * 16, __ATOMIC_RELAXED, __HIP_MEMORY_SCOPE_AGENT);
#pragma unroll
        for (int ai = 0; ai < 2; ++ai)
#pragma unroll
            for (int m = 0; m < 4; ++m) {
                const int r = row0 + ai * 128 + m * 16;
                const float rstd = rsqrtf(rs[ai][m] * (1.f / D) + EPS);
#pragma unroll
                for (int bj = 0; bj < 2; ++bj)
#pragma unroll
                    for (int n = 0; n < 2; ++n) { const int c = col0 + bj * 128 + n * 16; const f32x4 v = acc[ai][bj][m][n];
                        const f32x4 y = v * rstd * *(const f32x4*)(g + c);
                        if (mode == 0) { *(f32x4*)(xn + (size_t)r * D + c) = v;
                            const f32x4 hh = y * (*(const f32x4*)(sc + bo + c) + 1.f) + *(const f32x4*)(sh + bo + c);
                            u32x2 o; o.x = pk2(hh[0], hh[1]); o.y = pk2(hh[2], hh[3]); *(u32x2*)(hb + (size_t)r * D + c) = o; }
                        else *(f32x4*)(xn + (size_t)r * D + c) = y; }
                asm volatile("" ::: "memory");
            }
    }
};
struct EpiUp {
    static constexpr bool PERM = true, AFTER_DRAIN = false;
    bf16_t* hid;
    __device__ __forceinline__ void operator()(const f32x4 (&acc)[2][2][4][2], const pg8::Unit& u, int wr, int wc, int fr, int fq) const {
        const int row0 = u.pm * 256 + wr * 64 + fr, col0 = u.pn * 256 + wc * 32 + 8 * fq;
#pragma unroll
        for (int ai = 0; ai < 2; ++ai)
#pragma unroll
            for (int m = 0; m < 4; ++m) {
                bf16_t* rowp = hid + (size_t)(row0 + ai * 128 + m * 16) * 4096 + col0;
#pragma unroll
                for (int bj = 0; bj < 2; ++bj) {
                    f32x4 v0 = acc[ai][bj][m][0], v1 = acc[ai][bj][m][1];
#pragma unroll
                    for (int j = 0; j < 4; ++j) { float a = fmaxf(v0[j], 0.f); v0[j] = a * a; float b = fmaxf(v1[j], 0.f); v1[j] = b * b; }
                    u32x4 o; o.x = pk2(v0[0], v0[1]); o.y = pk2(v0[2], v0[3]); o.z = pk2(v1[0], v1[1]); o.w = pk2(v1[2], v1[3]);
                    *(u32x4*)(rowp + bj * 128) = o;
                }
            }
    }
};
struct EpiFou {
    static constexpr bool PERM = true, AFTER_DRAIN = false;
    bf16_t* mix; int rows_per_b; int row_off; float scale;
    __device__ __forceinline__ void operator()(const f32x4 (&acc)[2][2][4][2], const pg8::Unit& u, int wr, int wc, int fr, int fq) const {
        const int row0 = u.pm * 256 + wr * 64 + fr, col0 = wc * 32 + 8 * fq;
        const size_t rb = (size_t)row_off + (size_t)u.pn * rows_per_b;
#pragma unroll
        for (int ai = 0; ai < 2; ++ai)
#pragma unroll
            for (int m = 0; m < 4; ++m) {
                bf16_t* rowp = mix + (rb + row0 + ai * 128 + m * 16) * D + col0;
#pragma unroll
                for (int bj = 0; bj < 2; ++bj) {
                    const f32x4 v0 = acc[ai][bj][m][0] * scale, v1 = acc[ai][bj][m][1] * scale;
                    u32x4 o; o.x = pk2(v0[0], v0[1]); o.y = pk2(v0[2], v0[3]); o.z = pk2(v1[0], v1[1]); o.w = pk2(v1[2], v1[3]);
                    *(u32x4*)(rowp + bj * 128) = o;
                }
            }
    }
};

template <class Epi>
__device__ __forceinline__ void run_gemm(unsigned char* shm, const bf16_t* A, const bf16_t* Bt, int M, int N, int K, int G, int c, const Epi& E) {
    pg8::Gemm g; g.A = A; g.Bt = Bt; g.M = M; g.N = N; g.K = K; g.ld = K;
    pg8::StaticOrder S; S.init(M, N, G, c);
    pg8::gemm_phase<Epi, pg8::StaticOrder, false>((PG8_LAS unsigned char*)shm, g, S, E, nullptr);
}

struct OneUnit {
    int pm, pn;
    __device__ bool next(int i, pg8::Unit& u) const { if (i) return false; u.pm = pm; u.pn = pn; return true; }
    __device__ __forceinline__ void a_ready(const pg8::Unit&) const {}
    __device__ __forceinline__ void done(const pg8::Unit&) const {}
};
struct EpiPart {
    static constexpr bool PERM = true, AFTER_DRAIN = false;
    bf16_t* part;
    __device__ __forceinline__ void operator()(const f32x4 (&acc)[2][2][4][2], const pg8::Unit& u, int wr, int wc, int fr, int fq) const {
        const int row0 = u.pm * 256 + wr * 64 + fr, col0 = u.pn * 256 + wc * 32 + 8 * fq;
#pragma unroll
        for (int ai = 0; ai < 2; ++ai)
#pragma unroll
            for (int m = 0; m < 4; ++m) {
                bf16_t* rowp = part + (size_t)(row0 + ai * 128 + m * 16) * D + col0;
#pragma unroll
                for (int bj = 0; bj < 2; ++bj) { const f32x4 v0 = acc[ai][bj][m][0], v1 = acc[ai][bj][m][1];
                    u32x4 o; o.x = pk2(v0[0], v0[1]); o.y = pk2(v0[2], v0[3]); o.z = pk2(v1[0], v1[1]); o.w = pk2(v1[2], v1[3]);
                    *(u32x4*)(rowp + bj * 128) = o; }
            }
    }
};
__device__ __forceinline__ void run_gemm_ctx_split(unsigned char* shm, const bf16_t* A, const bf16_t* Bt, int K, int ld, int pm, int pn, const EpiPart& E) {
    pg8::Gemm g; g.A = A; g.Bt = Bt; g.M = TC; g.N = 1024; g.K = K; g.ld = ld;
    OneUnit S; S.pm = pm; S.pn = pn;
    pg8::gemm_phase<EpiPart, OneUnit, false>((PG8_LAS unsigned char*)shm, g, S, E, nullptr);
}

__device__ __forceinline__ void build_costab(float* tab) {
    for (int i = ltid(); i < 2048; i += 512) tab[i] = cospif((float)i * (1.0f / 1024.0f));
    __syncthreads();
}
__device__ __forceinline__ void tr_load(const float* __restrict__ src, int ldn, int nmax, int k0, int nsrc0, float* tile) {
    const int tid = ltid(), r = tid >> 4, c4 = (tid & 15) * 4;
#pragma unroll
    for (int h = 0; h < 2; ++h) {
        const int rr = r + 32 * h, nc = nsrc0 + c4;
        f32x4 v = {0.f, 0.f, 0.f, 0.f};
        if (nc < nmax) v = *(const f32x4*)(src + (size_t)(k0 + rr) * ldn + nc);
        float* t = tile + rr * 65 + c4; t[0] = v[0]; t[1] = v[1]; t[2] = v[2]; t[3] = v[3];
    }
    __syncthreads();
}
__device__ __forceinline__ void tr_tile(const float* __restrict__ src, int ldn, int nmax, int k0, int nsrc0, bf16_t* __restrict__ dst, int ldk, int ndst0, float* tile) {
    tr_load(src, ldn, nmax, k0, nsrc0, tile);
    const int tid = ltid(), n = tid >> 3, kq = tid & 7;
    const float* s = tile + (kq * 8) * 65 + n;
    u32x4 o; o.x = pk2(s[0], s[65]); o.y = pk2(s[130], s[195]); o.z = pk2(s[260], s[325]); o.w = pk2(s[390], s[455]);
    *(u32x4*)(dst + (size_t)(ndst0 + n) * ldk + k0 + kq * 8) = o;
    __syncthreads();
}
__device__ __forceinline__ void fold_tile(const float* __restrict__ win, int k0, int g, bf16_t* __restrict__ dst, float* tile, const float* tab) {
    tr_load(win, 2224, 2224, k0, g * 64, tile);
    const int tid = ltid(), cp = tid >> 3, kq = tid & 7;
    float ac[8], as[8];
#pragma unroll
    for (int i = 0; i < 8; ++i) { ac[i] = 0.f; as[i] = 0.f; }
    for (int c = 0; c < 64; ++c) {
        const int idx = ((c * cp) & 63) * 32;
        const float cs = tab[idx], sn = tab[(idx - 512) & 2047];
#pragma unroll
        for (int i = 0; i < 8; ++i) { const float v = tile[(kq * 8 + i) * 65 + c]; ac[i] += v * cs; as[i] += v * sn; }
    }
    u32x4 o; o.x = pk2(ac[0], ac[1]); o.y = pk2(ac[2], ac[3]); o.z = pk2(ac[4], ac[5]); o.w = pk2(ac[6], ac[7]);
    *(u32x4*)(dst + (size_t)(g * 64 + cp) * 1024 + k0 + kq * 8) = o;
    u32x4 q; q.x = pk2(as[0], as[1]); q.y = pk2(as[2], as[3]); q.z = pk2(as[4], as[5]); q.w = pk2(as[6], as[7]);
    *(u32x4*)(dst + (size_t)(256 + g * 64 + cp) * 1024 + k0 + kq * 8) = q;
    __syncthreads();
}
__device__ __forceinline__ void tr_tile_wave(const float* __restrict__ src, int ldn, int nmax, int k0, int nsrc0, bf16_t* __restrict__ dst, int ldk, int ndst0, float* tile, int lane) {
    const int r = lane >> 4, c4 = (lane & 15) * 4;
    f32x4 tv[16];
#pragma unroll
    for (int h = 0; h < 16; ++h) { const int rr = r + 4 * h, nc = nsrc0 + c4; tv[h] = (f32x4){0.f, 0.f, 0.f, 0.f};
        if (nc < nmax) tv[h] = *(const f32x4*)(src + (size_t)(k0 + rr) * ldn + nc); }
#pragma unroll
    for (int h = 0; h < 16; ++h) { const int rr = r + 4 * h; float* t = tile + rr * 65 + c4; t[0] = tv[h][0]; t[1] = tv[h][1]; t[2] = tv[h][2]; t[3] = tv[h][3]; }
    asm volatile("s_waitcnt lgkmcnt(0)" ::: "memory");
    const int c = lane & 7, nl = lane >> 3;
#pragma unroll
    for (int j = 0; j < 8; ++j) { const int n = nl + 8 * j; const float* s = tile + (8 * c) * 65 + n;
        u32x4 o; o.x = pk2(s[0], s[65]); o.y = pk2(s[130], s[195]); o.z = pk2(s[260], s[325]); o.w = pk2(s[390], s[455]);
        *(u32x4*)(dst + (size_t)(ndst0 + n) * ldk + k0 + 8 * c) = o; }
    asm volatile("s_waitcnt lgkmcnt(0)" ::: "memory");
}
constexpr int NWV_ITEMS = 512 + 256 + 1024 + 1024 + 24 + 20;
__device__ __forceinline__ void prep_weight_item_wave(const KP& p, int l, int it, float* tile, int lane) {
    unsigned char* ws = p.ws;
    if (it < 512) { const int ct = it & 31, kt = it >> 5;
        tr_tile_wave(p.in[I_WIN] + (size_t)l * 1024 * 2224, 2224, 2224, kt * 64, 256 + ct * 64, (bf16_t*)(ws + WS_WIN), 1024, 512 + ct * 64, tile, lane); return; }
    it -= 512;
    if (it < 256) { tr_tile_wave(p.in[I_WOUT] + (size_t)l * 1024 * 1024, 1024, 1024, (it >> 4) * 64, (it & 15) * 64, (bf16_t*)(ws + WS_WOUT), 1024, (it & 15) * 64, tile, lane); return; }
    it -= 256;
    if (it < 1024) { tr_tile_wave(p.in[I_WUP] + (size_t)l * 1024 * 4096, 4096, 4096, (it >> 6) * 64, (it & 63) * 64, (bf16_t*)(ws + WS_WUP), 1024, (it & 63) * 64, tile, lane); return; }
    it -= 1024;
    if (it < 1024) { tr_tile_wave(p.in[I_WDOWN] + (size_t)l * 4096 * 1024, 1024, 1024, (it >> 4) * 64, (it & 15) * 64, (bf16_t*)(ws + WS_WDOWN), 4096, (it & 15) * 64, tile, lane); return; }
    it -= 1024;
    if (it < 24) { tr_tile_wave(p.in[I_WUQ] + (size_t)l * 256 * 384, 384, 384, (it / 6) * 64, (it % 6) * 64, (bf16_t*)(ws + WS_WUQ), 256, (it % 6) * 64, tile, lane); return; }
    it -= 24;
    tr_tile_wave(p.in[I_WUKV] + (size_t)l * 128 * 640, 640, 640, (it / 10) * 64, (it % 10) * 64, (bf16_t*)(ws + WS_WUKV), 128, (it % 10) * 64, tile, lane);
}
__device__ __forceinline__ void prep_weights(const KP& p, int l, unsigned char* shm, const float* tab, int part = 0, int b0 = 0, int nb = 0) {
    const int tid = ltid(), bid = lbid() - b0, G = nb ? nb : (int)gridDim.x;
    if (part != 2) for (int it = bid; it < 64; it += G) fold_tile(p.in[I_WIN] + (size_t)l * 1024 * 2224, (it >> 2) * 64, it & 3, (bf16_t*)(p.ws + WS_WIN), (float*)(shm + 8192), tab);
    __syncthreads();
    float* wt = (float*)(shm + 8192) + (tid >> 6) * (64 * 65);
    for (int it = bid * 8 + (tid >> 6); it < NWV_ITEMS; it += G * 8) {
        const bool isdown = it >= 1792 && it < 2816;
        if ((part == 1 && isdown) || (part == 2 && !isdown)) continue;
        prep_weight_item_wave(p, l, it, wt, tid & 63); }
    __syncthreads();
}
constexpr int NW_ITEMS = 512 + 64 + 256 + 1024 + 1024 + 24 + 20;
__device__ __forceinline__ void prep_weight_item(const KP& p, int l, int it, float* tile, const float* tab) {
    unsigned char* ws = p.ws;
    if (it < 512) { const int ct = it & 31, kt = it >> 5;
        tr_tile(p.in[I_WIN] + (size_t)l * 1024 * 2224, 2224, 2224, kt * 64, 256 + ct * 64, (bf16_t*)(ws + WS_WIN), 1024, 512 + ct * 64, tile); return; }
    it -= 512;
    if (it < 64) { fold_tile(p.in[I_WIN] + (size_t)l * 1024 * 2224, (it >> 2) * 64, it & 3, (bf16_t*)(ws + WS_WIN), tile, tab); return; }
    it -= 64;
    if (it < 256) { tr_tile(p.in[I_WOUT] + (size_t)l * 1024 * 1024, 1024, 1024, (it >> 4) * 64, (it & 15) * 64, (bf16_t*)(ws + WS_WOUT), 1024, (it & 15) * 64, tile); return; }
    it -= 256;
    if (it < 1024) { tr_tile(p.in[I_WUP] + (size_t)l * 1024 * 4096, 4096, 4096, (it >> 6) * 64, (it & 63) * 64, (bf16_t*)(ws + WS_WUP), 1024, (it & 63) * 64, tile); return; }
    it -= 1024;
    if (it < 1024) { tr_tile(p.in[I_WDOWN] + (size_t)l * 4096 * 1024, 1024, 1024, (it >> 4) * 64, (it & 15) * 64, (bf16_t*)(ws + WS_WDOWN), 4096, (it & 15) * 64, tile); return; }
    it -= 1024;
    if (it < 24) { tr_tile(p.in[I_WUQ] + (size_t)l * 256 * 384, 384, 384, (it / 6) * 64, (it % 6) * 64, (bf16_t*)(ws + WS_WUQ), 256, (it % 6) * 64, tile); return; }
    it -= 24;
    tr_tile(p.in[I_WUKV] + (size_t)l * 128 * 640, 640, 640, (it / 10) * 64, (it % 10) * 64, (bf16_t*)(ws + WS_WUKV), 128, (it % 10) * 64, tile);
}
__device__ __forceinline__ void prep_mod_item(const KP& p, int it, float* sl) {
    const int tid = ltid(), l = it / 96, cgp = it % 96;
    for (int i = tid; i < 9216; i += 512) { const int r = i >> 10, k = i & 1023; const float v = r < 8 ? p.in[I_C][r * 1024 + k] : p.in[I_CCTX][k]; sl[i] = siluf(v); }
    __syncthreads();
    const int j4 = (tid & 15) * 4, ks = tid >> 4;
    f32x4 acc[9];
#pragma unroll
    for (int r = 0; r < 9; ++r) acc[r] = (f32x4){0.f, 0.f, 0.f, 0.f};
    const float* w = p.in[I_WMOD] + (size_t)l * 1024 * 6144 + cgp * 64 + j4;
#pragma unroll 8
    for (int k = ks * 32; k < ks * 32 + 32; ++k) {
        const f32x4 wv = *(const f32x4*)(w + (size_t)k * 6144);
#pragma unroll
        for (int r = 0; r < 9; ++r) acc[r] += wv * sl[r * 1024 + k];
    }
    float* red = sl + 9216;
#pragma unroll
    for (int r = 0; r < 9; ++r) *(f32x4*)(red + (ks * 9 + r) * 64 + j4) = acc[r];
    __syncthreads();
    for (int o = tid; o < 576; o += 512) { const int r = o >> 6, jl = o & 63; float s = 0.f;
#pragma unroll
        for (int q = 0; q < 32; ++q) s += red[(q * 9 + r) * 64 + jl];
        ((float*)(p.ws + WS_MOD))[(size_t)(l * 9 + r) * 6144 + cgp * 64 + jl] = s + p.in[I_BMOD][l * 6144 + cgp * 64 + jl]; }
    __syncthreads();
}
__device__ __forceinline__ void prep_dft_row(const KP& p, int rowid, const float* tab) {
    const int tid = ltid();
    if (rowid < 2048) {
        const int k = rowid; float v[4];
#pragma unroll
        for (int e = 0; e < 4; ++e) { const int j = tid * 4 + e;
            if (j <= 1024) v[e] = tab[(k * j) & 2047]; else { const int n = j - 1024; v[e] = -tab[(((k * n) & 2047) - 512) & 2047]; } }
        u32x2 ov; ov.x = pk2(v[0], v[1]); ov.y = pk2(v[2], v[3]);
        *(u32x2*)((bf16_t*)(p.ws + WS_FDFT) + (size_t)k * 2048 + tid * 4) = ov;
    } else if (tid < 64) {
        const int k = rowid - 2048; unsigned o[4];
#pragma unroll
        for (int i = 0; i < 4; ++i) { float v[2];
#pragma unroll
            for (int e = 0; e < 2; ++e) { const int np = tid * 8 + i * 2 + e, n = np & 255, j = ((k * n) & 255) * 8; v[e] = (np >> 8) ? -tab[(j - 512) & 2047] : tab[j]; }
            o[i] = pk2(v[0], v[1]); }
        u32x4 ov = {o[0], o[1], o[2], o[3]};
        *(u32x4*)((bf16_t*)(p.ws + WS_FDFTC) + (size_t)k * 512 + tid * 8) = ov;
    }
}
__device__ __forceinline__ void rope_cs(int tpos, int seg, int f, float& cs, float& sn);
__device__ __forceinline__ void step_prep0(const KP& p, unsigned char* shm) {
    float* tab = (float*)shm; float* work = (float*)(shm + 8192);
    build_costab(tab);
    {
        unsigned* z = (unsigned*)(p.ws + WS_RCNT);
        for (int i = lbid() * 512 + ltid(); i < (65536 + 262144) / 4; i += gridDim.x * 512) z[i] = 0u; }
    {
        float* rt = (float*)(p.ws + WS_ROPE);
        for (int i = lbid() * 512 + ltid(); i < 2048 * 16; i += gridDim.x * 512) { float cs, sn; rope_cs(i >> 4, (i >> 3) & 1, i & 7, cs, sn); rt[2 * i] = cs; rt[2 * i + 1] = sn; } }
    const int NT = 192 + 2304;
    for (int it = lbid(); it < NT; it += gridDim.x) {
        if (it < 192) prep_mod_item(p, it, work);
        else prep_dft_row(p, it - 192, tab);
    }
    __syncthreads();
    prep_weights(p, 0, shm, tab);
}

__device__ __forceinline__ void norm_rows(const float* xl, const float* xc, int nrows, const float* g, const float* modl, int shoff, int scoff, bf16_t* dst, const bf16_t* part = nullptr, const float* pga = nullptr, float* xcw = nullptr, int rlo = 0) {
    const int tid = ltid(), lane = tid & 63, gw = lbid() * 8 + (tid >> 6), NW = gridDim.x * 8;
    for (int r0 = rlo + gw; r0 < nrows; r0 += 3 * NW) {
        f32x4 v[3][4]; float ss[3];
#pragma unroll
        for (int q = 0; q < 3; ++q) { const int r = r0 + q * NW; ss[q] = 0.f;
            if (r < nrows) { const float* xr = r < TL ? xl + (size_t)r * D : xc + (size_t)(r - TL) * D;
#pragma unroll
                for (int j = 0; j < 4; ++j) v[q][j] = *(const f32x4*)(xr + lane * 4 + 256 * j);
                if (part != nullptr && r >= TL) {
#pragma unroll
                    for (int j = 0; j < 4; ++j) { const int c = lane * 4 + 256 * j; f32x4 a = {0.f, 0.f, 0.f, 0.f};
#pragma unroll
                        for (int sp = 0; sp < 4; ++sp) { const u32x2 pv = *(const u32x2*)(part + ((size_t)sp * TC + (r - TL)) * D + c); a[0] += lo_bf(pv.x); a[1] += hi_bf(pv.x); a[2] += lo_bf(pv.y); a[3] += hi_bf(pv.y); }
                        v[q][j] += *(const f32x4*)(pga + c) * a;
                        if (xcw != nullptr) *(f32x4*)(xcw + (size_t)(r - TL) * D + c) = v[q][j]; } } }
            else {
#pragma unroll
                for (int j = 0; j < 4; ++j) v[q][j] = (f32x4){0.f, 0.f, 0.f, 0.f}; } }
#pragma unroll
        for (int q = 0; q < 3; ++q) {
#pragma unroll
            for (int j = 0; j < 4; ++j) ss[q] += v[q][j][0] * v[q][j][0] + v[q][j][1] * v[q][j][1] + v[q][j][2] * v[q][j][2] + v[q][j][3] * v[q][j][3];
            ss[q] = wave_sum(ss[q]); }
#pragma unroll
        for (int q = 0; q < 3; ++q) { const int r = r0 + q * NW;
            if (r < nrows) { const int b = r < TL ? (r >> 11) : 8; const float rstd = rsqrtf(ss[q] * (1.f / D) + EPS); const float* mp = modl + (size_t)b * 6144;
#pragma unroll
                for (int j = 0; j < 4; ++j) { const int c = lane * 4 + 256 * j;
                    const f32x4 gg = *(const f32x4*)(g + c), sc = *(const f32x4*)(mp + scoff + c), sh = *(const f32x4*)(mp + shoff + c);
                    const f32x4 y = v[q][j] * rstd * gg, hh = y * (sc + 1.f) + sh;
                    u32x2 o; o.x = pk2(hh[0], hh[1]); o.y = pk2(hh[2], hh[3]);
                    *(u32x2*)(dst + (size_t)r * D + c) = o; } } }
    }
}
__device__ __forceinline__ void step_final(const KP& p) {
    const int tid = ltid(), lane = tid & 63, gw = lbid() * 8 + (tid >> 6), NW = gridDim.x * 8;
    const float* g = p.in[I_GFIN];
    for (int r0 = gw; r0 < TL; r0 += 2 * NW) {
        f32x4 v[2][4]; float ss[2];
#pragma unroll
        for (int q = 0; q < 2; ++q) { const float* xr = p.out + (size_t)(r0 + q * NW) * D; ss[q] = 0.f;
#pragma unroll
            for (int j = 0; j < 4; ++j) v[q][j] = *(const f32x4*)(xr + lane * 4 + 256 * j); }
#pragma unroll
        for (int q = 0; q < 2; ++q) {
#pragma unroll
            for (int j = 0; j < 4; ++j) ss[q] += v[q][j][0] * v[q][j][0] + v[q][j][1] * v[q][j][1] + v[q][j][2] * v[q][j][2] + v[q][j][3] * v[q][j][3];
            ss[q] = wave_sum(ss[q]); }
#pragma unroll
        for (int q = 0; q < 2; ++q) { float* xr = p.out + (size_t)(r0 + q * NW) * D; const float rstd = rsqrtf(ss[q] * (1.f / D) + EPS);
#pragma unroll
            for (int j = 0; j < 4; ++j) { const int c = lane * 4 + 256 * j; *(f32x4*)(xr + c) = v[q][j] * rstd * *(const f32x4*)(g + c); } }
    }
}

constexpr int ML_GA = 0;
constexpr int ML_CW = 3072;
constexpr int ML_Q = 7168;
constexpr int ML_K = 33792;
constexpr int ML_VT = 60416;
constexpr int ML_RAW = 90880;
__device__ __forceinline__ int ml_rowbase(int b, int jc) { return jc < 2 ? TL + b * CL + jc * LCH : b * SEQ + (jc - 2) * LCH; }

__device__ __forceinline__ void ml_stage(const KP& p, int l, int b, int h, int jc, unsigned char* shm) {
    const int tid = ltid();
    const bf16_t* proj = (const bf16_t*)(p.ws + WS_PROJ);
    const float* gates = (const float*)(p.ws + WS_GATES);
    float* GA = (float*)(shm + ML_GA); float* CW = (float*)(shm + ML_CW);
    bf16_t* vT = (bf16_t*)(shm + ML_VT); bf16_t* RAW = (bf16_t*)(shm + ML_RAW);
    const int rowbase = ml_rowbase(b, jc);
    const int t0 = jc < 2 ? jc * LCH : (jc - 2) * LCH, slen = jc < 2 ? CL : SEQ;
    float i_f = 0.f, i_b = 0.f, pf = 0.f, sf = 0.f;
    if (tid < 128) {
        const int lane = tid & 63;
        const float* gp = gates + (size_t)(rowbase + tid) * 16; const float* bg = p.in[I_BG] + l * 16;
        const f32x4 g0 = *(const f32x4*)gp, g1 = *(const f32x4*)(gp + 4), g2 = *(const f32x4*)(gp + 8), g3 = *(const f32x4*)(gp + 12);
        i_f = g0[h] + bg[h]; i_b = g2[h] + bg[8 + h];
        pf = logsig(g1[h] + bg[4 + h]); sf = logsig(g3[h] + bg[12 + h]);
#pragma unroll
        for (int o = 1; o < 64; o <<= 1) { const float t = __shfl_up(pf, o); if (lane >= o) pf += t; const float u = __shfl_down(sf, o); if (lane + o < 64) sf += u; }
        if (lane == 63) GA[4 * 128 + (tid >> 6)] = pf;
        if (lane == 0) GA[5 * 128 + (tid >> 6)] = sf;
    }
    float cwv[2]; u32x4 rv[7], vv[3];
#pragma unroll
    for (int q = 0; q < 2; ++q) { const int i = tid + 512 * q; cwv[q] = 0.f;
        if (i < 5 * 192) { const int k = i / 192, ch = i % 192; cwv[q] = p.in[I_CONV][(size_t)l * 5 * 768 + k * 768 + (ch < 96 ? h * 96 + ch : 384 + h * 96 + (ch - 96))]; } }
#pragma unroll
    for (int q = 0; q < 7; ++q) { const int i = tid + 512 * q; rv[q] = (u32x4){0u, 0u, 0u, 0u};
        if (i < 132 * 24) { const int rr = i / 24, ck = i % 24, t = t0 - 2 + rr;
            if (t >= 0 && t < slen) { const int col = ck < 12 ? C_MQ + h * 96 + ck * 8 : C_MK + h * 96 + (ck - 12) * 8; rv[q] = *(const u32x4*)(proj + (size_t)(rowbase - 2 + rr) * PW + col); } } }
#pragma unroll
    for (int q = 0; q < 3; ++q) { const int i = tid + 512 * q, s = i / 12, ck = i % 12; vv[q] = *(const u32x4*)(proj + (size_t)(rowbase + s) * PW + C_MV + h * 96 + ck * 8); }
#pragma unroll
    for (int q = 0; q < 2; ++q) { const int i = tid + 512 * q; if (i < 5 * 192) CW[i] = cwv[q]; }
#pragma unroll
    for (int q = 0; q < 7; ++q) { const int i = tid + 512 * q; if (i < 132 * 24) { const int rr = i / 24, ck = i % 24; *(u32x4*)(RAW + rr * 192 + ck * 8) = rv[q]; } }
#pragma unroll
    for (int q = 0; q < 3; ++q) { const int i = tid + 512 * q, s = i / 12, ck = i % 12; const u32x4 v = vv[q];
        bf16_t* d = vT + (ck * 8) * 136 + s;
        d[0] = (bf16_t)(v.x & 0xFFFF); d[136] = (bf16_t)(v.x >> 16); d[2 * 136] = (bf16_t)(v.y & 0xFFFF); d[3 * 136] = (bf16_t)(v.y >> 16);
        d[4 * 136] = (bf16_t)(v.z & 0xFFFF); d[5 * 136] = (bf16_t)(v.z >> 16); d[6 * 136] = (bf16_t)(v.w & 0xFFFF); d[7 * 136] = (bf16_t)(v.w >> 16); }
    for (int i = tid; i < 16 * 128; i += 512) { const int r = i >> 7, s = i & 127; vT[(96 + r) * 136 + s] = r == 0 ? (bf16_t)0x3F80 : (bf16_t)0; }
    __syncthreads();
    if (tid < 128) {
        const float bf = pf + (tid >= 64 ? GA[4 * 128 + 0] : 0.f), bb = sf + (tid < 64 ? GA[5 * 128 + 1] : 0.f);
        GA[0 * 128 + tid] = i_f; GA[1 * 128 + tid] = bf; GA[2 * 128 + tid] = i_b; GA[3 * 128 + tid] = bb;
    }
    __syncthreads();
}

__device__ __forceinline__ void conv8(const bf16_t* RAW, const float* CW, int s0, int ch, float (&o0)[8], float (&o1)[8]) {
    float w0[5], w1[5];
#pragma unroll
    for (int i = 0; i < 5; ++i) { w0[i] = CW[i * 192 + ch]; w1[i] = CW[i * 192 + ch + 1]; }
    unsigned rv[12];
#pragma unroll
    for (int i = 0; i < 12; ++i) rv[i] = *(const unsigned*)(RAW + (s0 + i) * 192 + ch);
#pragma unroll
    for (int o = 0; o < 8; ++o) { float a0 = 0.f, a1 = 0.f;
#pragma unroll
        for (int i = 0; i < 5; ++i) { a0 += lo_bf(rv[o + i]) * w0[i]; a1 += hi_bf(rv[o + i]) * w1[i]; }
        o0[o] = siluf(a0); o1[o] = siluf(a1); }
}
__device__ __forceinline__ void mlstm_a_item(const KP& p, int l, int item, unsigned char* shm) {
    const int tid = ltid(), w = tid >> 6, lane = tid & 63, fr = lane & 15, fq = lane >> 4;
    const int jc = item % NCH, bh = item / NCH, h = bh & 3, b = bh >> 2;
    ml_stage(p, l, b, h, jc, shm);
    float* GA = (float*)(shm + ML_GA); const float* CW = (const float*)(shm + ML_CW);
    bf16_t* kwf = (bf16_t*)(shm + ML_Q); bf16_t* kwb = (bf16_t*)(shm + ML_K);
    const bf16_t* vT = (const bf16_t*)(shm + ML_VT); const bf16_t* RAW = (const bf16_t*)(shm + ML_RAW);
    const float Bf = GA[1 * 128 + 127], Bb = GA[3 * 128 + 0];
    if (tid < 128) { GA[4 * 128 + tid] = __expf(Bf - GA[1 * 128 + tid] + GA[0 * 128 + tid]); GA[5 * 128 + tid] = __expf(Bb - GA[3 * 128 + tid] + GA[2 * 128 + tid]); }
    if (tid == 0) { float* dec = (float*)(p.ws + WS_DEC); dec[(bh * 2 + 0) * NCH + jc] = __expf(Bf); dec[(bh * 2 + 1) * NCH + jc] = __expf(Bb); }
    __syncthreads();
    for (int task = tid; task < 48 * 16; task += 512) { const int cp = task % 48, s0 = (task / 48) * 8, ch = 96 + 2 * cp, dk = 2 * cp;
        float o0[8], o1[8]; conv8(RAW, CW, s0, ch, o0, o1);
        const f32x4 wfa = *(const f32x4*)(GA + 4 * 128 + s0), wfb = *(const f32x4*)(GA + 4 * 128 + s0 + 4), wba = *(const f32x4*)(GA + 5 * 128 + s0), wbb = *(const f32x4*)(GA + 5 * 128 + s0 + 4);
        u32x4 t;
        t.x = pk2(o0[0] * wfa[0], o0[1] * wfa[1]); t.y = pk2(o0[2] * wfa[2], o0[3] * wfa[3]); t.z = pk2(o0[4] * wfb[0], o0[5] * wfb[1]); t.w = pk2(o0[6] * wfb[2], o0[7] * wfb[3]); *(u32x4*)(kwf + dk * 136 + s0) = t;
        t.x = pk2(o1[0] * wfa[0], o1[1] * wfa[1]); t.y = pk2(o1[2] * wfa[2], o1[3] * wfa[3]); t.z = pk2(o1[4] * wfb[0], o1[5] * wfb[1]); t.w = pk2(o1[6] * wfb[2], o1[7] * wfb[3]); *(u32x4*)(kwf + (dk + 1) * 136 + s0) = t;
        t.x = pk2(o0[0] * wba[0], o0[1] * wba[1]); t.y = pk2(o0[2] * wba[2], o0[3] * wba[3]); t.z = pk2(o0[4] * wbb[0], o0[5] * wbb[1]); t.w = pk2(o0[6] * wbb[2], o0[7] * wbb[3]); *(u32x4*)(kwb + dk * 136 + s0) = t;
        t.x = pk2(o1[0] * wba[0], o1[1] * wba[1]); t.y = pk2(o1[2] * wba[2], o1[3] * wba[3]); t.z = pk2(o1[4] * wbb[0], o1[5] * wbb[1]); t.w = pk2(o1[6] * wbb[2], o1[7] * wbb[3]); *(u32x4*)(kwb + (dk + 1) * 136 + s0) = t; }
    __syncthreads();
    bf16_t* dC = (bf16_t*)(p.ws + WS_DC);
    for (int tix = w; tix < 84; tix += 8) { const int dir = tix / 42, tt = tix % 42, vt = tt / 6, nt = tt % 6;
        const bf16_t* kw = dir ? kwb : kwf;
        f32x4 acc = {0.f, 0.f, 0.f, 0.f};
        bf16x8 af[4], bf4[4];
#pragma unroll
        for (int ks = 0; ks < 4; ++ks) { af[ks] = *(const bf16x8*)(vT + (16 * vt + fr) * 136 + 32 * ks + 8 * fq); bf4[ks] = *(const bf16x8*)(kw + (16 * nt + fr) * 136 + 32 * ks + 8 * fq); }
        __builtin_amdgcn_sched_barrier(0);
#pragma unroll
        for (int ks = 0; ks < 4; ++ks) acc = MFMA16(af[ks], bf4[ks], acc);
        bf16_t* o = dC + ((size_t)(bh * 2 + dir) * NCH + jc) * STSZ + (16 * vt + 4 * fq) * 96 + 16 * nt + fr;
        o[0] = f2bf(acc[0]); o[96] = f2bf(acc[1]); o[192] = f2bf(acc[2]); o[288] = f2bf(acc[3]); }
    __syncthreads();
}

__device__ __forceinline__ void mlstm_scan(const KP& p) {
    const bf16_t* dC = (const bf16_t*)(p.ws + WS_DC); bf16_t* Cst = (bf16_t*)(p.ws + WS_CST); const float* dec = (const float*)(p.ws + WS_DEC);
    const int nthr = gridDim.x * 512;
    for (int wi = lbid() * 512 + ltid(); wi < 64 * (STSZ / 8); wi += nthr) {
        const int chain = wi / (STSZ / 8), e = (wi % (STSZ / 8)) * 8, dir = chain & 1;
        u32x4 dv[NCH]; float dd[NCH];
#pragma unroll
        for (int pz = 0; pz < NCH; ++pz) { const int jc = dir == 0 ? pz : (pz < 2 ? 1 - pz : NCH + 1 - pz);
            dv[pz] = *(const u32x4*)(dC + ((size_t)chain * NCH + jc) * STSZ + e); dd[pz] = dec[chain * NCH + jc]; }
        float S[8];
#pragma unroll
        for (int i = 0; i < 8; ++i) S[i] = 0.f;
#pragma unroll
        for (int pz = 0; pz < NCH; ++pz) {
            const int jc = dir == 0 ? pz : (pz < 2 ? 1 - pz : NCH + 1 - pz);
            u32x4 o; o.x = pk2(S[0], S[1]); o.y = pk2(S[2], S[3]); o.z = pk2(S[4], S[5]); o.w = pk2(S[6], S[7]);
            *(u32x4*)(Cst + ((size_t)chain * NCH + jc) * STSZ + e) = o;
            const u32x4 d = dv[pz]; const float f = dd[pz];
            S[0] = S[0] * f + lo_bf(d.x); S[1] = S[1] * f + hi_bf(d.x); S[2] = S[2] * f + lo_bf(d.y); S[3] = S[3] * f + hi_bf(d.y);
            S[4] = S[4] * f + lo_bf(d.z); S[5] = S[5] * f + hi_bf(d.z); S[6] = S[6] * f + lo_bf(d.w); S[7] = S[7] * f + hi_bf(d.w);
        }
    }
}

__device__ __forceinline__ void mlstm_c_item(const KP& p, int l, int b, int h, int jc, unsigned char* shm) {
    const int tid = ltid(), w = tid >> 6, lane = tid & 63, fr = lane & 15, fq = lane >> 4;
    const int bh = b * 4 + h;
    ml_stage(p, l, b, h, jc, shm);
    const float* GA = (const float*)(shm + ML_GA); const float* CW = (const float*)(shm + ML_CW);
    bf16_t* qL = (bf16_t*)(shm + ML_Q); bf16_t* kL = (bf16_t*)(shm + ML_K);
    const bf16_t* vT = (const bf16_t*)(shm + ML_VT); const bf16_t* RAW = (const bf16_t*)(shm + ML_RAW);
    bf16_t* CsL = (bf16_t*)(shm + ML_RAW);
    const float qscale = 0.10206207261596577f;
    u32x4 cpre[6];
    {   const bf16_t* Cst = (const bf16_t*)(p.ws + WS_CST);
#pragma unroll
        for (int i = 0; i < 6; ++i) { const int c = tid + 512 * i; if (c < 2 * 112 * 12) { const int dir = c / 1344, r = (c % 1344) / 12, ck = c % 12;
            cpre[i] = *(const u32x4*)(Cst + ((size_t)(bh * 2 + dir) * NCH + jc) * STSZ + r * 96 + ck * 8); } else cpre[i] = (u32x4){0u, 0u, 0u, 0u}; } }
    for (int task = tid; task < 96 * 16; task += 512) { const int cp = task % 96, s0 = (task / 96) * 8, ch = 2 * cp;
        float o0[8], o1[8]; conv8(RAW, CW, s0, ch, o0, o1);
        if (ch < 96) {
#pragma unroll
            for (int i = 0; i < 8; ++i) *(unsigned*)(qL + (s0 + i) * 104 + ch) = pk2(o0[i] * qscale, o1[i] * qscale);
        } else {
#pragma unroll
            for (int i = 0; i < 8; ++i) *(unsigned*)(kL + (s0 + i) * 104 + (ch - 96)) = pk2(o0[i], o1[i]); } }
    __syncthreads();
    {
        for (int i = 0; i < 6; ++i) { const int c = tid + 512 * i; if (c < 2 * 112 * 12) { const int dir = c / 1344, r = (c % 1344) / 12, ck = c % 12; *(u32x4*)(CsL + dir * (112 * 104) + r * 104 + ck * 8) = cpre[i]; } }
    }
    __syncthreads();
    const int t = 16 * w + fr;
    const int row = ml_rowbase(b, jc) + t;
    const bf16_t* proj = (const bf16_t*)(p.ws + WS_PROJ);
    u32x2 mov[6];
#pragma unroll
    for (int vt = 0; vt < 6; ++vt) mov[vt] = *(const u32x2*)(proj + (size_t)row * PW + C_MO + h * 96 + 16 * vt + 4 * fq);
    bf16x8 qf[3];
#pragma unroll
    for (int ks = 0; ks < 3; ++ks) qf[ks] = *(const bf16x8*)(qL + t * 104 + 32 * ks + 8 * fq);
    const float bft = GA[128 + t], bbt = GA[3 * 128 + t];
    bf16x8 PF[4], PB[4];
#pragma unroll
    for (int half = 0; half < 2; ++half) {
        bf16x8 kf[4][3];
#pragma unroll
        for (int i = 0; i < 4; ++i)
#pragma unroll
            for (int ks = 0; ks < 3; ++ks) kf[i][ks] = *(const bf16x8*)(kL + (16 * (4 * half + i) + fr) * 104 + 32 * ks + 8 * fq);
        __builtin_amdgcn_sched_barrier(0);
        f32x4 sa[4];
#pragma unroll
        for (int i = 0; i < 4; ++i) { sa[i] = (f32x4){0.f, 0.f, 0.f, 0.f};
#pragma unroll
            for (int ks = 0; ks < 3; ++ks) sa[i] = MFMA16(kf[i][ks], qf[ks], sa[i]); }
        __builtin_amdgcn_sched_barrier(0);
#pragma unroll
        for (int k2 = 0; k2 < 2; ++k2) {
            unsigned pf[4], pb[4];
#pragma unroll
            for (int hh = 0; hh < 2; ++hh) { const int i = 2 * k2 + hh, st = 4 * half + i;
                const int s0 = 16 * st + 4 * fq;
                const f32x4 gif = *(const f32x4*)(GA + s0), gbf = *(const f32x4*)(GA + 128 + s0), gib = *(const f32x4*)(GA + 256 + s0), gbb = *(const f32x4*)(GA + 384 + s0);
                float vf[4], vb[4];
#pragma unroll
                for (int j = 0; j < 4; ++j) { const int s = s0 + j;
                    vf[j] = (s <= t) ? sa[i][j] * __expf(bft - gbf[j] + gif[j]) : 0.f;
                    vb[j] = (s >= t) ? sa[i][j] * __expf(bbt - gbb[j] + gib[j]) : 0.f; }
                pf[2 * hh] = pk2(vf[0], vf[1]); pf[2 * hh + 1] = pk2(vf[2], vf[3]); pb[2 * hh] = pk2(vb[0], vb[1]); pb[2 * hh + 1] = pk2(vb[2], vb[3]); }
            u32x4 tf = {pf[0], pf[1], pf[2], pf[3]}, tb = {pb[0], pb[1], pb[2], pb[3]};
            PF[2 * half + k2] = __builtin_bit_cast(bf16x8, tf); PB[2 * half + k2] = __builtin_bit_cast(bf16x8, tb);
        }
    }
    const float ebf = __expf(bft), ebb = __expf(bbt);
    f32x4 nf[7], nb[7];
#pragma unroll
    for (int vt = 0; vt < 7; ++vt) {
        bf16x8 cf[3], cb[3]; u32x2 vlo[4], vhi[4];
#pragma unroll
        for (int ks = 0; ks < 3; ++ks) { cf[ks] = *(const bf16x8*)(CsL + (16 * vt + fr) * 104 + 32 * ks + 8 * fq); cb[ks] = *(const bf16x8*)(CsL + 112 * 104 + (16 * vt + fr) * 104 + 32 * ks + 8 * fq); }
#pragma unroll
        for (int kk = 0; kk < 4; ++kk) { vlo[kk] = *(const u32x2*)(vT + (16 * vt + fr) * 136 + 32 * kk + 4 * fq); vhi[kk] = *(const u32x2*)(vT + (16 * vt + fr) * 136 + 32 * kk + 16 + 4 * fq); }
        __builtin_amdgcn_sched_barrier(0);
        f32x4 af = {0.f, 0.f, 0.f, 0.f}, ab = {0.f, 0.f, 0.f, 0.f};
#pragma unroll
        for (int ks = 0; ks < 3; ++ks) { af = MFMA16(cf[ks], qf[ks], af); ab = MFMA16(cb[ks], qf[ks], ab); }
        af *= ebf; ab *= ebb;
#pragma unroll
        for (int kk = 0; kk < 4; ++kk) { const bf16x8 a = mk8(vlo[kk], vhi[kk]); af = MFMA16(a, PF[kk], af); ab = MFMA16(a, PB[kk], ab); }
        nf[vt] = af; nb[vt] = ab;
    }
    const float denf = __shfl(nf[6][0], fr), denb = __shfl(nb[6][0], fr);
    const float rf = 1.f / fmaxf(fabsf(denf), 1.f), rb = 1.f / fmaxf(fabsf(denb), 1.f);
    float ss = 0.f;
#pragma unroll
    for (int vt = 0; vt < 6; ++vt) { nf[vt] = nf[vt] * rf + nb[vt] * rb; ss += nf[vt][0] * nf[vt][0] + nf[vt][1] * nf[vt][1] + nf[vt][2] * nf[vt][2] + nf[vt][3] * nf[vt][3]; }
    ss = sum_over_fq(ss);
    const float rn = rsqrtf(ss * (1.f / 96.f) + EPS);
    bf16_t* mix = (bf16_t*)(p.ws + WS_MIX);
    const float* gm = p.in[I_GM] + l * 384 + h * 96;
#pragma unroll
    for (int vt = 0; vt < 6; ++vt) { const int vc = 16 * vt + 4 * fq;
        const u32x2 mo = mov[vt]; const f32x4 g = *(const f32x4*)(gm + vc);
        const float m0 = lo_bf(mo.x), m1 = hi_bf(mo.x), m2 = lo_bf(mo.y), m3 = hi_bf(mo.y);
        const float y0 = nf[vt][0] * rn * g[0] / (1.f + __expf(-m0)), y1 = nf[vt][1] * rn * g[1] / (1.f + __expf(-m1));
        const float y2 = nf[vt][2] * rn * g[2] / (1.f + __expf(-m2)), y3 = nf[vt][3] * rn * g[3] / (1.f + __expf(-m3));
        u32x2 o; o.x = pk2(y0, y1); o.y = pk2(y2, y3);
        *(u32x2*)(mix + (size_t)row * D + 256 + h * 96 + vc) = o; }
    __syncthreads();
}

__device__ __forceinline__ void zt_fold_item(const KP& p, int item, unsigned char* shm) {
    const int tid = ltid(), w = tid >> 6, lane = tid & 63;
    const int col = item * 8 + w;
    const bf16_t* zr = (const bf16_t*)(p.ws + WS_ZT) + (size_t)col * 4096;
    bf16_t* la = (bf16_t*)(shm + w * 8192); bf16_t* lb = la + 2048;
#pragma unroll
    for (int q = 0; q < 4; ++q) { *(u32x4*)(la + (q * 64 + lane) * 8) = *(const u32x4*)(zr + (q * 64 + lane) * 8); *(u32x4*)(lb + (q * 64 + lane) * 8) = *(const u32x4*)(zr + 2048 + (q * 64 + lane) * 8); }
    asm volatile("s_waitcnt vmcnt(0) lgkmcnt(0)" ::: "memory");
    bf16_t* out = (bf16_t*)(p.ws + WS_ZTF) + (size_t)col * 2048;
#pragma unroll
    for (int q = 0; q < 4; ++q) { const int j0 = (q * 64 + lane) * 8; unsigned o[4];
#pragma unroll
        for (int e2 = 0; e2 < 4; ++e2) { float v[2];
#pragma unroll
            for (int e = 0; e < 2; ++e) { const int j = j0 + 2 * e2 + e;
                if (j == 0 || j == 1024) v[e] = bf2f(la[j]);
                else if (j < 1024) v[e] = bf2f(la[j]) + bf2f(la[2048 - j]);
                else { const int n = j - 1024; v[e] = bf2f(lb[n]) - bf2f(lb[2048 - n]); } }
            o[e2] = pk2(v[0], v[1]); }
        u32x4 ov = {o[0], o[1], o[2], o[3]};
        *(u32x4*)(out + j0) = ov; }
    asm volatile("s_waitcnt lgkmcnt(0)" ::: "memory");
}

__device__ __forceinline__ void rope_cs_tab(const float* rt, int tpos, int seg, int f, float& cs, float& sn) { const float2 v = *(const float2*)(rt + ((tpos * 2 + seg) * 8 + f) * 2); cs = v.x; sn = v.y; }
__device__ __forceinline__ void rope_cs(int tpos, int seg, int f, float& cs, float& sn) {
    const float pos = (float)(seg == 0 ? (tpos >> 6) : (tpos & 63));
    const float fr = exp2f(-(float)f * 1.6609640474436813f);
    sincosf(pos * fr, &sn, &cs);
}
__device__ __forceinline__ void qkv_item(const KP& p, int l, int item, unsigned char* shm) {
    const int tid = ltid(), w = tid >> 6, lane = tid & 63, fr = lane & 15, fq = lane >> 4;
    const int r0 = item * 64; const bool lat = r0 < TL;
    const int b = lat ? (r0 >> 11) : ((r0 - TL) >> 8), tl0 = lat ? (r0 & 2047) : ((r0 - TL) & 255), key0 = lat ? tl0 : SEQ + tl0;
    const bf16_t* proj = (const bf16_t*)(p.ws + WS_PROJ); const float* rt = (const float*)(p.ws + WS_ROPE);
    bf16_t* aq = (bf16_t*)shm; bf16_t* akv = (bf16_t*)(shm + 64 * 264 * 2);
    {
        const int tk = tid >> 3, sub = tid & 7; const bf16_t* pr = proj + (size_t)(r0 + tk) * PW;
        u32x4 cq[4], ck[2]; float sq = 0.f, sk = 0.f;
#pragma unroll
        for (int i = 0; i < 4; ++i) { cq[i] = *(const u32x4*)(pr + C_CQ + sub * 32 + i * 8);
#pragma unroll
            for (int e = 0; e < 4; ++e) { const float a = lo_bf(cq[i][e]), c = hi_bf(cq[i][e]); sq += a * a + c * c; } }
#pragma unroll
        for (int i = 0; i < 2; ++i) { ck[i] = *(const u32x4*)(pr + C_CKV + sub * 16 + i * 8);
#pragma unroll
            for (int e = 0; e < 4; ++e) { const float a = lo_bf(ck[i][e]), c = hi_bf(ck[i][e]); sk += a * a + c * c; } }
        sq += __shfl_xor(sq, 1); sq += __shfl_xor(sq, 2); sq += __shfl_xor(sq, 4);
        sk += __shfl_xor(sk, 1); sk += __shfl_xor(sk, 2); sk += __shfl_xor(sk, 4);
        const float rq = rsqrtf(sq * (1.f / 256.f) + EPS), rk = rsqrtf(sk * (1.f / 128.f) + EPS);
        const float* gq = p.in[I_GQN] + l * 256 + sub * 32; const float* gk = p.in[I_GKVN] + l * 128 + sub * 16;
#pragma unroll
        for (int i = 0; i < 4; ++i) { u32x4 o;
#pragma unroll
            for (int e = 0; e < 4; ++e) o[e] = pk2(lo_bf(cq[i][e]) * rq * gq[i * 8 + 2 * e], hi_bf(cq[i][e]) * rq * gq[i * 8 + 2 * e + 1]);
            *(u32x4*)(aq + tk * 264 + sub * 32 + i * 8) = o; }
#pragma unroll
        for (int i = 0; i < 2; ++i) { u32x4 o;
#pragma unroll
            for (int e = 0; e < 4; ++e) o[e] = pk2(lo_bf(ck[i][e]) * rk * gk[i * 8 + 2 * e], hi_bf(ck[i][e]) * rk * gk[i * 8 + 2 * e + 1]);
            *(u32x4*)(akv + tk * 136 + sub * 16 + i * 8) = o; }
    }
    bf16_t* Qb = (bf16_t*)(p.ws + WS_QB); bf16_t* Kb = (bf16_t*)(p.ws + WS_KB); bf16_t* Vt = (bf16_t*)(p.ws + WS_VT);
    {
        const int tk = tid >> 3, i0 = (tid & 7) * 4, seg = i0 >> 4, half = (i0 >> 3) & 1, f0 = i0 & 7;
        const bf16_t* pr = proj + (size_t)(r0 + tk) * PW + C_KR;
        const u32x2 me = *(const u32x2*)(pr + i0), pa = *(const u32x2*)(pr + (i0 ^ 8));
        float mv[4] = {lo_bf(me.x), hi_bf(me.x), lo_bf(me.y), hi_bf(me.y)}, pv[4] = {lo_bf(pa.x), hi_bf(pa.x), lo_bf(pa.y), hi_bf(pa.y)}, ov[4];
#pragma unroll
        for (int j = 0; j < 4; ++j) {
            if (lat) { float cs, sn; rope_cs_tab(rt, tl0 + tk, seg, f0 + j, cs, sn); ov[j] = half ? (pv[j] * sn + mv[j] * cs) : (mv[j] * cs - pv[j] * sn); }
            else ov[j] = mv[j]; }
        u32x2 o; o.x = pk2(ov[0], ov[1]); o.y = pk2(ov[2], ov[3]);
#pragma unroll
        for (int hh = 0; hh < 4; ++hh) *(u32x2*)(Kb + ((size_t)(b * 4 + hh) * KEYS + key0 + tk) * 96 + 64 + i0) = o;
    }
    __syncthreads();
    const bf16_t* WuqT = (const bf16_t*)(p.ws + WS_WUQ); const bf16_t* WukvT = (const bf16_t*)(p.ws + WS_WUKV);
    const float qs = 0.10206207261596577f * 1.4426950408889634f;
    for (int ct = w; ct < 24; ct += 8) {
        f32x4 acc[4];
#pragma unroll
        for (int tt = 0; tt < 4; ++tt) acc[tt] = (f32x4){0.f, 0.f, 0.f, 0.f};
        bf16x8 wa[8];
#pragma unroll
        for (int ks = 0; ks < 8; ++ks) wa[ks] = *(const bf16x8*)(WuqT + (size_t)(16 * ct + fr) * 256 + 32 * ks + 8 * fq);
#pragma unroll
        for (int kh = 0; kh < 4; ++kh) { bf16x8 bb[2][4];
#pragma unroll
            for (int k2 = 0; k2 < 2; ++k2)
#pragma unroll
                for (int tt = 0; tt < 4; ++tt) bb[k2][tt] = *(const bf16x8*)(aq + (16 * tt + fr) * 264 + 32 * (2 * kh + k2) + 8 * fq);
            __builtin_amdgcn_sched_barrier(0);
#pragma unroll
            for (int k2 = 0; k2 < 2; ++k2)
#pragma unroll
                for (int tt = 0; tt < 4; ++tt) acc[tt] = MFMA16(wa[2 * kh + k2], bb[k2][tt], acc[tt]); }
        const int hq = ct / 6, dt = ct % 6;
#pragma unroll
        for (int tt = 0; tt < 4; ++tt) { const int tk = 16 * tt + fr; f32x4 v = acc[tt];
            if (dt >= 4 && lat) { const int seg = dt - 4, half = fq >> 1;
#pragma unroll
                for (int j = 0; j < 4; ++j) { const float pa = __shfl_xor(v[j], 32); float cs, sn; rope_cs_tab(rt, tl0 + tk, seg, 4 * (fq & 1) + j, cs, sn);
                    v[j] = half ? (pa * sn + v[j] * cs) : (v[j] * cs - pa * sn); } }
            u32x2 o; o.x = pk2(v[0] * qs, v[1] * qs); o.y = pk2(v[2] * qs, v[3] * qs);
            *(u32x2*)(Qb + ((size_t)(b * 4 + hq) * KEYS + key0 + tk) * 96 + 16 * dt + 4 * fq) = o; }
    }
    for (int ct = w; ct < 40; ct += 8) {
        const int hk = ct / 10, dt = ct % 10;
        f32x4 acc[4];
#pragma unroll
        for (int tt = 0; tt < 4; ++tt) acc[tt] = (f32x4){0.f, 0.f, 0.f, 0.f};
        bf16x8 wa[4];
#pragma unroll
        for (int ks = 0; ks < 4; ++ks) wa[ks] = *(const bf16x8*)(WukvT + (size_t)(16 * ct + fr) * 128 + 32 * ks + 8 * fq);
#pragma unroll
        for (int kh = 0; kh < 2; ++kh) { bf16x8 bb[2][4];
#pragma unroll
            for (int k2 = 0; k2 < 2; ++k2)
#pragma unroll
                for (int tt = 0; tt < 4; ++tt) bb[k2][tt] = *(const bf16x8*)(akv + (16 * tt + fr) * 136 + 32 * (2 * kh + k2) + 8 * fq);
            __builtin_amdgcn_sched_barrier(0);
#pragma unroll
            for (int k2 = 0; k2 < 2; ++k2)
#pragma unroll
                for (int tt = 0; tt < 4; ++tt) acc[tt] = dt < 4 ? MFMA16(wa[2 * kh + k2], bb[k2][tt], acc[tt]) : MFMA16(bb[k2][tt], wa[2 * kh + k2], acc[tt]); }
#pragma unroll
        for (int tt = 0; tt < 4; ++tt) { const f32x4 v = acc[tt]; u32x2 o; o.x = pk2(v[0], v[1]); o.y = pk2(v[2], v[3]);
            if (dt < 4) *(u32x2*)(Kb + ((size_t)(b * 4 + hk) * KEYS + key0 + 16 * tt + fr) * 96 + 16 * dt + 4 * fq) = o;
            else *(u32x2*)(Vt + ((size_t)(b * 4 + hk) * 96 + 16 * (dt - 4) + fr) * KEYS + key0 + 32 * (tt >> 1) + 8 * fq + 4 * (tt & 1)) = o; }
    }
    __syncthreads();
}

template <int VAR>
__device__ __forceinline__ void attn_item(const KP& p, int item, unsigned char* shm) {
    const int tid = ltid(), w = tid >> 6, lane = tid & 63, fr = lane & 15, fq = lane >> 4;
    const int qb = item < 256 ? (item & 7) : 8, bh = item < 256 ? (item >> 3) : item - 256, b = bh >> 2, h = bh & 3;
    const int kbeg = qb < 8 ? 0 : SEQ, ntile = qb < 8 ? KEYS / 64 : CL / 64;
    const bf16_t* Qb = (const bf16_t*)(p.ws + WS_QB) + (size_t)bh * KEYS * 96;
    const bf16_t* Kb = (const bf16_t*)(p.ws + WS_KB) + (size_t)bh * KEYS * 96;
    const bf16_t* Vt = (const bf16_t*)(p.ws + WS_VT) + (size_t)bh * 96 * KEYS;
    const int q0 = qb * 256 + 32 * w;
    bf16x8 qf[2][3];
#pragma unroll
    for (int qt = 0; qt < 2; ++qt)
#pragma unroll
        for (int ks = 0; ks < 3; ++ks) qf[qt][ks] = *(const bf16x8*)(Qb + (size_t)(q0 + 16 * qt + fr) * 96 + 32 * ks + 8 * fq);
    f32x4 O[6][2];
#pragma unroll
    for (int dt = 0; dt < 6; ++dt) { O[dt][0] = (f32x4){0.f, 0.f, 0.f, 0.f}; O[dt][1] = (f32x4){0.f, 0.f, 0.f, 0.f}; }
    float mrow[2] = {-1e30f, -1e30f}, lrow[2] = {0.f, 0.f};
    u32x4 pre[6];
    constexpr int ABUF = (64 * 104 + 96 * 72) * 2;
    auto gload = [&](int kp) {
#pragma unroll
        for (int sub = 0; sub < 2; ++sub) { const int key0 = kbeg + (2 * kp + sub) * 64;
#pragma unroll
            for (int i = 0; i < 3; ++i) { const int c = tid + 512 * i;
                if (c < 768) pre[3 * sub + i] = *(const u32x4*)(Kb + (size_t)key0 * 96 + c * 8);
                else { const int cc = c - 768, dv = cc >> 3, part = cc & 7; pre[3 * sub + i] = *(const u32x4*)(Vt + (size_t)dv * KEYS + key0 + part * 8); } } }
    };
    auto lstore = [&](int buf) {
#pragma unroll
        for (int sub = 0; sub < 2; ++sub) { bf16_t* Kw = (bf16_t*)(shm + (2 * buf + sub) * ABUF); bf16_t* Vw = Kw + 64 * 104;
#pragma unroll
            for (int i = 0; i < 3; ++i) { const int c = tid + 512 * i;
                if (c < 768) { const int key = c / 12, part = c % 12; *(u32x4*)(Kw + key * 104 + part * 8) = pre[3 * sub + i]; }
                else { const int cc = c - 768, dv = cc >> 3, part = cc & 7; *(u32x4*)(Vw + dv * 72 + part * 8) = pre[3 * sub + i]; } } }
    };
    const int npair = ntile >> 1;
    gload(0);
    lstore(0);
    __syncthreads();
    if (npair > 1) gload(1);
    for (int kp = 0; kp < npair; ++kp) {
#pragma unroll
      for (int sub = 0; sub < 2; ++sub) {
        const bf16_t* Kc = (const bf16_t*)(shm + (2 * (kp & 1) + sub) * ABUF); const bf16_t* Vc = Kc + 64 * 104;
        bf16x8 kf[4][3];
#pragma unroll
        for (int kk = 0; kk < 4; ++kk)
#pragma unroll
            for (int ks = 0; ks < 3; ++ks) kf[kk][ks] = *(const bf16x8*)(Kc + (16 * kk + fr) * 104 + 32 * ks + 8 * fq);
        __builtin_amdgcn_sched_barrier(0);
        f32x4 S[4][2];
#pragma unroll
        for (int kk = 0; kk < 4; ++kk) { S[kk][0] = (f32x4){0.f, 0.f, 0.f, 0.f}; S[kk][1] = (f32x4){0.f, 0.f, 0.f, 0.f}; }
        bf16x8 P[2][2];
        auto softmax_qt = [&](const int qt) {
            float mx = S[0][qt][0];
#pragma unroll
            for (int kk = 0; kk < 4; ++kk)
#pragma unroll
                for (int j = 0; j < 4; ++j) mx = fmaxf(mx, S[kk][qt][j]);
            mx = max_over_fq(mx);
            if (__any(mx > mrow[qt] + 8.f)) {
                const float mnew = fmaxf(mrow[qt], mx), alpha = __builtin_amdgcn_exp2f(mrow[qt] - mnew); mrow[qt] = mnew;
                lrow[qt] *= alpha;
#pragma unroll
                for (int dt = 0; dt < 6; ++dt) O[dt][qt] *= alpha;
            }
            const float mn = mrow[qt];
            float ps = 0.f; unsigned pk[8];
#pragma unroll
            for (int kk = 0; kk < 4; ++kk) { const float e0 = __builtin_amdgcn_exp2f(S[kk][qt][0] - mn), e1 = __builtin_amdgcn_exp2f(S[kk][qt][1] - mn), e2 = __builtin_amdgcn_exp2f(S[kk][qt][2] - mn), e3 = __builtin_amdgcn_exp2f(S[kk][qt][3] - mn);
                ps += (e0 + e1) + (e2 + e3); pk[2 * kk] = pk2(e0, e1); pk[2 * kk + 1] = pk2(e2, e3); }
            lrow[qt] += ps;
            u32x4 t0 = {pk[0], pk[1], pk[2], pk[3]}, t1 = {pk[4], pk[5], pk[6], pk[7]};
            P[qt][0] = __builtin_bit_cast(bf16x8, t0); P[qt][1] = __builtin_bit_cast(bf16x8, t1);
        };
#pragma unroll
        for (int ks = 0; ks < 3; ++ks)
#pragma unroll
            for (int kk = 0; kk < 4; ++kk) S[kk][0] = MFMA16(kf[kk][ks], qf[0][ks], S[kk][0]);
        __builtin_amdgcn_sched_barrier(0);
#pragma unroll
        for (int ks = 0; ks < 3; ++ks)
#pragma unroll
            for (int kk = 0; kk < 4; ++kk) S[kk][1] = MFMA16(kf[kk][ks], qf[1][ks], S[kk][1]);
        softmax_qt(0);
        __builtin_amdgcn_sched_barrier(0);
        bf16x8 vf[6][2];
#pragma unroll
        for (int dt = 0; dt < 6; ++dt)
#pragma unroll
            for (int k2 = 0; k2 < 2; ++k2) vf[dt][k2] = *(const bf16x8*)(Vc + (16 * dt + fr) * 72 + 32 * k2 + 8 * fq);
        __builtin_amdgcn_sched_barrier(0);
#pragma unroll
        for (int dt = 0; dt < 6; ++dt)
#pragma unroll
            for (int k2 = 0; k2 < 2; ++k2) O[dt][0] = MFMA16(vf[dt][k2], P[0][k2], O[dt][0]);
        softmax_qt(1);
        __builtin_amdgcn_sched_barrier(0);
#pragma unroll
        for (int dt = 0; dt < 6; ++dt)
#pragma unroll
            for (int k2 = 0; k2 < 2; ++k2) O[dt][1] = MFMA16(vf[dt][k2], P[1][k2], O[dt][1]);
      }
        if (kp + 1 < npair) lstore((kp + 1) & 1);
        __syncthreads();
        if (kp + 2 < npair) gload(kp + 2);
    }
    bf16_t* mix = (bf16_t*)(p.ws + WS_MIX);
#pragma unroll
    for (int qt = 0; qt < 2; ++qt) { float lt = lrow[qt]; lt += __shfl_xor(lt, 16); lt += __shfl_xor(lt, 32); const float inv = 1.f / lt;
        const int q = q0 + 16 * qt + fr; const size_t row = q < SEQ ? (size_t)b * SEQ + q : (size_t)TL + b * CL + (q - SEQ);
#pragma unroll
        for (int dt = 0; dt < 6; ++dt) { const f32x4 v = O[dt][qt] * inv; u32x2 o; o.x = pk2(v[0], v[1]); o.y = pk2(v[2], v[3]);
            *(u32x2*)(mix + row * D + 640 + h * 96 + 16 * dt + 4 * fq) = o; } }
    __syncthreads();
}


#ifdef DIAG
__device__ __forceinline__ float block_max(float v, float* red) {
    const int tid = ltid();
#pragma unroll
    for (int o = 1; o < 64; o <<= 1) v = fmaxf(v, __shfl_xor(v, o));
    __syncthreads(); if ((tid & 63) == 0) red[tid >> 6] = v; __syncthreads();
    float r = red[0];
#pragma unroll
    for (int i = 1; i < 8; ++i) r = fmaxf(r, red[i]);
    __syncthreads(); return r;
}
__device__ __forceinline__ float block_sum(float v, float* red) {
    const int tid = ltid();
    v = wave_sum(v);
    __syncthreads(); if ((tid & 63) == 0) red[tid >> 6] = v; __syncthreads();
    float r = 0.f;
#pragma unroll
    for (int i = 0; i < 8; ++i) r += red[i];
    __syncthreads(); return r;
}
__device__ __forceinline__ float dg_conv(const KP& p, int l, int rbase, int slen, int t, int chg) {
    const bf16_t* proj = (const bf16_t*)(p.ws + WS_PROJ); float a = 0.f;
    for (int i = 0; i < 5; ++i) { const int tt = t - 2 + i; if (tt < 0 || tt >= slen) continue;
        a += bf2f(proj[(size_t)(rbase + tt) * PW + chg]) * p.in[I_CONV][(size_t)l * 5 * 768 + i * 768 + chg]; }
    return siluf(a);
}
__device__ __forceinline__ float diag_mlstm(const KP& p, int l, int b, int h, int tsel, unsigned char* shm) {
    const int tid = ltid();
    float* Ff = (float*)shm; float* Gb = Ff + 2304; float* If = Gb + 2304; float* Ib = If + 2304; float* Wf = Ib + 2304; float* Wb = Wf + 2304; float* qt = Wb + 2304; float* red = qt + 96; float* yr = red + 16;
    const float* gates = (const float*)(p.ws + WS_GATES); const float* bg = p.in[I_BG] + l * 16;
    const bf16_t* proj = (const bf16_t*)(p.ws + WS_PROJ);
    for (int pos = tid; pos < 2304; pos += 512) { const int row = pos < 256 ? TL + b * CL + pos : b * SEQ + (pos - 256); const float* gp = gates + (size_t)row * 16;
        const int pb = pos < 256 ? 2048 + pos : pos - 256;
        If[pos] = gp[h] + bg[h]; Ff[pos] = logsig(gp[4 + h] + bg[4 + h]); Ib[pb] = gp[8 + h] + bg[8 + h]; Gb[pb] = logsig(gp[12 + h] + bg[12 + h]); }
    __syncthreads();
    if (tid == 0) { float a = 0.f; for (int i = 0; i < 2304; ++i) { a += Ff[i]; Ff[i] = a; } a = 0.f; for (int i = 2303; i >= 0; --i) { a += Gb[i]; Gb[i] = a; } }
    if (tid < 96) qt[tid] = dg_conv(p, l, b * SEQ, SEQ, tsel, h * 96 + tid) * 0.10206207261596577f;
    __syncthreads();
    const int tf = 256 + tsel, tb = tsel;
    for (int pos = tid; pos < 2304; pos += 512) { const bool isc = pos < 256; const int rbase = isc ? TL + b * CL : b * SEQ, slen = isc ? CL : SEQ, t = isc ? pos : pos - 256;
        float dot = 0.f; for (int d = 0; d < 96; ++d) dot += qt[d] * dg_conv(p, l, rbase, slen, t, 384 + h * 96 + d);
        const int pb = isc ? 2048 + pos : pos - 256;
        Wf[pos] = pos <= tf ? dot * __expf(Ff[tf] - Ff[pos] + If[pos]) : 0.f;
        Wb[pos] = pb >= tb ? dot * __expf(Gb[tb] - Gb[pb] + Ib[pb]) : 0.f; }
    __syncthreads();
    float hv = 0.f;
    if (tid < 96) { float nf = 0.f, nb = 0.f, df = 0.f, db = 0.f;
        for (int pos = 0; pos < 2304; ++pos) { const int row = pos < 256 ? TL + b * CL + pos : b * SEQ + (pos - 256); const float v = bf2f(proj[(size_t)row * PW + C_MV + h * 96 + tid]);
            nf += Wf[pos] * v; nb += Wb[pos] * v; df += Wf[pos]; db += Wb[pos]; }
        hv = nf / fmaxf(fabsf(df), 1.f) + nb / fmaxf(fabsf(db), 1.f); }
    const float ss = block_sum(tid < 96 ? hv * hv : 0.f, red);
    float diff = 0.f;
    if (tid < 96) { const int row = b * SEQ + tsel; const float mo = bf2f(proj[(size_t)row * PW + C_MO + h * 96 + tid]);
        const float y = hv * rsqrtf(ss * (1.f / 96.f) + EPS) * p.in[I_GM][l * 384 + h * 96 + tid] / (1.f + __expf(-mo));
        const float yf = bf2f(((const bf16_t*)(p.ws + WS_MIX))[(size_t)row * D + 256 + h * 96 + tid]);
        diff = fabsf(y - yf); }
    return block_max(diff, red);
}
__device__ __forceinline__ float diag_attn(const KP& p, int l, int b, int h, int qsel, unsigned char* shm) {
    const int tid = ltid();
    float* sc = (float*)shm; float* qv = sc + 2304; float* red = qv + 96; float* nq = red + 16;
    float* Vs = (float*)(p.ws + WS_HID + 100000000);
    const bf16_t* proj = (const bf16_t*)(p.ws + WS_PROJ);
    const float* wuq = p.in[I_WUQ] + (size_t)l * 256 * 384; const float* wukv = p.in[I_WUKV] + (size_t)l * 128 * 640;
    const int qrow = b * SEQ + qsel;
    { float v = tid < 256 ? bf2f(proj[(size_t)qrow * PW + C_CQ + tid]) : 0.f; const float ss = block_sum(v * v, red);
      if (tid < 256) nq[tid] = v * rsqrtf(ss * (1.f / 256.f) + EPS) * p.in[I_GQN][l * 256 + tid]; }
    __syncthreads();
    if (tid < 96) { float a = 0.f; for (int k = 0; k < 256; ++k) a += nq[k] * wuq[(size_t)k * 384 + h * 96 + tid]; qv[tid] = a; }
    __syncthreads();
    if (tid < 16) {
        const int seg = tid >> 3, f = tid & 7; float cs, sn; rope_cs(qsel, seg, f, cs, sn);
        const float x1 = qv[64 + seg * 16 + f], x2 = qv[64 + seg * 16 + 8 + f]; qv[64 + seg * 16 + f] = x1 * cs - x2 * sn; qv[64 + seg * 16 + 8 + f] = x1 * sn + x2 * cs; }
    __syncthreads();
    for (int key = tid; key < 2304; key += 512) { const bool lat = key < SEQ; const int row = lat ? b * SEQ + key : TL + b * CL + (key - SEQ);
        const bf16_t* pr = proj + (size_t)row * PW;
        float ss = 0.f; for (int k = 0; k < 128; ++k) { const float v = bf2f(pr[C_CKV + k]); ss += v * v; }
        const float rk = rsqrtf(ss * (1.f / 128.f) + EPS);
        float s = 0.f;
        for (int c = 0; c < 160; ++c) { float a = 0.f; for (int k = 0; k < 128; ++k) a += bf2f(pr[C_CKV + k]) * rk * p.in[I_GKVN][l * 128 + k] * wukv[(size_t)k * 640 + h * 160 + c];
            if (c < 64) s += qv[c] * a; else Vs[(size_t)key * 96 + (c - 64)] = a; }
        for (int seg = 0; seg < 2; ++seg) for (int f = 0; f < 8; ++f) { float x1 = bf2f(pr[C_KR + seg * 16 + f]), x2 = bf2f(pr[C_KR + seg * 16 + 8 + f]);
            if (lat) { float cs, sn; rope_cs(key, seg, f, cs, sn); const float o1 = x1 * cs - x2 * sn, o2 = x1 * sn + x2 * cs; x1 = o1; x2 = o2; }
            s += qv[64 + seg * 16 + f] * x1 + qv[64 + seg * 16 + 8 + f] * x2; }
        sc[key] = s * 0.10206207261596577f; }
    __syncthreads();
    float mx = -1e30f; for (int key = tid; key < 2304; key += 512) mx = fmaxf(mx, sc[key]); mx = block_max(mx, red);
    float sm = 0.f; for (int key = tid; key < 2304; key += 512) { const float e = __expf(sc[key] - mx); sc[key] = e; sm += e; } sm = block_sum(sm, red);
    __threadfence(); __syncthreads();
    float diff = 0.f;
    if (tid < 96) { float a = 0.f; for (int key = 0; key < 2304; ++key) a += sc[key] * Vs[(size_t)key * 96 + tid]; a /= sm;
        const float yf = bf2f(((const bf16_t*)(p.ws + WS_MIX))[(size_t)qrow * D + 640 + h * 96 + tid]); diff = fabsf(a - yf); }
    return block_max(diff, red);
}

__device__ __forceinline__ float diag_fourier(const KP& p, int b, int g, unsigned char* shm) {
    const int tid = ltid();
    float* hrow = (float*)shm; float* red = hrow + 1024;
    float* pf = (float*)(p.ws + WS_HID + 100000000);
    const float* mod = (const float*)(p.ws + WS_MOD) + (size_t)b * 6144;
    for (int n = 0; n < 2048; ++n) {
        const float* xr = p.in[I_X] + ((size_t)b * SEQ + n) * D;
        const float x0 = xr[tid], x1 = xr[tid + 512];
        const float ss = block_sum(x0 * x0 + x1 * x1, red); const float rstd = rsqrtf(ss * (1.f / D) + EPS);
        hrow[tid] = x0 * rstd * p.in[I_G1][tid] * (1.f + mod[1024 + tid]) + mod[tid];
        hrow[tid + 512] = x1 * rstd * p.in[I_G1][tid + 512] * (1.f + mod[1024 + tid + 512]) + mod[tid + 512];
        __syncthreads();
        { const int c = tid & 63, ks = tid >> 6; float a = 0.f;
          for (int k = ks * 128; k < ks * 128 + 128; ++k) a += hrow[k] * p.in[I_WIN][(size_t)k * 2224 + g * 64 + c];
          red[16 + ks * 64 + c] = a; }
        __syncthreads();
        if (tid < 64) { float a = 0.f; for (int q = 0; q < 8; ++q) a += red[16 + q * 64 + tid]; pf[n * 64 + tid] = a; }
        __syncthreads();
    }
    __threadfence(); __syncthreads();
    float worst = 0.f;
#pragma unroll 1
    for (int i = 0; i < 6; ++i) { const int k = i == 0 ? 0 : i == 1 ? 1 : i == 2 ? 5 : i == 3 ? 1000 : i == 4 ? 1024 : 2047;
        const int cp = tid & 63, ns = tid >> 6; float a = 0.f;
        for (int n = ns * 256; n < ns * 256 + 256; ++n) for (int c = 0; c < 64; ++c) { const int idx = (k * n + 32 * c * cp) & 2047; a += pf[n * 64 + c] * cospif((float)idx * (1.f / 1024.f)); }
        __syncthreads(); red[16 + ns * 64 + cp] = a; __syncthreads();
        float diff = 0.f;
        if (tid < 64) { float y = 0.f; for (int q = 0; q < 8; ++q) y += red[16 + q * 64 + tid]; y *= 0.00276213586400995f;
            const float yf = bf2f(((const bf16_t*)(p.ws + WS_MIX))[((size_t)b * SEQ + k) * D + g * 64 + tid]); diff = fabsf(y - yf); }
        worst = fmaxf(worst, block_max(diff, red));
    }
    return worst;
}

__device__ __forceinline__ int dg_row(int i) { return i == 0 ? 0 : i == 1 ? 1 : i == 2 ? 255 : i == 3 ? 256 : i == 4 ? 5000 : i == 5 ? 16383 : i == 6 ? 16384 : 18431; }
__device__ __forceinline__ float diag_g2(const KP& p, int i, unsigned char* shm) {
    const int tid = ltid(); float* red = (float*)shm;
    const int r = dg_row(i), b = r < TL ? r >> 11 : 8;
    const bf16_t* mr = (const bf16_t*)(p.ws + WS_MIX) + (size_t)r * D;
    const float* xo = r < TL ? p.in[I_X] + (size_t)r * D : p.in[I_CTX] + (size_t)(r - TL) * D;
    const float* xn = r < TL ? p.out + (size_t)r * D : (const float*)(p.ws + WS_XCTX) + (size_t)(r - TL) * D;
    const float* mod = (const float*)(p.ws + WS_MOD);
    float diff = 0.f;
    for (int c = tid; c < 1024; c += 512) { float a = 0.f; for (int j = 0; j < 1024; ++j) a += bf2f(mr[j]) * p.in[I_WOUT][(size_t)j * 1024 + c];
        diff = fmaxf(diff, fabsf(xo[c] + mod[(size_t)b * 6144 + 2048 + c] * a - xn[c])); }
#ifdef DIAG_MODONLY
    diff = 0.f;
#endif
#ifndef DIAG_G2ONLY
    { const int l = i & 1, j = (37 * tid + 11 * i) % 6144; float a = 0.f;
      for (int k = 0; k < 1024; ++k) { const float cv = b < 8 ? p.in[I_C][b * 1024 + k] : p.in[I_CCTX][k]; a += siluf(cv) * p.in[I_WMOD][(size_t)l * 1024 * 6144 + (size_t)k * 6144 + j]; }
      a += p.in[I_BMOD][l * 6144 + j]; diff = fmaxf(diff, fabsf(a - mod[(size_t)(l * 9 + b) * 6144 + j])); }
#endif
    return block_max(diff, red);
}
__device__ __forceinline__ float diag_g3(const KP& p, int i, unsigned char* shm) {
    const int tid = ltid(); float* red = (float*)shm; float* hr = red + 16;
    const int r = dg_row(i), b = r < TL ? r >> 11 : 8;
    const float* xr = r < TL ? p.out + (size_t)r * D : (const float*)(p.ws + WS_XCTX) + (size_t)(r - TL) * D;
    const float* mod = (const float*)(p.ws + WS_MOD) + (size_t)b * 6144;
    const bf16_t* hb = (const bf16_t*)(p.ws + WS_HBUF) + (size_t)r * D;
    const float x0 = xr[tid], x1 = xr[tid + 512];
    const float ss = block_sum(x0 * x0 + x1 * x1, red); const float rstd = rsqrtf(ss * (1.f / D) + EPS);
    float diff = 0.f;
    { const float h0 = x0 * rstd * p.in[I_G2][tid] * (1.f + mod[4096 + tid]) + mod[3072 + tid], h1 = x1 * rstd * p.in[I_G2][tid + 512] * (1.f + mod[4096 + tid + 512]) + mod[3072 + tid + 512];
      diff = fmaxf(fabsf(h0 - bf2f(hb[tid])), fabsf(h1 - bf2f(hb[tid + 512]))); hr[tid] = bf2f(hb[tid]); hr[tid + 512] = bf2f(hb[tid + 512]); }
    __syncthreads();
    const bf16_t* hid = (const bf16_t*)(p.ws + WS_HID) + (size_t)r * 4096;
    for (int j = tid; j < 4096; j += 512) { float a = 0.f; for (int k = 0; k < 1024; ++k) a += hr[k] * p.in[I_WUP][(size_t)k * 4096 + j];
        a = fmaxf(a, 0.f); a = a * a; diff = fmaxf(diff, fabsf(a - bf2f(hid[j])) / (1.f + fabsf(a))); }
    return block_max(diff, red);
}
#endif


#define XB_TMO      128
#define XB_XCNT(j)  (256  + 64 * (j))
#define XB_XSUB(j)  (1280 + 64 * (j))
#define XB_XGEN(j)  (2304 + 64 * (j))
#define XB_TOP      3328
#define XB_TOPGEN   3392
#define XCD_BAR_WORDS 3456
#define XB_SPIN_CAP (1u << 18)
#define LAS __attribute__((address_space(3)))
__device__ __forceinline__ unsigned xb_ld(unsigned* p)              { return __hip_atomic_load(p, __ATOMIC_RELAXED, __HIP_MEMORY_SCOPE_AGENT); }
__device__ __forceinline__ unsigned xb_add(unsigned* p, unsigned v) { return __hip_atomic_fetch_add(p, v, __ATOMIC_RELAXED, __HIP_MEMORY_SCOPE_AGENT); }
__device__ __forceinline__ unsigned xb_xcc_id() { return (unsigned)__builtin_amdgcn_s_getreg((3 << 11) | 20) & 0xFu; }
#define XB_SPIN(cond, bar) do { unsigned _sp = 0; while (cond) { __builtin_amdgcn_s_sleep(1); \
    if ((++_sp & 255u) == 0u) { if (xb_ld(&(bar)[XB_TMO])) break; if (_sp > XB_SPIN_CAP) { atomicAdd(&(bar)[XB_TMO], 1u); break; } } } } while (0)
struct XcdBarrier { unsigned* bar; unsigned x; volatile LAS unsigned* st; };
__device__ __forceinline__ XcdBarrier xcd_barrier_post(unsigned* bar, volatile LAS unsigned* st) {
    XcdBarrier b; b.bar = bar; b.x = xb_xcc_id(); b.st = st;
    if (threadIdx.x == 0) (void)xb_add(&bar[XB_XCNT(b.x)], 1u);
    return b;
}
__device__ __forceinline__ void xcd_barrier_complete(unsigned* bar, unsigned x, unsigned& nloc, unsigned& nx) {
    const unsigned G = gridDim.x * gridDim.y * gridDim.z;
    unsigned sum, cnt, mine, sp = 0u;
    for (;;) {
        sum = 0u; cnt = 0u; mine = 0u;
#pragma unroll
        for (unsigned j = 0; j < 16; ++j) { const unsigned c = xb_ld(&bar[XB_XCNT(j)]); sum += c; cnt += (c > 0u) ? 1u : 0u; mine = (j == x) ? c : mine; }
        if (sum == G) break;
        __builtin_amdgcn_s_sleep(1);
        if ((++sp & 255u) == 0u) { if (xb_ld(&bar[XB_TMO])) break; if (sp > XB_SPIN_CAP) { atomicAdd(&bar[XB_TMO], 1u); break; } }
    }
    nloc = mine > 0u ? mine : 1u; nx = cnt > 0u ? cnt : 1u;
}
__device__ __forceinline__ void xcd_barrier(const XcdBarrier& b) {
    asm volatile("s_waitcnt vmcnt(0)" ::: "memory");
    __syncthreads();
    if (threadIdx.x == 0) {
        unsigned* bar = b.bar;
        __builtin_amdgcn_s_waitcnt(0);
        unsigned nloc = b.st[0], nx = b.st[1];
        if (nloc == 0u) { xcd_barrier_complete(bar, b.x, nloc, nx); b.st[0] = nloc; b.st[1] = nx; }
        const unsigned old = xb_add(&bar[XB_XSUB(b.x)], 1u);
        const unsigned gen = old / nloc;
        if (old + 1u == (gen + 1u) * nloc) {
            __builtin_amdgcn_fence(__ATOMIC_RELEASE, "agent");
            asm volatile("s_waitcnt vmcnt(0)" ::: "memory");
            const unsigned og = xb_add(&bar[XB_TOP], 1u);
            const unsigned tg = og / nx;
            if (og + 1u == (tg + 1u) * nx) xb_add(&bar[XB_TOPGEN], 1u);
            else XB_SPIN(xb_ld(&bar[XB_TOPGEN]) == tg, bar);
            __builtin_amdgcn_fence(__ATOMIC_ACQUIRE, "agent");
            xb_add(&bar[XB_XGEN(b.x)], 1u);
            asm volatile("s_waitcnt vmcnt(0)" ::: "memory");
        } else {
            XB_SPIN(xb_ld(&bar[XB_XGEN(b.x)]) == gen, bar);
            __builtin_amdgcn_fence(__ATOMIC_ACQUIRE, "agent");
            asm volatile("s_waitcnt vmcnt(0)" ::: "memory");
        }
    }
    __syncthreads();
}

__device__ __attribute__((noinline)) void grid_sync_fn() { cg::this_grid().sync(); }
__global__ __launch_bounds__(512, 2) void mega(KP p) {
    extern __shared__ __attribute__((aligned(16))) unsigned char shm[];
    volatile LAS unsigned* xst = (volatile LAS unsigned*)(LAS unsigned char*)(shm + LDS_BYTES - 16);
    if (threadIdx.x == 0) { xst[0] = 0u; xst[1] = 0u; }
    __syncthreads();
    if (p.ph_lo < 0) grid_sync_fn();
    const XcdBarrier xbar = xcd_barrier_post((unsigned*)(p.ws + WS_BAR), xst);
    for (int s = p.ph_lo; s < p.ph_hi; ++s) {
      if (s == 16) continue;
      const int nrep = (s >= 1 && s < 19 && ((REPMASK >> ((s - 1) % 9)) & 1)) ? 2 : 1;
      for (int rep = 0; rep < nrep; ++rep) {
        const int G = gridDim.x, bid = lbid();
        unsigned char* ws = p.ws; asm volatile("" : "+s"(ws));
        float* outp = p.out; asm volatile("" : "+s"(outp));
        if (s == 0) { if (PHMASK & 512) step_prep0(p, shm);
#ifdef REP_PREP
            xcd_barrier(xbar); step_prep0(p, shm);
#endif
        }
        else if (s == 19) { if (PHMASK & 1024) step_final(p); }
        else {
            const int l = (s - 1) / 9, ph = (s - 1) % 9; const bool last = l == 1;
            const float* modl = (const float*)(ws + WS_MOD) + (size_t)l * 9 * 6144;
            const float* xl = l == 0 ? p.in[I_X] : outp; const float* xc = l == 0 ? p.in[I_CTX] : (const float*)(ws + WS_XCTX);
            const int Mrows = last ? TL : TT;
            if (ph == 0) {
                if (PHMASK & 1) {
                if (l == 1) { float* tab = (float*)shm; prep_weights(p, 1, shm, tab, 2); }
                norm_rows(xl, xc, TT, p.in[I_G1] + l * D, modl, 0, 1024, (bf16_t*)(ws + WS_HBUF), l == 1 ? (const bf16_t*)(ws + WS_PART) : nullptr, (const float*)(ws + WS_MOD) + 8 * 6144 + 5120, nullptr, l == 1 ? TL : 0); }
            } else if (ph == 1) {
                if (PHMASK & 2) {
                EpiIn E; E.proj = (bf16_t*)(ws + WS_PROJ); E.gates = (float*)(ws + WS_GATES); E.zt = (bf16_t*)(ws + WS_ZT); E.ztc = (bf16_t*)(ws + WS_ZTC);
                run_gemm(shm, (const bf16_t*)(ws + WS_HBUF), (const bf16_t*)(ws + WS_WIN), TT, NIN, 1024, G, bid, E); }
            } else if (ph == 2) {
                if (PHMASK & 4) {
                    for (int it = bid; it < 32 * NCH + TT / 64; it += G) { if (it < 32 * NCH) mlstm_a_item(p, l, it, shm); else qkv_item(p, l, it - 32 * NCH, shm); }
                    {
                        const int nlong = (32 * NCH + TT / 64) % G, f0 = bid >= nlong ? bid - nlong : -1, fs = G - nlong;
                        if (f0 >= 0) for (int f = f0; f < 256; f += fs) zt_fold_item(p, f, shm);
                        __syncthreads(); }
                }
            } else if (ph == 3 || ph == 4) {
                if (PHMASK & 8) {
                const int nF = 64;
                if (ph == 3) mlstm_scan(p);
                {
                    int a0, a1, ast;
                    if (ph == 3) { a0 = bid; a1 = 256; ast = G; } else { a0 = (!last && bid >= nF + 8) ? 256 + (bid - nF - 8) : (1 << 30); a1 = 288; ast = G - nF - 8; }
                    for (int it = a0; it < a1; it += ast) {
                        const int item = it < 256 ? (((it & 7) * 4 + (it >> 6)) << 3) + ((it >> 3) & 7) : it;
                        attn_item<0>(p, item, shm); } }
                if (ph == 4) {
                if (bid < nF) {
                    for (int pass = 0; pass < (last ? 1 : 2); ++pass) {
                        const bool fl = pass == 0;
                        if (!fl && bid >= 8) break;
                        EpiFou E; E.mix = (bf16_t*)(ws + WS_MIX); E.rows_per_b = fl ? SEQ : CL; E.row_off = fl ? 0 : TL; E.scale = fl ? 0.00276213586400995f : 0.0078125f;
                        run_gemm(shm, (const bf16_t*)(ws + (fl ? WS_FDFT : WS_FDFTC)), (const bf16_t*)(ws + (fl ? WS_ZTF : WS_ZTC)), fl ? 2048 : 256, 2048, fl ? 2048 : 512, G, bid, E);
                    }
                } else {
                    const int vb = bid - nF, nb = G - nF, per = last ? 16 : NCH, nit = 32 * per;
                    for (int it = vb; it < nit; it += nb) { const int bh = it / per, jc = (last ? 2 : 0) + it % per; mlstm_c_item(p, l, bh >> 2, bh & 3, jc, shm); }
                } } }
            } else if (ph == 6) {
                if (PHMASK & 64) norm_rows(outp, l == 0 ? p.in[I_CTX] : (const float*)(ws + WS_XCTX), Mrows, p.in[I_G2] + l * D, modl, 3072, 4096, (bf16_t*)(ws + WS_HBUF),
                                           l == 0 ? (const bf16_t*)(ws + WS_PART) : nullptr, modl + 8 * 6144 + 2048, (float*)(ws + WS_XCTX), TL);
            } else if (ph == 7) {
                if (PHMASK & 128) {
                EpiUp E; E.hid = (bf16_t*)(ws + WS_HID);
                run_gemm(shm, (const bf16_t*)(ws + WS_HBUF), (const bf16_t*)(ws + WS_WUP), Mrows, 4096, 1024, G, bid, E); }
            } else {
                if (PHMASK & 32) {
                const bool g2 = ph == 5;
                {
                    const float* mod1 = (const float*)(ws + WS_MOD) + (size_t)9 * 6144;
                    EpiResNorm E; E.xo = g2 ? xl : outp; E.xn = outp; E.ga = modl + (g2 ? 2048 : 5120);
                    E.rss = (float*)(ws + WS_RSS) + (size_t)(2 * l + (g2 ? 0 : 1)) * TL; E.cnt = (unsigned*)(ws + WS_RCNT) + (2 * l + (g2 ? 0 : 1)) * 64 * 64;
                    E.mode = (!g2 && last) ? 1 : 0;
                    E.g = g2 ? p.in[I_G2] + l * D : (last ? p.in[I_GFIN] : p.in[I_G1] + D);
                    E.sc = g2 ? modl + 4096 : mod1 + 1024; E.sh = g2 ? modl + 3072 : mod1; E.hb = (bf16_t*)(ws + WS_HBUF);
                    pg8::Gemm gm; gm.A = (const bf16_t*)(ws + (g2 ? WS_MIX : WS_HID)); gm.Bt = (const bf16_t*)(ws + (g2 ? WS_WOUT : WS_WDOWN)); gm.M = TL; gm.N = 1024; gm.K = g2 ? 1024 : 4096; gm.ld = gm.K;
                    pg8::StaticOrder S; S.init(TL, 1024, G, bid);
                    pg8::gemm_phase<EpiResNorm, pg8::StaticOrder, false>((PG8_LAS unsigned char*)shm, gm, S, E, nullptr); }
                if (!last && !g2 && bid >= 128) { float* tab = (float*)shm; build_costab(tab); prep_weights(p, 1, shm, tab, 1, 128, G - 128); }
                if (!last) for (int su = bid; su < 128; su += G) {
                    const int ks = su >> 5, ui = su & 31, ld = g2 ? 1024 : 4096, Ks = ld >> 2;
                    EpiPart E; E.part = (bf16_t*)(ws + WS_PART) + (size_t)ks * TC * D;
                    run_gemm_ctx_split(shm, (const bf16_t*)(ws + (g2 ? WS_MIX : WS_HID)) + (size_t)TL * ld + ks * Ks, (const bf16_t*)(ws + (g2 ? WS_WOUT : WS_WDOWN)) + ks * Ks, Ks, ld, ui >> 2, ui & 3, E); }
                }
            }
        }
        if (s + 1 < p.ph_hi || rep + 1 < nrep) xcd_barrier(xbar);
      }
    }
#ifdef EXTRA_SYNCS
    for (int i = 0; i < EXTRA_SYNCS; ++i) xcd_barrier(xbar);
#endif
#ifdef DIAG
    grid_sync_fn();
    if (blockIdx.x == 0) {
        float worst = 0.f;
#pragma unroll 1
        for (int i = 0; i < 8; ++i) {
            const int tk = i == 0 ? 0 : i == 1 ? 1 : i == 2 ? 127 : i == 3 ? 128 : i == 4 ? 129 : i == 5 ? 1000 : i == 6 ? 2046 : 2047;
#if DIAG == 1
            const float d = diag_mlstm(p, 0, 3, 2, tk, shm);
#elif DIAG == 2
            const float d = diag_attn(p, 0, 3, 2, tk, shm);
#elif DIAG == 3
            const float d = i == 0 ? diag_fourier(p, 3, 2, shm) : 0.f;
#elif DIAG == 4
            const float d = fmaxf(diag_mlstm(p, 1, 5, 1, tk, shm), diag_attn(p, 1, 5, 1, tk, shm));
#elif DIAG == 5
            const float d = diag_g2(p, i, shm);
#else
            const float d = diag_g3(p, i, shm);
#endif
#ifdef DIAG_TOK
            if (i == DIAG_TOK) worst = d;
#else
            worst = fmaxf(worst, d);
#endif
        }
        if (threadIdx.x == 0) p.out[0] = 1e4f * worst;
    }
#endif
}

extern "C" void kernel_launch(void* const* d_in, const int* in_sizes, int n_in, void* d_out, int out_size, void* d_ws, size_t ws_size, hipStream_t stream) {
    static int grid_blocks = 0;
    if (grid_blocks == 0) {
        if (n_in != 20 || ws_size < WS_NEED) { fprintf(stderr, "kernel_launch: unexpected inputs (n_in %d, ws %zu, need %zu)\n", n_in, ws_size, (size_t)WS_NEED); grid_blocks = -1; return; }
        int dev = 0, cus = 0, per_cu = 0;
        hipGetDevice(&dev);
        hipDeviceGetAttribute(&cus, hipDeviceAttributeMultiprocessorCount, dev);
        hipFuncSetAttribute((const void*)mega, hipFuncAttributeMaxDynamicSharedMemorySize, LDS_BYTES);
        hipOccupancyMaxActiveBlocksPerMultiprocessor(&per_cu, (const void*)mega, 512, LDS_BYTES);
        if (per_cu < 1) per_cu = 1;
        grid_blocks = cus * per_cu;
        if (grid_blocks != 256) { fprintf(stderr, "kernel_launch: this build needs exactly 256 resident workgroups (got %d)\n", grid_blocks); grid_blocks = -1; (void)hipGetLastError(); return; }
        (void)hipGetLastError();
    }
    if (grid_blocks < 0) return;
    KP p{};
    for (int i = 0; i < 20; ++i) p.in[i] = (const float*)d_in[i];
    p.out = (float*)d_out; p.ws = (unsigned char*)d_ws; p.ph_lo = 0; p.ph_hi = 19;
#ifdef DIAG
    p.ph_hi = DIAG == 4 ? 15 : DIAG == 5 ? 7 : DIAG == 6 ? 9 : 6;
#endif
    (void)hipMemsetAsync((unsigned char*)d_ws + WS_BAR, 0, 16384, stream);
    void* args[] = {&p};
    hipError_t e = hipLaunchCooperativeKernel((const void*)mega, dim3(grid_blocks), dim3(512), args, LDS_BYTES, stream);
    if (e != hipSuccess) fprintf(stderr, "cooperative launch failed: %s (grid %d)\n", hipGetErrorString(e), grid_blocks);
}
```

```cpp
#include <hip/hip_runtime.h>
#include <hip/hip_cooperative_groups.h>
#include <cstdio>
namespace cg = cooperative_groups;
namespace pg8 {
#define PG8_LAS __attribute__((address_space(3)))
typedef unsigned short bf16_t;
typedef short bf16x8 __attribute__((ext_vector_type(8)));
typedef float f32x4 __attribute__((ext_vector_type(4)));
typedef unsigned u32x4 __attribute__((ext_vector_type(4)));
constexpr int BM = 256, BK = 64, HALF = 128, HTB = HALF * BK * 2  , STAGE_BYTES = 8 * HTB, NXCD = 8, WGM = 8;

__host__ __device__ __forceinline__ int lds_byte(int r, int c) { const int st = (r >> 4) * 2 + (c >> 5), rr = r & 15, cc = c & 31, ob = rr * 64 + cc * 2; return st * 1024 + (ob ^ (((ob >> 9) & 1) << 5)); }
__host__ __device__ __forceinline__ void stage_rc(int b, int& R, int& C) { const int st = b / 1024, sb = b % 1024, swz = sb ^ (((sb >> 9) & 1) << 5); R = (st >> 1) * 16 + swz / 64; C = (st & 1) * 32 + (swz % 64) / 2; }
__host__ __device__ __forceinline__ int perm32(int rho) { const int n = rho >> 4, i = rho & 15; return 8 * (i >> 2) + 4 * n + (i & 3); }

struct Unit { int pm, pn; };
struct Gemm { const bf16_t* A; const bf16_t* Bt; int M, N, K, ld; };

struct StaticOrder {
    int nM, nN, nwg, G, c;
    __host__ __device__ void init(int M, int N, int G_, int c_) { nM = M / BM; nN = N / BM; nwg = nM * nN; G = G_; c = c_; }
    __host__ __device__ bool next(int i, Unit& u) const {
        const long L = (long)i * G + c; if (L >= nwg) return false;
        int wgid = (int)L; { const int q = nwg / NXCD, r = nwg % NXCD, xcd = wgid % NXCD, off = wgid / NXCD; wgid = (xcd < r ? xcd * (q + 1) : r * (q + 1) + (xcd - r) * q) + off; }
        const int nig = WGM * nN, gid = wgid / nig, fm = gid * WGM, gsz = (nM - fm) < WGM ? (nM - fm) : WGM;
        u.pm = fm + ((wgid % nig) % gsz); u.pn = (wgid % nig) / gsz; return true;
    }
    __device__ __forceinline__ void a_ready(const Unit&) const {}
    __device__ __forceinline__ void done(const Unit&) const {}
};
__device__ __forceinline__ unsigned cvt_pk_bf16(float lo, float hi) { unsigned r; asm volatile("v_cvt_pk_bf16_f32 %0, %1, %2" : "=v"(r) : "v"(lo), "v"(hi)); return r; }
template <class Epi, class Sched, bool STAMP = false>
__device__ __forceinline__ void gemm_phase(PG8_LAS unsigned char* lds, const Gemm g, const Sched& S, const Epi& E, unsigned long long* stamps) {
    int tid_l = threadIdx.x; asm volatile("" : "+v"(tid_l)); const int tid = tid_l, wid = __builtin_amdgcn_readfirstlane(tid >> 6), lane = tid & 63, wr = wid >> 2, wc = wid & 3, fr = lane & 15, fq = lane >> 4;
    const int K = g.K, nt = K / BK, LD = g.ld;
    int ts_lo = 0, ts_hi = 0, nts = 0; const unsigned long long rt_entry = STAMP ? (unsigned long long)wall_clock64() : 0ull;
#define PG8_STAMP() do { if (STAMP && wid == 0 && nts < 64) { const unsigned long long _c = (unsigned long long)clock64(); \
        ts_lo = (lane == nts) ? (int)(unsigned)_c : ts_lo; ts_hi = (lane == nts) ? (int)(unsigned)(_c >> 32) : ts_hi; ++nts; } } while (0)
    PG8_STAMP();
    unsigned voffA[2], voffB[2];
#pragma unroll
    for (int i = 0; i < 2; ++i) { int R, C; stage_rc(tid * 16 + i * 8192, R, C); const int Rb = Epi::PERM ? ((R & ~31) + perm32(R & 31)) : R;
        voffA[i] = (unsigned)(R * LD + C) * 2u; voffB[i] = (unsigned)(Rb * LD + C) * 2u; }
    const size_t kstep = (size_t)(BK * 2);
    const size_t hstep = (size_t)HALF * LD * 2;
    const size_t tstep = 2 * hstep;
    const unsigned ldsw = (unsigned)wid * 1024u;
    const int aoff = lds_byte(wr * 64 + fr, fq * 8), boff = lds_byte(wc * 32 + fr, fq * 8);
#define PG8_SA(b, h) (((b) * 2 + (h)) * HTB)
#define PG8_SB(b, h) ((4 + (b) * 2 + (h)) * HTB)
#define PG8_STAGE(bufoff, gbase, voff) do { _Pragma("unroll") for (int _i = 0; _i < 2; ++_i) \
        __builtin_amdgcn_global_load_lds((const unsigned*)((const char*)(gbase) + (voff)[_i]), (PG8_LAS unsigned*)(lds + (bufoff) + ldsw + _i * 8192), 16, 0, 0); } while (0)
#define PG8_LDA(dst, b, h) do { _Pragma("unroll") for (int m = 0; m < 4; ++m) _Pragma("unroll") for (int k = 0; k < 2; ++k) dst[m][k] = *(const PG8_LAS bf16x8*)(lds + PG8_SA(b, h) + aoff + m * 2048 + k * 1024); } while (0)
#define PG8_LDB(dst, b, h) do { _Pragma("unroll") for (int n = 0; n < 2; ++n) _Pragma("unroll") for (int k = 0; k < 2; ++k) dst[n][k] = *(const PG8_LAS bf16x8*)(lds + PG8_SB(b, h) + boff + n * 2048 + k * 1024); } while (0)
#define PG8_MMA(ai, bj, At, Bt) do { __builtin_amdgcn_s_setprio(1); _Pragma("unroll") for (int m = 0; m < 4; ++m) _Pragma("unroll") for (int n = 0; n < 2; ++n) _Pragma("unroll") for (int k = 0; k < 2; ++k) \
        acc[ai][bj][m][n] = __builtin_amdgcn_mfma_f32_16x16x32_bf16(Bt[n][k], At[m][k], acc[ai][bj][m][n], 0, 0, 0); __builtin_amdgcn_s_setprio(0); } while (0)
#define PG8_WAIT_V(n) asm volatile("s_waitcnt vmcnt(" #n ")" ::: "memory")
#define PG8_WAIT_L(n) asm volatile("s_waitcnt lgkmcnt(" #n ")" ::: "memory")
#define PG8_BAR __builtin_amdgcn_s_barrier()
#define PG8_SCHED __builtin_amdgcn_sched_barrier(0)
    Unit cur, nxt; int ui = 0;
    if (!S.next(0, cur)) return;
    f32x4 acc[2][2][4][2];
#pragma unroll
    for (int a = 0; a < 2; ++a)
#pragma unroll
        for (int b = 0; b < 2; ++b)
#pragma unroll
            for (int m = 0; m < 4; ++m)
#pragma unroll
                for (int n = 0; n < 2; ++n) acc[a][b][m][n] = (f32x4){0.f, 0.f, 0.f, 0.f};
    bf16x8 At[4][2], B0[2][2], B1[2][2];
    const char* cA = (const char*)g.A + (size_t)cur.pm * tstep; const char* cB = (const char*)g.Bt + (size_t)cur.pn * tstep;
    S.a_ready(cur);
    PG8_STAGE(PG8_SB(0, 0), cB, voffB); PG8_STAGE(PG8_SA(0, 0), cA, voffA); PG8_STAGE(PG8_SB(0, 1), cB + hstep, voffB); PG8_STAGE(PG8_SA(0, 1), cA + hstep, voffA);
    if (wr == 1) PG8_BAR;
    PG8_WAIT_V(4); PG8_BAR;
    PG8_STAGE(PG8_SB(1, 0), cB + kstep, voffB); PG8_STAGE(PG8_SA(1, 0), cA + kstep, voffA); PG8_STAGE(PG8_SB(1, 1), cB + hstep + kstep, voffB);
    PG8_WAIT_V(6); PG8_BAR;
    PG8_STAMP();
    for (;;) {
        const bool has_next = S.next(ui + 1, nxt);
        const char* nA = has_next ? (const char*)g.A + (size_t)nxt.pm * tstep : cA; const char* nB = has_next ? (const char*)g.Bt + (size_t)nxt.pn * tstep : cB;
        for (int t = 0; t < nt; t += 2) {
            const bool last = (t == nt - 2);
            const char* a1 = cA + (size_t)(t + 1) * kstep;
            const char* a2 = last ? nA : cA + (size_t)(t + 2) * kstep; const char* b2 = last ? nB : cB + (size_t)(t + 2) * kstep;
            const char* a3 = a2 + kstep; const char* b3 = b2 + kstep;
            if (last && has_next) S.a_ready(nxt);
            PG8_LDB(B0, 0, 0); PG8_SCHED; PG8_LDA(At, 0, 0); PG8_STAGE(PG8_SA(1, 1), a1 + hstep, voffA);
            PG8_WAIT_L(8); PG8_BAR; PG8_WAIT_L(0); PG8_MMA(0, 0, At, B0); PG8_BAR; PG8_SCHED;
            PG8_LDB(B1, 0, 1); PG8_STAGE(PG8_SB(0, 0), b2, voffB);
            PG8_BAR; PG8_WAIT_L(0); PG8_MMA(0, 1, At, B1); PG8_BAR;
            PG8_LDA(At, 0, 1); PG8_STAGE(PG8_SA(0, 0), a2, voffA);
            PG8_BAR; PG8_WAIT_L(0); PG8_MMA(1, 0, At, B0); PG8_BAR; PG8_SCHED;
            PG8_STAGE(PG8_SB(0, 1), b2 + hstep, voffB);
            PG8_WAIT_V(6); PG8_BAR; PG8_MMA(1, 1, At, B1); PG8_BAR;
            PG8_LDB(B0, 1, 0); PG8_SCHED; PG8_LDA(At, 1, 0); PG8_STAGE(PG8_SA(0, 1), a2 + hstep, voffA);
            PG8_WAIT_L(8); PG8_BAR; PG8_WAIT_L(0); PG8_MMA(0, 0, At, B0); PG8_BAR; PG8_SCHED;
            PG8_LDB(B1, 1, 1); PG8_STAGE(PG8_SB(1, 0), b3, voffB);
            PG8_BAR; PG8_WAIT_L(0); PG8_MMA(0, 1, At, B1); PG8_BAR;
            PG8_LDA(At, 1, 1); PG8_STAGE(PG8_SA(1, 0), a3, voffA);
            PG8_BAR; PG8_WAIT_L(0); PG8_MMA(1, 0, At, B0); PG8_BAR; PG8_SCHED;
            PG8_STAGE(PG8_SB(1, 1), b3 + hstep, voffB);
            PG8_WAIT_V(6); PG8_BAR; PG8_MMA(1, 1, At, B1); PG8_BAR;
        }
        PG8_STAMP();
        if constexpr (!Epi::AFTER_DRAIN) { E(acc, cur, wr, wc, fr, fq); S.done(cur); }
        PG8_STAMP();
        if (!has_next) break;
#pragma unroll
        for (int a = 0; a < 2; ++a)
#pragma unroll
            for (int b = 0; b < 2; ++b)
#pragma unroll
                for (int m = 0; m < 4; ++m)
#pragma unroll
                    for (int n = 0; n < 2; ++n) acc[a][b][m][n] = (f32x4){0.f, 0.f, 0.f, 0.f};
        cur = nxt; cA = nA; cB = nB; ++ui;
    }
    PG8_WAIT_V(0);
    if (wr == 0) PG8_BAR;
    PG8_BAR;
    if constexpr (Epi::AFTER_DRAIN) { E.fused(acc, cur, wr, wc, fr, fq, lds, wid, lane); S.done(cur); }
    PG8_STAMP();
    if (STAMP && wid == 0) { stamps[lane] = lane < nts ? (((unsigned long long)(unsigned)ts_hi << 32) | (unsigned)ts_lo) : 0ull;
        if (lane == 62) stamps[62] = rt_entry; if (lane == 63) stamps[63] = (unsigned long long)wall_clock64(); }
#undef PG8_STAMP
#undef PG8_SA
#undef PG8_SB
#undef PG8_STAGE
#undef PG8_LDA
#undef PG8_LDB
#undef PG8_MMA
#undef PG8_WAIT_V
#undef PG8_WAIT_L
#undef PG8_BAR
#undef PG8_SCHED
}
}

using pg8::bf16_t; using pg8::bf16x8; using pg8::f32x4; using pg8::u32x4;
typedef unsigned u32x2 __attribute__((ext_vector_type(2)));
#define MFMA16(a, b, c) __builtin_amdgcn_mfma_f32_16x16x32_bf16((a), (b), (c), 0, 0, 0)

constexpr int D = 1024, NB = 8, SEQ = 2048, CL = 256, TL = NB * SEQ, TC = NB * CL, TT = TL + TC;
constexpr int NIN = 2560;
constexpr int PW = 2048;
constexpr int C_MQ = 0, C_MK = 384, C_MV = 768, C_MO = 1152, C_CQ = 1552, C_CKV = 1808, C_KR = 1936;
constexpr int KEYS = SEQ + CL;
constexpr int LCH = 128, NCH = 18;
constexpr int VC = 112, STSZ = VC * 96;
constexpr int LDS_BYTES = 147456;
constexpr float EPS = 1e-6f;
#ifndef ATT_REP
#define ATT_REP 1
#endif
#ifndef REPMASK
#define REPMASK 0
#endif
#ifndef PHMASK
#define PHMASK 0xFFFF
#endif

constexpr size_t WS_MOD = 0;
constexpr size_t WS_WIN = WS_MOD + 442368;
constexpr size_t WS_WOUT = WS_WIN + 5242880;
constexpr size_t WS_WUP = WS_WOUT + 2097152;
constexpr size_t WS_WDOWN = WS_WUP + 8388608;
constexpr size_t WS_WUQ = WS_WDOWN + 8388608;
constexpr size_t WS_WUKV = WS_WUQ + 196608;
constexpr size_t WS_FDFT = WS_WUKV + 163840;
constexpr size_t WS_FDFTC = WS_FDFT + 16777216;
constexpr size_t WS_XCTX = WS_FDFTC + 262144;
constexpr size_t WS_S0 = WS_XCTX + 8388608;
constexpr size_t WS_HBUF = WS_S0;
constexpr size_t WS_HID = WS_S0 + 37748736;
constexpr size_t WS_MIX = WS_S0;
constexpr size_t WS_PROJ = WS_S0 + 37748736;
constexpr size_t WS_GATES = WS_PROJ + 75497472;
constexpr size_t WS_QB = WS_GATES + 1179648;
constexpr size_t WS_KB = WS_QB + 14155776;
constexpr size_t WS_VT = WS_KB + 14155776;
constexpr size_t WS_DC = WS_VT + 14155776;
constexpr size_t WS_DEC = WS_DC + 24772608;
constexpr size_t WS_ZT = WS_DEC + 8192;
constexpr size_t WS_ZTC = WS_ZT + 16777216;
constexpr size_t WS_ZTF = WS_ZTC + 2097152;
constexpr size_t WS_CST = WS_DC;
constexpr size_t WS_END_MIX = WS_ZTF + 8388608;
constexpr size_t WS_END_MLP = WS_HID + 150994944;
constexpr size_t WS_PART = WS_HID + 150994944;
constexpr size_t WS_RSS = 268435456 - 16384 - 262144 - 262144;
constexpr size_t WS_RCNT = WS_RSS - 65536;
constexpr size_t WS_ROPE = 268435456 - 16384 - 262144;
constexpr size_t WS_BAR = 268435456 - 16384;
constexpr size_t WS_NEED = 268435456;
static_assert(WS_END_MIX <= WS_RCNT && WS_PART + 4 * 4194304 <= WS_RCNT, "workspace map");

struct KP { const float* in[20]; float* out; unsigned char* ws; int ph_lo, ph_hi; };
enum { I_X, I_C, I_CTX, I_CCTX, I_WMOD, I_BMOD, I_G1, I_G2, I_WIN, I_BG, I_CONV, I_GM, I_GQN, I_GKVN, I_WUQ, I_WUKV, I_WOUT, I_WUP, I_WDOWN, I_GFIN };

__device__ __forceinline__ int ltid() { int t = threadIdx.x; asm volatile("" : "+v"(t)); return t; }
__device__ __forceinline__ int lbid() { int t = blockIdx.x; asm volatile("" : "+s"(t)); return t; }
__device__ __forceinline__ float bf2f(bf16_t v) { return __uint_as_float(((unsigned)v) << 16); }
__device__ __forceinline__ bf16_t f2bf(float f) { unsigned u = __float_as_uint(f); u += 0x7FFFu + ((u >> 16) & 1u); return (bf16_t)(u >> 16); }
__device__ __forceinline__ unsigned pk2(float lo, float hi) { unsigned r; asm("v_cvt_pk_bf16_f32 %0, %1, %2" : "=v"(r) : "v"(lo), "v"(hi)); return r; }
__device__ __forceinline__ float lo_bf(unsigned u) { return __uint_as_float(u << 16); }
__device__ __forceinline__ float hi_bf(unsigned u) { return __uint_as_float(u & 0xFFFF0000u); }
__device__ __forceinline__ float wave_sum(float v) {
#pragma unroll
    for (int o = 1; o < 64; o <<= 1) v += __shfl_xor(v, o);
    return v;
}
__device__ __forceinline__ float max_over_fq(float x) {
    const unsigned u = __float_as_uint(x);
    const auto r = __builtin_amdgcn_permlane32_swap(u, u, false, false);
    const float m = fmaxf(__uint_as_float(r[0]), __uint_as_float(r[1]));
    const unsigned v = __float_as_uint(m);
    const auto s = __builtin_amdgcn_permlane16_swap(v, v, false, false);
    return fmaxf(__uint_as_float(s[0]), __uint_as_float(s[1]));
}
__device__ __forceinline__ float sum_over_fq(float x) {
    const unsigned u = __float_as_uint(x);
    const auto r = __builtin_amdgcn_permlane32_swap(u, u, false, false);
    const float m = __uint_as_float(r[0]) + __uint_as_float(r[1]);
    const unsigned v = __float_as_uint(m);
    const auto s = __builtin_amdgcn_permlane16_swap(v, v, false, false);
    return __uint_as_float(s[0]) + __uint_as_float(s[1]);
}
__device__ __forceinline__ float logsig(float f) { const float e = __expf(-fabsf(f)); return fminf(f, 0.f) - __logf(1.f + e); }
__device__ __forceinline__ float siluf(float v) { return v / (1.f + __expf(-v)); }
__device__ __forceinline__ bf16x8 mk8(u32x2 lo, u32x2 hi) { u32x4 t = {lo.x, lo.y, hi.x, hi.y}; return __builtin_bit_cast(bf16x8, t); }

struct EpiIn {
    static constexpr bool PERM = true, AFTER_DRAIN = false;
    bf16_t* proj; float* gates; bf16_t* zt; bf16_t* ztc;
    __device__ __forceinline__ void operator()(const f32x4 (&acc)[2][2][4][2], const pg8::Unit& u, int wr, int wc, int fr, int fq) const {
        const int row0 = u.pm * 256 + wr * 64 + fr;
        if (u.pn < 2) {
            const bool latu = u.pm < 64;
            unsigned char* zb = latu ? (unsigned char*)zt : (unsigned char*)ztc;
            const unsigned ldzb = latu ? 8192u : 1024u;
            const unsigned cofs = (unsigned)(wc * 32 + 8 * fq) * ldzb;
#pragma unroll
            for (int ai = 0; ai < 2; ++ai)
#pragma unroll
                for (int m = 0; m < 4; ++m) {
                    const int r = row0 + ai * 128 + m * 16;
                    unsigned off;
                    if (latu) { const int b = r >> 11, n = r & 2047; off = (unsigned)((b * 256) * 4096 + u.pn * 2048 + n) * 2u + cofs; }
                    else { const int rc = r - TL, b = rc >> 8, n = rc & 255; off = (unsigned)((b * 256) * 512 + u.pn * 256 + n) * 2u + cofs; }
#pragma unroll
                    for (int bj = 0; bj < 2; ++bj)
#pragma unroll
                        for (int n2 = 0; n2 < 2; ++n2) {
                            const f32x4 v = acc[ai][bj][m][n2];
#pragma unroll
                            for (int j = 0; j < 4; ++j) *(bf16_t*)(zb + (off + (unsigned)(bj * 128 + 4 * n2 + j) * ldzb)) = f2bf(v[j]);
                        }
                    asm volatile("" ::: "memory");
                }
        } else {
            const int colbase = (u.pn - 2) * 256 + wc * 32 + 8 * fq;
            const bool isg = (u.pn == 8) && (wc == 0) && (fq < 2);
#pragma unroll
            for (int ai = 0; ai < 2; ++ai)
#pragma unroll
                for (int m = 0; m < 4; ++m) {
                    const int r = row0 + ai * 128 + m * 16;
                    bf16_t* rowp = proj + (size_t)r * PW + colbase;
#pragma unroll
                    for (int bj = 0; bj < 2; ++bj) {
                        const f32x4 v0 = acc[ai][bj][m][0], v1 = acc[ai][bj][m][1];
                        u32x4 o; o.x = pk2(v0[0], v0[1]); o.y = pk2(v0[2], v0[3]); o.z = pk2(v1[0], v1[1]); o.w = pk2(v1[2], v1[3]);
                        *(u32x4*)(rowp + bj * 128) = o;
                    }
                    if (isg) { float* gp = gates + (size_t)r * 16 + 8 * fq; *(f32x4*)gp = acc[ai][0][m][0]; *(f32x4*)(gp + 4) = acc[ai][0][m][1]; }
                    asm volatile("" ::: "memory");
                }
        }
    }
};
struct EpiRes {
    static constexpr bool PERM = false, AFTER_DRAIN = false;
    const float* xol; const float* xoc; float* xnl; float* xnc; const float* ga;
    __device__ __forceinline__ void operator()(const f32x4 (&acc)[2][2][4][2], const pg8::Unit& u, int wr, int wc, int fr, int fq) const {
        const int row0 = u.pm * 256 + wr * 64 + fr, col0 = u.pn * 256 + wc * 32 + 4 * fq;
#pragma unroll
        for (int ai = 0; ai < 2; ++ai)
#pragma unroll
            for (int m = 0; m < 4; ++m) {
                const int r = row0 + ai * 128 + m * 16;
                const float* xo; float* xn; int b;
                if (r < TL) { xo = xol + (size_t)r * D; xn = xnl + (size_t)r * D; b = r >> 11; } else { xo = xoc + (size_t)(r - TL) * D; xn = xnc + (size_t)(r - TL) * D; b = 8; }
                const float* gp = ga + (size_t)b * 6144;
#pragma unroll
                for (int bj = 0; bj < 2; ++bj)
#pragma unroll
                    for (int n = 0; n < 2; ++n) {
                        const int c = col0 + bj * 128 + n * 16;
                        const f32x4 g = *(const f32x4*)(gp + c), xv = *(const f32x4*)(xo + c);
                        *(f32x4*)(xn + c) = xv + g * acc[ai][bj][m][n];
                    }
            }
    }
};
struct EpiResNorm {
    static constexpr bool PERM = false, AFTER_DRAIN = true;
    const float* xo; float* xn; const float* ga; float* rss; unsigned* cnt; int mode; const float* g; const float* sc; const float* sh; bf16_t* hb;
    __device__ __forceinline__ void fused(f32x4 (&acc)[2][2][4][2], const pg8::Unit& u, int wr, int wc, int fr, int fq, PG8_LAS unsigned char* lds, int wid, int lane) const {
        const int row0 = u.pm * 256 + wr * 64 + fr, col0 = u.pn * 256 + wc * 32 + 4 * fq, b = (u.pm * 256) >> 11;
        float ps[2][4];
        {   const float* gp = ga + (size_t)b * 6144 + col0;
            f32x4 gv[2][2];
#pragma unroll
            for (int bj = 0; bj < 2; ++bj)
#pragma unroll
                for (int n = 0; n < 2; ++n) gv[bj][n] = *(const f32x4*)(gp + bj * 128 + n * 16);
#pragma unroll
            for (int ai = 0; ai < 2; ++ai) {
                f32x4 xt[4][2][2];
#pragma unroll
                for (int m = 0; m < 4; ++m) { const float* xr = xo + (size_t)(row0 + ai * 128 + m * 16) * D + col0;
#pragma unroll
                    for (int bj = 0; bj < 2; ++bj)
#pragma unroll
                        for (int n = 0; n < 2; ++n) xt[m][bj][n] = *(const f32x4*)(xr + bj * 128 + n * 16); }
#pragma unroll
                for (int m = 0; m < 4; ++m) { float s = 0.f;
#pragma unroll
                    for (int bj = 0; bj < 2; ++bj)
#pragma unroll
                        for (int n = 0; n < 2; ++n) { const f32x4 v = xt[m][bj][n] + gv[bj][n] * acc[ai][bj][m][n]; acc[ai][bj][m][n] = v;
                            s += v[0] * v[0] + v[1] * v[1] + v[2] * v[2] + v[3] * v[3]; }
                    ps[ai][m] = sum_over_fq(s); }
                asm volatile("" ::: "memory");
            } }
        PG8_LAS float* red = (PG8_LAS float*)lds;
        if (fq == 0) {
#pragma unroll
            for (int ai = 0; ai < 2; ++ai)
#pragma unroll
                for (int m = 0; m < 4; ++m) red[wc * 256 + ai * 128 + wr * 64 + m * 16 + fr] = ps[ai][m]; }
        __syncthreads();
        const int tid = wid * 64 + lane;
        if (tid < 256) { const float tot = (red[tid] + red[256 + tid]) + (red[512 + tid] + red[768 + tid]);
            (void)__hip_atomic_fetch_add(rss + u.pm * 256 + tid, tot, __ATOMIC_RELAXED, __HIP_MEMORY_SCOPE_AGENT); }
        asm volatile("s_waitcnt vmcnt(0)" ::: "memory");
        __syncthreads();
        if (tid == 0) { unsigned* c = cnt + u.pm * 64;
            (void)__hip_atomic_fetch_add(c, 1u, __ATOMIC_RELAXED, __HIP_MEMORY_SCOPE_AGENT);
            unsigned spins = 0; while (__hip_atomic_load(c, __ATOMIC_RELAXED, __HIP_MEMORY_SCOPE_AGENT) < 4u && ++spins < (1u << 22)) __builtin_amdgcn_s_sleep(1); }
        __syncthreads();
        float rs[2][4];
#pragma unroll
        for (int ai = 0; ai < 2; ++ai)
#pragma unroll
            for (int m = 0; m < 4; ++m) rs[ai][m] = __hip_atomic_load(rss + row0 + ai * 128 + m * 16, __ATOMIC_RELAXED, __HIP_MEMORY_SCOPE_AGENT);
#pragma unroll
        for (int ai = 0; ai < 2; ++ai)
#pragma unroll
            for (int m = 0; m < 4; ++m) rs[ai][m] = rsqrtf(rs[ai][m] * (1.f / D) + EPS);
        const size_t bo = (size_t)b * 6144;
#pragma unroll
        for (int bj = 0; bj < 2; ++bj) {
            f32x4 gq[2], sv[2];
#pragma unroll
            for (int n = 0; n < 2; ++n) { const int c = col0 + bj * 128 + n * 16; const f32x4 gg = *(const f32x4*)(g + c);
                if (mode == 0) { gq[n] = gg * (*(const f32x4*)(sc + bo + c) + 1.f); sv[n] = *(const f32x4*)(sh + bo + c); }
                else { gq[n] = gg; sv[n] = (f32x4){0.f, 0.f, 0.f, 0.f}; } }
#pragma unroll
            for (int ai = 0; ai < 2; ++ai)
#pragma unroll
                for (int m = 0; m < 4; ++m) {
                    const int r = row0 + ai * 128 + m * 16; const float rstd = rs[ai][m];
#pragma unroll
                    for (int n = 0; n < 2; ++n) { const int c = col0 + bj * 128 + n * 16; const f32x4 v = acc[ai][bj][m][n];
                        const f32x4 hh = v * rstd * gq[n] + sv[n];
                        if (mode == 0) { *(f32x4*)(xn + (size_t)r * D + c) = v;
                            u32x2 o; o.x = pk2(hh[0], hh[1]); o.y = pk2(hh[2], hh[3]); *(u32x2*)(hb + (size_t)r * D + c) = o; }
                        else *(f32x4*)(xn + (size_t)r * D + c) = hh; }
                }
            asm volatile("" ::: "memory");
        }
    }
};
struct EpiUp {
    static constexpr bool PERM = true, AFTER_DRAIN = false;
    bf16_t* hid;
    __device__ __forceinline__ void operator()(const f32x4 (&acc)[2][2][4][2], const pg8::Unit& u, int wr, int wc, int fr, int fq) const {
        const int row0 = u.pm * 256 + wr * 64 + fr, col0 = u.pn * 256 + wc * 32 + 8 * fq;
#pragma unroll
        for (int ai = 0; ai < 2; ++ai)
#pragma unroll
            for (int m = 0; m < 4; ++m) {
                bf16_t* rowp = hid + (size_t)(row0 + ai * 128 + m * 16) * 4096 + col0;
#pragma unroll
                for (int bj = 0; bj < 2; ++bj) {
                    f32x4 v0 = acc[ai][bj][m][0], v1 = acc[ai][bj][m][1];
#pragma unroll
                    for (int j = 0; j < 4; ++j) { float a = fmaxf(v0[j], 0.f); v0[j] = a * a; float b = fmaxf(v1[j], 0.f); v1[j] = b * b; }
                    u32x4 o; o.x = pk2(v0[0], v0[1]); o.y = pk2(v0[2], v0[3]); o.z = pk2(v1[0], v1[1]); o.w = pk2(v1[2], v1[3]);
                    *(u32x4*)(rowp + bj * 128) = o;
                }
            }
    }
};
struct EpiFou {
    static constexpr bool PERM = true, AFTER_DRAIN = false;
    bf16_t* mix; int rows_per_b; int row_off; float scale;
    __device__ __forceinline__ void operator()(const f32x4 (&acc)[2][2][4][2], const pg8::Unit& u, int wr, int wc, int fr, int fq) const {
        const int row0 = u.pm * 256 + wr * 64 + fr, col0 = wc * 32 + 8 * fq;
        const size_t rb = (size_t)row_off + (size_t)u.pn * rows_per_b;
#pragma unroll
        for (int ai = 0; ai < 2; ++ai)
#pragma unroll
            for (int m = 0; m < 4; ++m) {
                bf16_t* rowp = mix + (rb + row0 + ai * 128 + m * 16) * D + col0;
#pragma unroll
                for (int bj = 0; bj < 2; ++bj) {
                    const f32x4 v0 = acc[ai][bj][m][0] * scale, v1 = acc[ai][bj][m][1] * scale;
                    u32x4 o; o.x = pk2(v0[0], v0[1]); o.y = pk2(v0[2], v0[3]); o.z = pk2(v1[0], v1[1]); o.w = pk2(v1[2], v1[3]);
                    *(u32x4*)(rowp + bj * 128) = o;
                }
            }
    }
};

template <class Epi>
__device__ __forceinline__ void run_gemm(unsigned char* shm, const bf16_t* A, const bf16_t* Bt, int M, int N, int K, int G, int c, const Epi& E) {
    pg8::Gemm g; g.A = A; g.Bt = Bt; g.M = M; g.N = N; g.K = K; g.ld = K;
    pg8::StaticOrder S; S.init(M, N, G, c);
    pg8::gemm_phase<Epi, pg8::StaticOrder, false>((PG8_LAS unsigned char*)shm, g, S, E, nullptr);
}

struct OneUnit {
    int pm, pn;
    __device__ bool next(int i, pg8::Unit& u) const { if (i) return false; u.pm = pm; u.pn = pn; return true; }
    __device__ __forceinline__ void a_ready(const pg8::Unit&) const {}
    __device__ __forceinline__ void done(const pg8::Unit&) const {}
};
struct EpiPart {
    static constexpr bool PERM = true, AFTER_DRAIN = false;
    bf16_t* part;
    __device__ __forceinline__ void operator()(const f32x4 (&acc)[2][2][4][2], const pg8::Unit& u, int wr, int wc, int fr, int fq) const {
        const int row0 = u.pm * 256 + wr * 64 + fr, col0 = u.pn * 256 + wc * 32 + 8 * fq;
#pragma unroll
        for (int ai = 0; ai < 2; ++ai)
#pragma unroll
            for (int m = 0; m < 4; ++m) {
                bf16_t* rowp = part + (size_t)(row0 + ai * 128 + m * 16) * D + col0;
#pragma unroll
                for (int bj = 0; bj < 2; ++bj) { const f32x4 v0 = acc[ai][bj][m][0], v1 = acc[ai][bj][m][1];
                    u32x4 o; o.x = pk2(v0[0], v0[1]); o.y = pk2(v0[2], v0[3]); o.z = pk2(v1[0], v1[1]); o.w = pk2(v1[2], v1[3]);
                    *(u32x4*)(rowp + bj * 128) = o; }
            }
    }
};
__device__ __forceinline__ void run_gemm_ctx_split(unsigned char* shm, const bf16_t* A, const bf16_t* Bt, int K, int ld, int pm, int pn, const EpiPart& E) {
    pg8::Gemm g; g.A = A; g.Bt = Bt; g.M = TC; g.N = 1024; g.K = K; g.ld = ld;
    OneUnit S; S.pm = pm; S.pn = pn;
    pg8::gemm_phase<EpiPart, OneUnit, false>((PG8_LAS unsigned char*)shm, g, S, E, nullptr);
}

__device__ __forceinline__ void build_costab(float* tab) {
    for (int i = ltid(); i < 2048; i += 512) tab[i] = cospif((float)i * (1.0f / 1024.0f));
    __syncthreads();
}
__device__ __forceinline__ void tr_load(const float* __restrict__ src, int ldn, int nmax, int k0, int nsrc0, float* tile) {
    const int tid = ltid(), r = tid >> 4, c4 = (tid & 15) * 4;
#pragma unroll
    for (int h = 0; h < 2; ++h) {
        const int rr = r + 32 * h, nc = nsrc0 + c4;
        f32x4 v = {0.f, 0.f, 0.f, 0.f};
        if (nc < nmax) v = *(const f32x4*)(src + (size_t)(k0 + rr) * ldn + nc);
        float* t = tile + rr * 65 + c4; t[0] = v[0]; t[1] = v[1]; t[2] = v[2]; t[3] = v[3];
    }
    __syncthreads();
}
__device__ __forceinline__ void tr_tile(const float* __restrict__ src, int ldn, int nmax, int k0, int nsrc0, bf16_t* __restrict__ dst, int ldk, int ndst0, float* tile) {
    tr_load(src, ldn, nmax, k0, nsrc0, tile);
    const int tid = ltid(), n = tid >> 3, kq = tid & 7;
    const float* s = tile + (kq * 8) * 65 + n;
    u32x4 o; o.x = pk2(s[0], s[65]); o.y = pk2(s[130], s[195]); o.z = pk2(s[260], s[325]); o.w = pk2(s[390], s[455]);
    *(u32x4*)(dst + (size_t)(ndst0 + n) * ldk + k0 + kq * 8) = o;
    __syncthreads();
}
__device__ __forceinline__ void fold_tile(const float* __restrict__ win, int k0, int g, bf16_t* __restrict__ dst, float* tile, const float* tab) {
    tr_load(win, 2224, 2224, k0, g * 64, tile);
    const int tid = ltid(), cp = tid >> 3, kq = tid & 7;
    float ac[8], as[8];
#pragma unroll
    for (int i = 0; i < 8; ++i) { ac[i] = 0.f; as[i] = 0.f; }
    for (int c = 0; c < 64; ++c) {
        const int idx = ((c * cp) & 63) * 32;
        const float cs = tab[idx], sn = tab[(idx - 512) & 2047];
#pragma unroll
        for (int i = 0; i < 8; ++i) { const float v = tile[(kq * 8 + i) * 65 + c]; ac[i] += v * cs; as[i] += v * sn; }
    }
    u32x4 o; o.x = pk2(ac[0], ac[1]); o.y = pk2(ac[2], ac[3]); o.z = pk2(ac[4], ac[5]); o.w = pk2(ac[6], ac[7]);
    *(u32x4*)(dst + (size_t)(g * 64 + cp) * 1024 + k0 + kq * 8) = o;
    u32x4 q; q.x = pk2(as[0], as[1]); q.y = pk2(as[2], as[3]); q.z = pk2(as[4], as[5]); q.w = pk2(as[6], as[7]);
    *(u32x4*)(dst + (size_t)(256 + g * 64 + cp) * 1024 + k0 + kq * 8) = q;
    __syncthreads();
}
__device__ __forceinline__ void tr_tile_wave(const float* __restrict__ src, int ldn, int nmax, int k0, int nsrc0, bf16_t* __restrict__ dst, int ldk, int ndst0, float* tile, int lane) {
    const int r = lane >> 4, c4 = (lane & 15) * 4;
    f32x4 tv[16];
#pragma unroll
    for (int h = 0; h < 16; ++h) { const int rr = r + 4 * h, nc = nsrc0 + c4; tv[h] = (f32x4){0.f, 0.f, 0.f, 0.f};
        if (nc < nmax) tv[h] = *(const f32x4*)(src + (size_t)(k0 + rr) * ldn + nc); }
#pragma unroll
    for (int h = 0; h < 16; ++h) { const int rr = r + 4 * h; float* t = tile + rr * 65 + c4; t[0] = tv[h][0]; t[1] = tv[h][1]; t[2] = tv[h][2]; t[3] = tv[h][3]; }
    asm volatile("s_waitcnt lgkmcnt(0)" ::: "memory");
    const int c = lane & 7, nl = lane >> 3;
#pragma unroll
    for (int j = 0; j < 8; ++j) { const int n = nl + 8 * j; const float* s = tile + (8 * c) * 65 + n;
        u32x4 o; o.x = pk2(s[0], s[65]); o.y = pk2(s[130], s[195]); o.z = pk2(s[260], s[325]); o.w = pk2(s[390], s[455]);
        *(u32x4*)(dst + (size_t)(ndst0 + n) * ldk + k0 + 8 * c) = o; }
    asm volatile("s_waitcnt lgkmcnt(0)" ::: "memory");
}
constexpr int NWV_ITEMS = 512 + 256 + 1024 + 1024 + 24 + 20;
__device__ __forceinline__ void prep_weight_item_wave(const KP& p, int l, int it, float* tile, int lane) {
    unsigned char* ws = p.ws;
    if (it < 512) { const int ct = it & 31, kt = it >> 5;
        tr_tile_wave(p.in[I_WIN] + (size_t)l * 1024 * 2224, 2224, 2224, kt * 64, 256 + ct * 64, (bf16_t*)(ws + WS_WIN), 1024, 512 + ct * 64, tile, lane); return; }
    it -= 512;
    if (it < 256) { tr_tile_wave(p.in[I_WOUT] + (size_t)l * 1024 * 1024, 1024, 1024, (it >> 4) * 64, (it & 15) * 64, (bf16_t*)(ws + WS_WOUT), 1024, (it & 15) * 64, tile, lane); return; }
    it -= 256;
    if (it < 1024) { tr_tile_wave(p.in[I_WUP] + (size_t)l * 1024 * 4096, 4096, 4096, (it >> 6) * 64, (it & 63) * 64, (bf16_t*)(ws + WS_WUP), 1024, (it & 63) * 64, tile, lane); return; }
    it -= 1024;
    if (it < 1024) { tr_tile_wave(p.in[I_WDOWN] + (size_t)l * 4096 * 1024, 1024, 1024, (it >> 4) * 64, (it & 15) * 64, (bf16_t*)(ws + WS_WDOWN), 4096, (it & 15) * 64, tile, lane); return; }
    it -= 1024;
    if (it < 24) { tr_tile_wave(p.in[I_WUQ] + (size_t)l * 256 * 384, 384, 384, (it / 6) * 64, (it % 6) * 64, (bf16_t*)(ws + WS_WUQ), 256, (it % 6) * 64, tile, lane); return; }
    it -= 24;
    tr_tile_wave(p.in[I_WUKV] + (size_t)l * 128 * 640, 640, 640, (it / 10) * 64, (it % 10) * 64, (bf16_t*)(ws + WS_WUKV), 128, (it % 10) * 64, tile, lane);
}
__device__ __forceinline__ void prep_weights(const KP& p, int l, unsigned char* shm, const float* tab, int part = 0, int b0 = 0, int nb = 0) {
    const int tid = ltid(), bid = lbid() - b0, G = nb ? nb : (int)gridDim.x;
    if (part != 2) for (int it = bid; it < 64; it += G) fold_tile(p.in[I_WIN] + (size_t)l * 1024 * 2224, (it >> 2) * 64, it & 3, (bf16_t*)(p.ws + WS_WIN), (float*)(shm + 8192), tab);
    __syncthreads();
    float* wt = (float*)(shm + 8192) + (tid >> 6) * (64 * 65);
    for (int it = bid * 8 + (tid >> 6); it < NWV_ITEMS; it += G * 8) {
        const bool isdown = it >= 1792 && it < 2816;
        if ((part == 1 && isdown) || (part == 2 && !isdown)) continue;
        prep_weight_item_wave(p, l, it, wt, tid & 63); }
    __syncthreads();
}
constexpr int NW_ITEMS = 512 + 64 + 256 + 1024 + 1024 + 24 + 20;
__device__ __forceinline__ void prep_weight_item(const KP& p, int l, int it, float* tile, const float* tab) {
    unsigned char* ws = p.ws;
    if (it < 512) { const int ct = it & 31, kt = it >> 5;
        tr_tile(p.in[I_WIN] + (size_t)l * 1024 * 2224, 2224, 2224, kt * 64, 256 + ct * 64, (bf16_t*)(ws + WS_WIN), 1024, 512 + ct * 64, tile); return; }
    it -= 512;
    if (it < 64) { fold_tile(p.in[I_WIN] + (size_t)l * 1024 * 2224, (it >> 2) * 64, it & 3, (bf16_t*)(ws + WS_WIN), tile, tab); return; }
    it -= 64;
    if (it < 256) { tr_tile(p.in[I_WOUT] + (size_t)l * 1024 * 1024, 1024, 1024, (it >> 4) * 64, (it & 15) * 64, (bf16_t*)(ws + WS_WOUT), 1024, (it & 15) * 64, tile); return; }
    it -= 256;
    if (it < 1024) { tr_tile(p.in[I_WUP] + (size_t)l * 1024 * 4096, 4096, 4096, (it >> 6) * 64, (it & 63) * 64, (bf16_t*)(ws + WS_WUP), 1024, (it & 63) * 64, tile); return; }
    it -= 1024;
    if (it < 1024) { tr_tile(p.in[I_WDOWN] + (size_t)l * 4096 * 1024, 1024, 1024, (it >> 4) * 64, (it & 15) * 64, (bf16_t*)(ws + WS_WDOWN), 4096, (it & 15) * 64, tile); return; }
    it -= 1024;
    if (it < 24) { tr_tile(p.in[I_WUQ] + (size_t)l * 256 * 384, 384, 384, (it / 6) * 64, (it % 6) * 64, (bf16_t*)(ws + WS_WUQ), 256, (it % 6) * 64, tile); return; }
    it -= 24;
    tr_tile(p.in[I_WUKV] + (size_t)l * 128 * 640, 640, 640, (it / 10) * 64, (it % 10) * 64, (bf16_t*)(ws + WS_WUKV), 128, (it % 10) * 64, tile);
}
__device__ __forceinline__ void prep_mod_item(const KP& p, int it, float* sl) {
    const int tid = ltid(), l = it / 96, cgp = it % 96;
    for (int i = tid; i < 9216; i += 512) { const int r = i >> 10, k = i & 1023; const float v = r < 8 ? p.in[I_C][r * 1024 + k] : p.in[I_CCTX][k]; sl[i] = siluf(v); }
    __syncthreads();
    const int j4 = (tid & 15) * 4, ks = tid >> 4;
    f32x4 acc[9];
#pragma unroll
    for (int r = 0; r < 9; ++r) acc[r] = (f32x4){0.f, 0.f, 0.f, 0.f};
    const float* w = p.in[I_WMOD] + (size_t)l * 1024 * 6144 + cgp * 64 + j4;
#pragma unroll 8
    for (int k = ks * 32; k < ks * 32 + 32; ++k) {
        const f32x4 wv = *(const f32x4*)(w + (size_t)k * 6144);
#pragma unroll
        for (int r = 0; r < 9; ++r) acc[r] += wv * sl[r * 1024 + k];
    }
    float* red = sl + 9216;
#pragma unroll
    for (int r = 0; r < 9; ++r) *(f32x4*)(red + (ks * 9 + r) * 64 + j4) = acc[r];
    __syncthreads();
    for (int o = tid; o < 576; o += 512) { const int r = o >> 6, jl = o & 63; float s = 0.f;
#pragma unroll
        for (int q = 0; q < 32; ++q) s += red[(q * 9 + r) * 64 + jl];
        ((float*)(p.ws + WS_MOD))[(size_t)(l * 9 + r) * 6144 + cgp * 64 + jl] = s + p.in[I_BMOD][l * 6144 + cgp * 64 + jl]; }
    __syncthreads();
}
__device__ __forceinline__ void prep_dft_row(const KP& p, int rowid, const float* tab) {
    const int tid = ltid();
    if (rowid < 2048) {
        const int k = rowid; float v[4];
#pragma unroll
        for (int e = 0; e < 4; ++e) { const int j = tid * 4 + e;
            if (j <= 1024) v[e] = tab[(k * j) & 2047]; else { const int n = j - 1024; v[e] = -tab[(((k * n) & 2047) - 512) & 2047]; } }
        u32x2 ov; ov.x = pk2(v[0], v[1]); ov.y = pk2(v[2], v[3]);
        *(u32x2*)((bf16_t*)(p.ws + WS_FDFT) + (size_t)k * 2048 + tid * 4) = ov;
    } else if (tid < 64) {
        const int k = rowid - 2048; unsigned o[4];
#pragma unroll
        for (int i = 0; i < 4; ++i) { float v[2];
#pragma unroll
            for (int e = 0; e < 2; ++e) { const int np = tid * 8 + i * 2 + e, n = np & 255, j = ((k * n) & 255) * 8; v[e] = (np >> 8) ? -tab[(j - 512) & 2047] : tab[j]; }
            o[i] = pk2(v[0], v[1]); }
        u32x4 ov = {o[0], o[1], o[2], o[3]};
        *(u32x4*)((bf16_t*)(p.ws + WS_FDFTC) + (size_t)k * 512 + tid * 8) = ov;
    }
}
__device__ __forceinline__ void rope_cs(int tpos, int seg, int f, float& cs, float& sn);
__device__ __forceinline__ void step_prep0(const KP& p, unsigned char* shm) {
    float* tab = (float*)shm; float* work = (float*)(shm + 8192);
    build_costab(tab);
    {
        unsigned* z = (unsigned*)(p.ws + WS_RCNT);
        for (int i = lbid() * 512 + ltid(); i < (65536 + 262144) / 4; i += gridDim.x * 512) z[i] = 0u; }
    {
        float* rt = (float*)(p.ws + WS_ROPE);
        for (int i = lbid() * 512 + ltid(); i < 2048 * 16; i += gridDim.x * 512) { float cs, sn; rope_cs(i >> 4, (i >> 3) & 1, i & 7, cs, sn); rt[2 * i] = cs; rt[2 * i + 1] = sn; } }
    const int NT = 192 + 2304;
    for (int it = lbid(); it < NT; it += gridDim.x) {
        if (it < 192) prep_mod_item(p, it, work);
        else prep_dft_row(p, it - 192, tab);
    }
    __syncthreads();
    prep_weights(p, 0, shm, tab);
}

__device__ __forceinline__ void norm_rows(const float* xl, const float* xc, int nrows, const float* g, const float* modl, int shoff, int scoff, bf16_t* dst, const bf16_t* part = nullptr, const float* pga = nullptr, float* xcw = nullptr, int rlo = 0) {
    const int tid = ltid(), lane = tid & 63, gw = lbid() * 8 + (tid >> 6), NW = gridDim.x * 8;
    for (int r0 = rlo + gw; r0 < nrows; r0 += 3 * NW) {
        f32x4 v[3][4]; float ss[3];
#pragma unroll
        for (int q = 0; q < 3; ++q) { const int r = r0 + q * NW; ss[q] = 0.f;
            if (r < nrows) { const float* xr = r < TL ? xl + (size_t)r * D : xc + (size_t)(r - TL) * D;
#pragma unroll
                for (int j = 0; j < 4; ++j) v[q][j] = *(const f32x4*)(xr + lane * 4 + 256 * j);
                if (part != nullptr && r >= TL) {
#pragma unroll
                    for (int j = 0; j < 4; ++j) { const int c = lane * 4 + 256 * j; f32x4 a = {0.f, 0.f, 0.f, 0.f};
#pragma unroll
                        for (int sp = 0; sp < 4; ++sp) { const u32x2 pv = *(const u32x2*)(part + ((size_t)sp * TC + (r - TL)) * D + c); a[0] += lo_bf(pv.x); a[1] += hi_bf(pv.x); a[2] += lo_bf(pv.y); a[3] += hi_bf(pv.y); }
                        v[q][j] += *(const f32x4*)(pga + c) * a;
                        if (xcw != nullptr) *(f32x4*)(xcw + (size_t)(r - TL) * D + c) = v[q][j]; } } }
            else {
#pragma unroll
                for (int j = 0; j < 4; ++j) v[q][j] = (f32x4){0.f, 0.f, 0.f, 0.f}; } }
#pragma unroll
        for (int q = 0; q < 3; ++q) {
#pragma unroll
            for (int j = 0; j < 4; ++j) ss[q] += v[q][j][0] * v[q][j][0] + v[q][j][1] * v[q][j][1] + v[q][j][2] * v[q][j][2] + v[q][j][3] * v[q][j][3];
            ss[q] = wave_sum(ss[q]); }
#pragma unroll
        for (int q = 0; q < 3; ++q) { const int r = r0 + q * NW;
            if (r < nrows) { const int b = r < TL ? (r >> 11) : 8; const float rstd = rsqrtf(ss[q] * (1.f / D) + EPS); const float* mp = modl + (size_t)b * 6144;
#pragma unroll
                for (int j = 0; j < 4; ++j) { const int c = lane * 4 + 256 * j;
                    const f32x4 gg = *(const f32x4*)(g + c), sc = *(const f32x4*)(mp + scoff + c), sh = *(const f32x4*)(mp + shoff + c);
                    const f32x4 y = v[q][j] * rstd * gg, hh = y * (sc + 1.f) + sh;
                    u32x2 o; o.x = pk2(hh[0], hh[1]); o.y = pk2(hh[2], hh[3]);
                    *(u32x2*)(dst + (size_t)r * D + c) = o; } } }
    }
}
__device__ __forceinline__ void step_final(const KP& p) {
    const int tid = ltid(), lane = tid & 63, gw = lbid() * 8 + (tid >> 6), NW = gridDim.x * 8;
    const float* g = p.in[I_GFIN];
    for (int r0 = gw; r0 < TL; r0 += 2 * NW) {
        f32x4 v[2][4]; float ss[2];
#pragma unroll
        for (int q = 0; q < 2; ++q) { const float* xr = p.out + (size_t)(r0 + q * NW) * D; ss[q] = 0.f;
#pragma unroll
            for (int j = 0; j < 4; ++j) v[q][j] = *(const f32x4*)(xr + lane * 4 + 256 * j); }
#pragma unroll
        for (int q = 0; q < 2; ++q) {
#pragma unroll
            for (int j = 0; j < 4; ++j) ss[q] += v[q][j][0] * v[q][j][0] + v[q][j][1] * v[q][j][1] + v[q][j][2] * v[q][j][2] + v[q][j][3] * v[q][j][3];
            ss[q] = wave_sum(ss[q]); }
#pragma unroll
        for (int q = 0; q < 2; ++q) { float* xr = p.out + (size_t)(r0 + q * NW) * D; const float rstd = rsqrtf(ss[q] * (1.f / D) + EPS);
#pragma unroll
            for (int j = 0; j < 4; ++j) { const int c = lane * 4 + 256 * j; *(f32x4*)(xr + c) = v[q][j] * rstd * *(const f32x4*)(g + c); } }
    }
}

constexpr int ML_GA = 0;
constexpr int ML_CW = 3072;
constexpr int ML_Q = 7168;
constexpr int ML_K = 33792;
constexpr int ML_VT = 60416;
constexpr int ML_RAW = 90880;
__device__ __forceinline__ int ml_rowbase(int b, int jc) { return jc < 2 ? TL + b * CL + jc * LCH : b * SEQ + (jc - 2) * LCH; }

__device__ __forceinline__ void ml_stage(const KP& p, int l, int b, int h, int jc, unsigned char* shm) {
    const int tid = ltid();
    const bf16_t* proj = (const bf16_t*)(p.ws + WS_PROJ);
    const float* gates = (const float*)(p.ws + WS_GATES);
    float* GA = (float*)(shm + ML_GA); float* CW = (float*)(shm + ML_CW);
    bf16_t* vT = (bf16_t*)(shm + ML_VT); bf16_t* RAW = (bf16_t*)(shm + ML_RAW);
    const int rowbase = ml_rowbase(b, jc);
    const int t0 = jc < 2 ? jc * LCH : (jc - 2) * LCH, slen = jc < 2 ? CL : SEQ;
    float i_f = 0.f, i_b = 0.f, pf = 0.f, sf = 0.f;
    if (tid < 128) {
        const int lane = tid & 63;
        const float* gp = gates + (size_t)(rowbase + tid) * 16; const float* bg = p.in[I_BG] + l * 16;
        const f32x4 g0 = *(const f32x4*)gp, g1 = *(const f32x4*)(gp + 4), g2 = *(const f32x4*)(gp + 8), g3 = *(const f32x4*)(gp + 12);
        i_f = g0[h] + bg[h]; i_b = g2[h] + bg[8 + h];
        pf = logsig(g1[h] + bg[4 + h]); sf = logsig(g3[h] + bg[12 + h]);
#pragma unroll
        for (int o = 1; o < 64; o <<= 1) { const float t = __shfl_up(pf, o); if (lane >= o) pf += t; const float u = __shfl_down(sf, o); if (lane + o < 64) sf += u; }
        if (lane == 63) GA[4 * 128 + (tid >> 6)] = pf;
        if (lane == 0) GA[5 * 128 + (tid >> 6)] = sf;
    }
    float cwv[2]; u32x4 rv[7], vv[3];
#pragma unroll
    for (int q = 0; q < 2; ++q) { const int i = tid + 512 * q; cwv[q] = 0.f;
        if (i < 5 * 192) { const int k = i / 192, ch = i % 192; cwv[q] = p.in[I_CONV][(size_t)l * 5 * 768 + k * 768 + (ch < 96 ? h * 96 + ch : 384 + h * 96 + (ch - 96))]; } }
#pragma unroll
    for (int q = 0; q < 7; ++q) { const int i = tid + 512 * q; rv[q] = (u32x4){0u, 0u, 0u, 0u};
        if (i < 132 * 24) { const int rr = i / 24, ck = i % 24, t = t0 - 2 + rr;
            if (t >= 0 && t < slen) { const int col = ck < 12 ? C_MQ + h * 96 + ck * 8 : C_MK + h * 96 + (ck - 12) * 8; rv[q] = *(const u32x4*)(proj + (size_t)(rowbase - 2 + rr) * PW + col); } } }
#pragma unroll
    for (int q = 0; q < 3; ++q) { const int i = tid + 512 * q, s = i / 12, ck = i % 12; vv[q] = *(const u32x4*)(proj + (size_t)(rowbase + s) * PW + C_MV + h * 96 + ck * 8); }
#pragma unroll
    for (int q = 0; q < 2; ++q) { const int i = tid + 512 * q; if (i < 5 * 192) CW[i] = cwv[q]; }
#pragma unroll
    for (int q = 0; q < 7; ++q) { const int i = tid + 512 * q; if (i < 132 * 24) { const int rr = i / 24, ck = i % 24; *(u32x4*)(RAW + rr * 192 + ck * 8) = rv[q]; } }
#pragma unroll
    for (int q = 0; q < 3; ++q) { const int i = tid + 512 * q, s = i / 12, ck = i % 12; const u32x4 v = vv[q];
        bf16_t* d = vT + (ck * 8) * 136 + s;
        d[0] = (bf16_t)(v.x & 0xFFFF); d[136] = (bf16_t)(v.x >> 16); d[2 * 136] = (bf16_t)(v.y & 0xFFFF); d[3 * 136] = (bf16_t)(v.y >> 16);
        d[4 * 136] = (bf16_t)(v.z & 0xFFFF); d[5 * 136] = (bf16_t)(v.z >> 16); d[6 * 136] = (bf16_t)(v.w & 0xFFFF); d[7 * 136] = (bf16_t)(v.w >> 16); }
    for (int i = tid; i < 16 * 128; i += 512) { const int r = i >> 7, s = i & 127; vT[(96 + r) * 136 + s] = r == 0 ? (bf16_t)0x3F80 : (bf16_t)0; }
    __syncthreads();
    if (tid < 128) {
        const float bf = pf + (tid >= 64 ? GA[4 * 128 + 0] : 0.f), bb = sf + (tid < 64 ? GA[5 * 128 + 1] : 0.f);
        GA[0 * 128 + tid] = i_f; GA[1 * 128 + tid] = bf; GA[2 * 128 + tid] = i_b; GA[3 * 128 + tid] = bb;
    }
    __syncthreads();
}

__device__ __forceinline__ void conv8(const bf16_t* RAW, const float* CW, int s0, int ch, float (&o0)[8], float (&o1)[8]) {
    float w0[5], w1[5];
#pragma unroll
    for (int i = 0; i < 5; ++i) { w0[i] = CW[i * 192 + ch]; w1[i] = CW[i * 192 + ch + 1]; }
    unsigned rv[12];
#pragma unroll
    for (int i = 0; i < 12; ++i) rv[i] = *(const unsigned*)(RAW + (s0 + i) * 192 + ch);
#pragma unroll
    for (int o = 0; o < 8; ++o) { float a0 = 0.f, a1 = 0.f;
#pragma unroll
        for (int i = 0; i < 5; ++i) { a0 += lo_bf(rv[o + i]) * w0[i]; a1 += hi_bf(rv[o + i]) * w1[i]; }
        o0[o] = siluf(a0); o1[o] = siluf(a1); }
}
__device__ __forceinline__ void mlstm_a_item(const KP& p, int l, int item, unsigned char* shm) {
    const int tid = ltid(), w = tid >> 6, lane = tid & 63, fr = lane & 15, fq = lane >> 4;
    const int jc = item % NCH, bh = item / NCH, h = bh & 3, b = bh >> 2;
    ml_stage(p, l, b, h, jc, shm);
    float* GA = (float*)(shm + ML_GA); const float* CW = (const float*)(shm + ML_CW);
    bf16_t* kwf = (bf16_t*)(shm + ML_Q); bf16_t* kwb = (bf16_t*)(shm + ML_K);
    const bf16_t* vT = (const bf16_t*)(shm + ML_VT); const bf16_t* RAW = (const bf16_t*)(shm + ML_RAW);
    const float Bf = GA[1 * 128 + 127], Bb = GA[3 * 128 + 0];
    if (tid < 128) { GA[4 * 128 + tid] = __expf(Bf - GA[1 * 128 + tid] + GA[0 * 128 + tid]); GA[5 * 128 + tid] = __expf(Bb - GA[3 * 128 + tid] + GA[2 * 128 + tid]); }
    if (tid == 0) { float* dec = (float*)(p.ws + WS_DEC); dec[(bh * 2 + 0) * NCH + jc] = __expf(Bf); dec[(bh * 2 + 1) * NCH + jc] = __expf(Bb); }
    __syncthreads();
    for (int task = tid; task < 48 * 16; task += 512) { const int cp = task % 48, s0 = (task / 48) * 8, ch = 96 + 2 * cp, dk = 2 * cp;
        float o0[8], o1[8]; conv8(RAW, CW, s0, ch, o0, o1);
        const f32x4 wfa = *(const f32x4*)(GA + 4 * 128 + s0), wfb = *(const f32x4*)(GA + 4 * 128 + s0 + 4), wba = *(const f32x4*)(GA + 5 * 128 + s0), wbb = *(const f32x4*)(GA + 5 * 128 + s0 + 4);
        u32x4 t;
        t.x = pk2(o0[0] * wfa[0], o0[1] * wfa[1]); t.y = pk2(o0[2] * wfa[2], o0[3] * wfa[3]); t.z = pk2(o0[4] * wfb[0], o0[5] * wfb[1]); t.w = pk2(o0[6] * wfb[2], o0[7] * wfb[3]); *(u32x4*)(kwf + dk * 136 + s0) = t;
        t.x = pk2(o1[0] * wfa[0], o1[1] * wfa[1]); t.y = pk2(o1[2] * wfa[2], o1[3] * wfa[3]); t.z = pk2(o1[4] * wfb[0], o1[5] * wfb[1]); t.w = pk2(o1[6] * wfb[2], o1[7] * wfb[3]); *(u32x4*)(kwf + (dk + 1) * 136 + s0) = t;
        t.x = pk2(o0[0] * wba[0], o0[1] * wba[1]); t.y = pk2(o0[2] * wba[2], o0[3] * wba[3]); t.z = pk2(o0[4] * wbb[0], o0[5] * wbb[1]); t.w = pk2(o0[6] * wbb[2], o0[7] * wbb[3]); *(u32x4*)(kwb + dk * 136 + s0) = t;
        t.x = pk2(o1[0] * wba[0], o1[1] * wba[1]); t.y = pk2(o1[2] * wba[2], o1[3] * wba[3]); t.z = pk2(o1[4] * wbb[0], o1[5] * wbb[1]); t.w = pk2(o1[6] * wbb[2], o1[7] * wbb[3]); *(u32x4*)(kwb + (dk + 1) * 136 + s0) = t; }
    __syncthreads();
    bf16_t* dC = (bf16_t*)(p.ws + WS_DC);
    for (int tix = w; tix < 84; tix += 8) { const int dir = tix / 42, tt = tix % 42, vt = tt / 6, nt = tt % 6;
        const bf16_t* kw = dir ? kwb : kwf;
        f32x4 acc = {0.f, 0.f, 0.f, 0.f};
        bf16x8 af[4], bf4[4];
#pragma unroll
        for (int ks = 0; ks < 4; ++ks) { af[ks] = *(const bf16x8*)(vT + (16 * vt + fr) * 136 + 32 * ks + 8 * fq); bf4[ks] = *(const bf16x8*)(kw + (16 * nt + fr) * 136 + 32 * ks + 8 * fq); }
        __builtin_amdgcn_sched_barrier(0);
#pragma unroll
        for (int ks = 0; ks < 4; ++ks) acc = MFMA16(af[ks], bf4[ks], acc);
        bf16_t* o = dC + ((size_t)(bh * 2 + dir) * NCH + jc) * STSZ + (16 * vt + 4 * fq) * 96 + 16 * nt + fr;
        o[0] = f2bf(acc[0]); o[96] = f2bf(acc[1]); o[192] = f2bf(acc[2]); o[288] = f2bf(acc[3]); }
    __syncthreads();
}

__device__ __forceinline__ void mlstm_scan(const KP& p) {
    const bf16_t* dC = (const bf16_t*)(p.ws + WS_DC); bf16_t* Cst = (bf16_t*)(p.ws + WS_CST); const float* dec = (const float*)(p.ws + WS_DEC);
    const int nthr = gridDim.x * 512;
    for (int wi = lbid() * 512 + ltid(); wi < 64 * (STSZ / 8); wi += nthr) {
        const int chain = wi / (STSZ / 8), e = (wi % (STSZ / 8)) * 8, dir = chain & 1;
        u32x4 dv[NCH]; float dd[NCH];
#pragma unroll
        for (int pz = 0; pz < NCH; ++pz) { const int jc = dir == 0 ? pz : (pz < 2 ? 1 - pz : NCH + 1 - pz);
            dv[pz] = *(const u32x4*)(dC + ((size_t)chain * NCH + jc) * STSZ + e); dd[pz] = dec[chain * NCH + jc]; }
        float S[8];
#pragma unroll
        for (int i = 0; i < 8; ++i) S[i] = 0.f;
#pragma unroll
        for (int pz = 0; pz < NCH; ++pz) {
            const int jc = dir == 0 ? pz : (pz < 2 ? 1 - pz : NCH + 1 - pz);
            u32x4 o; o.x = pk2(S[0], S[1]); o.y = pk2(S[2], S[3]); o.z = pk2(S[4], S[5]); o.w = pk2(S[6], S[7]);
            *(u32x4*)(Cst + ((size_t)chain * NCH + jc) * STSZ + e) = o;
            const u32x4 d = dv[pz]; const float f = dd[pz];
            S[0] = S[0] * f + lo_bf(d.x); S[1] = S[1] * f + hi_bf(d.x); S[2] = S[2] * f + lo_bf(d.y); S[3] = S[3] * f + hi_bf(d.y);
            S[4] = S[4] * f + lo_bf(d.z); S[5] = S[5] * f + hi_bf(d.z); S[6] = S[6] * f + lo_bf(d.w); S[7] = S[7] * f + hi_bf(d.w);
        }
    }
}

__device__ __forceinline__ void mlstm_c_item(const KP& p, int l, int b, int h, int jc, unsigned char* shm) {
    const int tid = ltid(), w = tid >> 6, lane = tid & 63, fr = lane & 15, fq = lane >> 4;
    const int bh = b * 4 + h;
    ml_stage(p, l, b, h, jc, shm);
    const float* GA = (const float*)(shm + ML_GA); const float* CW = (const float*)(shm + ML_CW);
    bf16_t* qL = (bf16_t*)(shm + ML_Q); bf16_t* kL = (bf16_t*)(shm + ML_K);
    const bf16_t* vT = (const bf16_t*)(shm + ML_VT); const bf16_t* RAW = (const bf16_t*)(shm + ML_RAW);
    bf16_t* CsL = (bf16_t*)(shm + ML_RAW);
    const float qscale = 0.10206207261596577f;
    u32x4 cpre[6];
    {   const bf16_t* Cst = (const bf16_t*)(p.ws + WS_CST);
#pragma unroll
        for (int i = 0; i < 6; ++i) { const int c = tid + 512 * i; if (c < 2 * 112 * 12) { const int dir = c / 1344, r = (c % 1344) / 12, ck = c % 12;
            cpre[i] = *(const u32x4*)(Cst + ((size_t)(bh * 2 + dir) * NCH + jc) * STSZ + r * 96 + ck * 8); } else cpre[i] = (u32x4){0u, 0u, 0u, 0u}; } }
    for (int task = tid; task < 96 * 16; task += 512) { const int cp = task % 96, s0 = (task / 96) * 8, ch = 2 * cp;
        float o0[8], o1[8]; conv8(RAW, CW, s0, ch, o0, o1);
        if (ch < 96) {
#pragma unroll
            for (int i = 0; i < 8; ++i) *(unsigned*)(qL + (s0 + i) * 104 + ch) = pk2(o0[i] * qscale, o1[i] * qscale);
        } else {
#pragma unroll
            for (int i = 0; i < 8; ++i) *(unsigned*)(kL + (s0 + i) * 104 + (ch - 96)) = pk2(o0[i], o1[i]); } }
    __syncthreads();
    {
        for (int i = 0; i < 6; ++i) { const int c = tid + 512 * i; if (c < 2 * 112 * 12) { const int dir = c / 1344, r = (c % 1344) / 12, ck = c % 12; *(u32x4*)(CsL + dir * (112 * 104) + r * 104 + ck * 8) = cpre[i]; } }
    }
    __syncthreads();
    const int t = 16 * w + fr;
    const int row = ml_rowbase(b, jc) + t;
    const bf16_t* proj = (const bf16_t*)(p.ws + WS_PROJ);
    u32x2 mov[6];
#pragma unroll
    for (int vt = 0; vt < 6; ++vt) mov[vt] = *(const u32x2*)(proj + (size_t)row * PW + C_MO + h * 96 + 16 * vt + 4 * fq);
    bf16x8 qf[3];
#pragma unroll
    for (int ks = 0; ks < 3; ++ks) qf[ks] = *(const bf16x8*)(qL + t * 104 + 32 * ks + 8 * fq);
    const float bft = GA[128 + t], bbt = GA[3 * 128 + t];
    bf16x8 PF[4], PB[4];
#pragma unroll
    for (int half = 0; half < 2; ++half) {
        bf16x8 kf[4][3];
#pragma unroll
        for (int i = 0; i < 4; ++i)
#pragma unroll
            for (int ks = 0; ks < 3; ++ks) kf[i][ks] = *(const bf16x8*)(kL + (16 * (4 * half + i) + fr) * 104 + 32 * ks + 8 * fq);
        __builtin_amdgcn_sched_barrier(0);
        f32x4 sa[4];
#pragma unroll
        for (int i = 0; i < 4; ++i) { sa[i] = (f32x4){0.f, 0.f, 0.f, 0.f};
#pragma unroll
            for (int ks = 0; ks < 3; ++ks) sa[i] = MFMA16(kf[i][ks], qf[ks], sa[i]); }
        __builtin_amdgcn_sched_barrier(0);
#pragma unroll
        for (int k2 = 0; k2 < 2; ++k2) {
            unsigned pf[4], pb[4];
#pragma unroll
            for (int hh = 0; hh < 2; ++hh) { const int i = 2 * k2 + hh, st = 4 * half + i;
                const int s0 = 16 * st + 4 * fq;
                const f32x4 gif = *(const f32x4*)(GA + s0), gbf = *(const f32x4*)(GA + 128 + s0), gib = *(const f32x4*)(GA + 256 + s0), gbb = *(const f32x4*)(GA + 384 + s0);
                float vf[4], vb[4];
#pragma unroll
                for (int j = 0; j < 4; ++j) { const int s = s0 + j;
                    vf[j] = (s <= t) ? sa[i][j] * __expf(bft - gbf[j] + gif[j]) : 0.f;
                    vb[j] = (s >= t) ? sa[i][j] * __expf(bbt - gbb[j] + gib[j]) : 0.f; }
                pf[2 * hh] = pk2(vf[0], vf[1]); pf[2 * hh + 1] = pk2(vf[2], vf[3]); pb[2 * hh] = pk2(vb[0], vb[1]); pb[2 * hh + 1] = pk2(vb[2], vb[3]); }
            u32x4 tf = {pf[0], pf[1], pf[2], pf[3]}, tb = {pb[0], pb[1], pb[2], pb[3]};
            PF[2 * half + k2] = __builtin_bit_cast(bf16x8, tf); PB[2 * half + k2] = __builtin_bit_cast(bf16x8, tb);
        }
    }
    const float ebf = __expf(bft), ebb = __expf(bbt);
    f32x4 nf[7], nb[7];
#pragma unroll
    for (int vt = 0; vt < 7; ++vt) {
        bf16x8 cf[3], cb[3]; u32x2 vlo[4], vhi[4];
#pragma unroll
        for (int ks = 0; ks < 3; ++ks) { cf[ks] = *(const bf16x8*)(CsL + (16 * vt + fr) * 104 + 32 * ks + 8 * fq); cb[ks] = *(const bf16x8*)(CsL + 112 * 104 + (16 * vt + fr) * 104 + 32 * ks + 8 * fq); }
#pragma unroll
        for (int kk = 0; kk < 4; ++kk) { vlo[kk] = *(const u32x2*)(vT + (16 * vt + fr) * 136 + 32 * kk + 4 * fq); vhi[kk] = *(const u32x2*)(vT + (16 * vt + fr) * 136 + 32 * kk + 16 + 4 * fq); }
        __builtin_amdgcn_sched_barrier(0);
        f32x4 af = {0.f, 0.f, 0.f, 0.f}, ab = {0.f, 0.f, 0.f, 0.f};
#pragma unroll
        for (int ks = 0; ks < 3; ++ks) { af = MFMA16(cf[ks], qf[ks], af); ab = MFMA16(cb[ks], qf[ks], ab); }
        af *= ebf; ab *= ebb;
#pragma unroll
        for (int kk = 0; kk < 4; ++kk) { const bf16x8 a = mk8(vlo[kk], vhi[kk]); af = MFMA16(a, PF[kk], af); ab = MFMA16(a, PB[kk], ab); }
        nf[vt] = af; nb[vt] = ab;
    }
    const float denf = __shfl(nf[6][0], fr), denb = __shfl(nb[6][0], fr);
    const float rf = 1.f / fmaxf(fabsf(denf), 1.f), rb = 1.f / fmaxf(fabsf(denb), 1.f);
    float ss = 0.f;
#pragma unroll
    for (int vt = 0; vt < 6; ++vt) { nf[vt] = nf[vt] * rf + nb[vt] * rb; ss += nf[vt][0] * nf[vt][0] + nf[vt][1] * nf[vt][1] + nf[vt][2] * nf[vt][2] + nf[vt][3] * nf[vt][3]; }
    ss = sum_over_fq(ss);
    const float rn = rsqrtf(ss * (1.f / 96.f) + EPS);
    bf16_t* mix = (bf16_t*)(p.ws + WS_MIX);
    const float* gm = p.in[I_GM] + l * 384 + h * 96;
#pragma unroll
    for (int vt = 0; vt < 6; ++vt) { const int vc = 16 * vt + 4 * fq;
        const u32x2 mo = mov[vt]; const f32x4 g = *(const f32x4*)(gm + vc);
        const float m0 = lo_bf(mo.x), m1 = hi_bf(mo.x), m2 = lo_bf(mo.y), m3 = hi_bf(mo.y);
        const float y0 = nf[vt][0] * rn * g[0] / (1.f + __expf(-m0)), y1 = nf[vt][1] * rn * g[1] / (1.f + __expf(-m1));
        const float y2 = nf[vt][2] * rn * g[2] / (1.f + __expf(-m2)), y3 = nf[vt][3] * rn * g[3] / (1.f + __expf(-m3));
        u32x2 o; o.x = pk2(y0, y1); o.y = pk2(y2, y3);
        *(u32x2*)(mix + (size_t)row * D + 256 + h * 96 + vc) = o; }
    __syncthreads();
}

__device__ __forceinline__ void zt_fold_item(const KP& p, int item, unsigned char* shm) {
    const int tid = ltid(), w = tid >> 6, lane = tid & 63;
    const int col = item * 8 + w;
    const bf16_t* zr = (const bf16_t*)(p.ws + WS_ZT) + (size_t)col * 4096;
    bf16_t* la = (bf16_t*)(shm + w * 8192); bf16_t* lb = la + 2048;
#pragma unroll
    for (int q = 0; q < 4; ++q) { *(u32x4*)(la + (q * 64 + lane) * 8) = *(const u32x4*)(zr + (q * 64 + lane) * 8); *(u32x4*)(lb + (q * 64 + lane) * 8) = *(const u32x4*)(zr + 2048 + (q * 64 + lane) * 8); }
    asm volatile("s_waitcnt vmcnt(0) lgkmcnt(0)" ::: "memory");
    bf16_t* out = (bf16_t*)(p.ws + WS_ZTF) + (size_t)col * 2048;
#pragma unroll
    for (int q = 0; q < 4; ++q) { const int j0 = (q * 64 + lane) * 8; unsigned o[4];
#pragma unroll
        for (int e2 = 0; e2 < 4; ++e2) { float v[2];
#pragma unroll
            for (int e = 0; e < 2; ++e) { const int j = j0 + 2 * e2 + e;
                if (j == 0 || j == 1024) v[e] = bf2f(la[j]);
                else if (j < 1024) v[e] = bf2f(la[j]) + bf2f(la[2048 - j]);
                else { const int n = j - 1024; v[e] = bf2f(lb[n]) - bf2f(lb[2048 - n]); } }
            o[e2] = pk2(v[0], v[1]); }
        u32x4 ov = {o[0], o[1], o[2], o[3]};
        *(u32x4*)(out + j0) = ov; }
    asm volatile("s_waitcnt lgkmcnt(0)" ::: "memory");
}

__device__ __forceinline__ void rope_cs_tab(const float* rt, int tpos, int seg, int f, float& cs, float& sn) { const float2 v = *(const float2*)(rt + ((tpos * 2 + seg) * 8 + f) * 2); cs = v.x; sn = v.y; }
__device__ __forceinline__ void rope_cs(int tpos, int seg, int f, float& cs, float& sn) {
    const float pos = (float)(seg == 0 ? (tpos >> 6) : (tpos & 63));
    const float fr = exp2f(-(float)f * 1.6609640474436813f);
    sincosf(pos * fr, &sn, &cs);
}
__device__ __forceinline__ void qkv_item(const KP& p, int l, int item, unsigned char* shm) {
    const int tid = ltid(), w = tid >> 6, lane = tid & 63, fr = lane & 15, fq = lane >> 4;
    const int r0 = item * 64; const bool lat = r0 < TL;
    const int b = lat ? (r0 >> 11) : ((r0 - TL) >> 8), tl0 = lat ? (r0 & 2047) : ((r0 - TL) & 255), key0 = lat ? tl0 : SEQ + tl0;
    const bf16_t* proj = (const bf16_t*)(p.ws + WS_PROJ); const float* rt = (const float*)(p.ws + WS_ROPE);
    bf16_t* aq = (bf16_t*)shm; bf16_t* akv = (bf16_t*)(shm + 64 * 264 * 2);
    {
        const int tk = tid >> 3, sub = tid & 7; const bf16_t* pr = proj + (size_t)(r0 + tk) * PW;
        u32x4 cq[4], ck[2]; float sq = 0.f, sk = 0.f;
#pragma unroll
        for (int i = 0; i < 4; ++i) { cq[i] = *(const u32x4*)(pr + C_CQ + sub * 32 + i * 8);
#pragma unroll
            for (int e = 0; e < 4; ++e) { const float a = lo_bf(cq[i][e]), c = hi_bf(cq[i][e]); sq += a * a + c * c; } }
#pragma unroll
        for (int i = 0; i < 2; ++i) { ck[i] = *(const u32x4*)(pr + C_CKV + sub * 16 + i * 8);
#pragma unroll
            for (int e = 0; e < 4; ++e) { const float a = lo_bf(ck[i][e]), c = hi_bf(ck[i][e]); sk += a * a + c * c; } }
        sq += __shfl_xor(sq, 1); sq += __shfl_xor(sq, 2); sq += __shfl_xor(sq, 4);
        sk += __shfl_xor(sk, 1); sk += __shfl_xor(sk, 2); sk += __shfl_xor(sk, 4);
        const float rq = rsqrtf(sq * (1.f / 256.f) + EPS), rk = rsqrtf(sk * (1.f / 128.f) + EPS);
        const float* gq = p.in[I_GQN] + l * 256 + sub * 32; const float* gk = p.in[I_GKVN] + l * 128 + sub * 16;
#pragma unroll
        for (int i = 0; i < 4; ++i) { u32x4 o;
#pragma unroll
            for (int e = 0; e < 4; ++e) o[e] = pk2(lo_bf(cq[i][e]) * rq * gq[i * 8 + 2 * e], hi_bf(cq[i][e]) * rq * gq[i * 8 + 2 * e + 1]);
            *(u32x4*)(aq + tk * 264 + sub * 32 + i * 8) = o; }
#pragma unroll
        for (int i = 0; i < 2; ++i) { u32x4 o;
#pragma unroll
            for (int e = 0; e < 4; ++e) o[e] = pk2(lo_bf(ck[i][e]) * rk * gk[i * 8 + 2 * e], hi_bf(ck[i][e]) * rk * gk[i * 8 + 2 * e + 1]);
            *(u32x4*)(akv + tk * 136 + sub * 16 + i * 8) = o; }
    }
    bf16_t* Qb = (bf16_t*)(p.ws + WS_QB); bf16_t* Kb = (bf16_t*)(p.ws + WS_KB); bf16_t* Vt = (bf16_t*)(p.ws + WS_VT);
    {
        const int tk = tid >> 3, i0 = (tid & 7) * 4, seg = i0 >> 4, half = (i0 >> 3) & 1, f0 = i0 & 7;
        const bf16_t* pr = proj + (size_t)(r0 + tk) * PW + C_KR;
        const u32x2 me = *(const u32x2*)(pr + i0), pa = *(const u32x2*)(pr + (i0 ^ 8));
        float mv[4] = {lo_bf(me.x), hi_bf(me.x), lo_bf(me.y), hi_bf(me.y)}, pv[4] = {lo_bf(pa.x), hi_bf(pa.x), lo_bf(pa.y), hi_bf(pa.y)}, ov[4];
#pragma unroll
        for (int j = 0; j < 4; ++j) {
            if (lat) { float cs, sn; rope_cs_tab(rt, tl0 + tk, seg, f0 + j, cs, sn); ov[j] = half ? (pv[j] * sn + mv[j] * cs) : (mv[j] * cs - pv[j] * sn); }
            else ov[j] = mv[j]; }
        u32x2 o; o.x = pk2(ov[0], ov[1]); o.y = pk2(ov[2], ov[3]);
#pragma unroll
        for (int hh = 0; hh < 4; ++hh) *(u32x2*)(Kb + ((size_t)(b * 4 + hh) * KEYS + key0 + tk) * 96 + 64 + i0) = o;
    }
    __syncthreads();
    const bf16_t* WuqT = (const bf16_t*)(p.ws + WS_WUQ); const bf16_t* WukvT = (const bf16_t*)(p.ws + WS_WUKV);
    const float qs = 0.10206207261596577f * 1.4426950408889634f;
    for (int ct = w; ct < 24; ct += 8) {
        f32x4 acc[4];
#pragma unroll
        for (int tt = 0; tt < 4; ++tt) acc[tt] = (f32x4){0.f, 0.f, 0.f, 0.f};
        bf16x8 wa[8];
#pragma unroll
        for (int ks = 0; ks < 8; ++ks) wa[ks] = *(const bf16x8*)(WuqT + (size_t)(16 * ct + fr) * 256 + 32 * ks + 8 * fq);
#pragma unroll
        for (int kh = 0; kh < 4; ++kh) { bf16x8 bb[2][4];
#pragma unroll
            for (int k2 = 0; k2 < 2; ++k2)
#pragma unroll
                for (int tt = 0; tt < 4; ++tt) bb[k2][tt] = *(const bf16x8*)(aq + (16 * tt + fr) * 264 + 32 * (2 * kh + k2) + 8 * fq);
            __builtin_amdgcn_sched_barrier(0);
#pragma unroll
            for (int k2 = 0; k2 < 2; ++k2)
#pragma unroll
                for (int tt = 0; tt < 4; ++tt) acc[tt] = MFMA16(wa[2 * kh + k2], bb[k2][tt], acc[tt]); }
        const int hq = ct / 6, dt = ct % 6;
#pragma unroll
        for (int tt = 0; tt < 4; ++tt) { const int tk = 16 * tt + fr; f32x4 v = acc[tt];
            if (dt >= 4 && lat) { const int seg = dt - 4, half = fq >> 1;
#pragma unroll
                for (int j = 0; j < 4; ++j) { const float pa = __shfl_xor(v[j], 32); float cs, sn; rope_cs_tab(rt, tl0 + tk, seg, 4 * (fq & 1) + j, cs, sn);
                    v[j] = half ? (pa * sn + v[j] * cs) : (v[j] * cs - pa * sn); } }
            u32x2 o; o.x = pk2(v[0] * qs, v[1] * qs); o.y = pk2(v[2] * qs, v[3] * qs);
            *(u32x2*)(Qb + ((size_t)(b * 4 + hq) * KEYS + key0 + tk) * 96 + 16 * dt + 4 * fq) = o; }
    }
    for (int ct = w; ct < 40; ct += 8) {
        const int hk = ct / 10, dt = ct % 10;
        f32x4 acc[4];
#pragma unroll
        for (int tt = 0; tt < 4; ++tt) acc[tt] = (f32x4){0.f, 0.f, 0.f, 0.f};
        bf16x8 wa[4];
#pragma unroll
        for (int ks = 0; ks < 4; ++ks) wa[ks] = *(const bf16x8*)(WukvT + (size_t)(16 * ct + fr) * 128 + 32 * ks + 8 * fq);
#pragma unroll
        for (int kh = 0; kh < 2; ++kh) { bf16x8 bb[2][4];
#pragma unroll
            for (int k2 = 0; k2 < 2; ++k2)
#pragma unroll
                for (int tt = 0; tt < 4; ++tt) bb[k2][tt] = *(const bf16x8*)(akv + (16 * tt + fr) * 136 + 32 * (2 * kh + k2) + 8 * fq);
            __builtin_amdgcn_sched_barrier(0);
#pragma unroll
            for (int k2 = 0; k2 < 2; ++k2)
#pragma unroll
                for (int tt = 0; tt < 4; ++tt) acc[tt] = dt < 4 ? MFMA16(wa[2 * kh + k2], bb[k2][tt], acc[tt]) : MFMA16(bb[k2][tt], wa[2 * kh + k2], acc[tt]); }
#pragma unroll
        for (int tt = 0; tt < 4; ++tt) { const f32x4 v = acc[tt]; u32x2 o; o.x = pk2(v[0], v[1]); o.y = pk2(v[2], v[3]);
            if (dt < 4) *(u32x2*)(Kb + ((size_t)(b * 4 + hk) * KEYS + key0 + 16 * tt + fr) * 96 + 16 * dt + 4 * fq) = o;
            else *(u32x2*)(Vt + ((size_t)(b * 4 + hk) * 96 + 16 * (dt - 4) + fr) * KEYS + key0 + 32 * (tt >> 1) + 8 * fq + 4 * (tt & 1)) = o; }
    }
    __syncthreads();
}

template <int VAR>
__device__ __forceinline__ void attn_item(const KP& p, int item, unsigned char* shm) {
    const int tid = ltid(), w = tid >> 6, lane = tid & 63, fr = lane & 15, fq = lane >> 4;
    const int qb = item < 256 ? (item & 7) : 8, bh = item < 256 ? (item >> 3) : item - 256, b = bh >> 2, h = bh & 3;
    const int kbeg = qb < 8 ? 0 : SEQ, ntile = qb < 8 ? KEYS / 64 : CL / 64;
    const bf16_t* Qb = (const bf16_t*)(p.ws + WS_QB) + (size_t)bh * KEYS * 96;
    const bf16_t* Kb = (const bf16_t*)(p.ws + WS_KB) + (size_t)bh * KEYS * 96;
    const bf16_t* Vt = (const bf16_t*)(p.ws + WS_VT) + (size_t)bh * 96 * KEYS;
    const int q0 = qb * 256 + 32 * w;
    bf16x8 qf[2][3];
#pragma unroll
    for (int qt = 0; qt < 2; ++qt)
#pragma unroll
        for (int ks = 0; ks < 3; ++ks) qf[qt][ks] = *(const bf16x8*)(Qb + (size_t)(q0 + 16 * qt + fr) * 96 + 32 * ks + 8 * fq);
    f32x4 O[6][2];
#pragma unroll
    for (int dt = 0; dt < 6; ++dt) { O[dt][0] = (f32x4){0.f, 0.f, 0.f, 0.f}; O[dt][1] = (f32x4){0.f, 0.f, 0.f, 0.f}; }
    float mrow[2] = {-1e30f, -1e30f}, lrow[2] = {0.f, 0.f};
    u32x4 pre[6];
    constexpr int ABUF = (64 * 104 + 96 * 72) * 2;
    auto gload = [&](int kp) {
#pragma unroll
        for (int sub = 0; sub < 2; ++sub) { const int key0 = kbeg + (2 * kp + sub) * 64;
#pragma unroll
            for (int i = 0; i < 3; ++i) { const int c = tid + 512 * i;
                if (c < 768) pre[3 * sub + i] = *(const u32x4*)(Kb + (size_t)key0 * 96 + c * 8);
                else { const int cc = c - 768, dv = cc >> 3, part = cc & 7; pre[3 * sub + i] = *(const u32x4*)(Vt + (size_t)dv * KEYS + key0 + part * 8); } } }
    };
    auto lstore = [&](int buf) {
#pragma unroll
        for (int sub = 0; sub < 2; ++sub) { bf16_t* Kw = (bf16_t*)(shm + (2 * buf + sub) * ABUF); bf16_t* Vw = Kw + 64 * 104;
#pragma unroll
            for (int i = 0; i < 3; ++i) { const int c = tid + 512 * i;
                if (c < 768) { const int key = c / 12, part = c % 12; *(u32x4*)(Kw + key * 104 + part * 8) = pre[3 * sub + i]; }
                else { const int cc = c - 768, dv = cc >> 3, part = cc & 7; *(u32x4*)(Vw + dv * 72 + part * 8) = pre[3 * sub + i]; } } }
    };
    const int npair = ntile >> 1;
    gload(0);
    lstore(0);
    __syncthreads();
    if (npair > 1) gload(1);
    for (int kp = 0; kp < npair; ++kp) {
#pragma unroll
      for (int sub = 0; sub < 2; ++sub) {
        const bf16_t* Kc = (const bf16_t*)(shm + (2 * (kp & 1) + sub) * ABUF); const bf16_t* Vc = Kc + 64 * 104;
        bf16x8 kf[4][3];
#pragma unroll
        for (int kk = 0; kk < 4; ++kk)
#pragma unroll
            for (int ks = 0; ks < 3; ++ks) kf[kk][ks] = *(const bf16x8*)(Kc + (16 * kk + fr) * 104 + 32 * ks + 8 * fq);
        __builtin_amdgcn_sched_barrier(0);
        f32x4 S[4][2];
#pragma unroll
        for (int kk = 0; kk < 4; ++kk) { S[kk][0] = (f32x4){0.f, 0.f, 0.f, 0.f}; S[kk][1] = (f32x4){0.f, 0.f, 0.f, 0.f}; }
        bf16x8 P[2][2];
        auto softmax_qt = [&](const int qt) {
            float mx = S[0][qt][0];
#pragma unroll
            for (int kk = 0; kk < 4; ++kk)
#pragma unroll
                for (int j = 0; j < 4; ++j) mx = fmaxf(mx, S[kk][qt][j]);
            mx = max_over_fq(mx);
            if (__any(mx > mrow[qt] + 8.f)) {
                const float mnew = fmaxf(mrow[qt], mx), alpha = __builtin_amdgcn_exp2f(mrow[qt] - mnew); mrow[qt] = mnew;
                lrow[qt] *= alpha;
#pragma unroll
                for (int dt = 0; dt < 6; ++dt) O[dt][qt] *= alpha;
            }
            const float mn = mrow[qt];
            float ps = 0.f; unsigned pk[8];
#pragma unroll
            for (int kk = 0; kk < 4; ++kk) { const float e0 = __builtin_amdgcn_exp2f(S[kk][qt][0] - mn), e1 = __builtin_amdgcn_exp2f(S[kk][qt][1] - mn), e2 = __builtin_amdgcn_exp2f(S[kk][qt][2] - mn), e3 = __builtin_amdgcn_exp2f(S[kk][qt][3] - mn);
                ps += (e0 + e1) + (e2 + e3); pk[2 * kk] = pk2(e0, e1); pk[2 * kk + 1] = pk2(e2, e3); }
            lrow[qt] += ps;
            u32x4 t0 = {pk[0], pk[1], pk[2], pk[3]}, t1 = {pk[4], pk[5], pk[6], pk[7]};
            P[qt][0] = __builtin_bit_cast(bf16x8, t0); P[qt][1] = __builtin_bit_cast(bf16x8, t1);
        };
#pragma unroll
        for (int ks = 0; ks < 3; ++ks)
#pragma unroll
            for (int kk = 0; kk < 4; ++kk) S[kk][0] = MFMA16(kf[kk][ks], qf[0][ks], S[kk][0]);
        __builtin_amdgcn_sched_barrier(0);
#pragma unroll
        for (int ks = 0; ks < 3; ++ks)
#pragma unroll
            for (int kk = 0; kk < 4; ++kk) S[kk][1] = MFMA16(kf[kk][ks], qf[1][ks], S[kk][1]);
        softmax_qt(0);
        __builtin_amdgcn_sched_barrier(0);
        bf16x8 vf[6][2];
#pragma unroll
        for (int dt = 0; dt < 6; ++dt)
#pragma unroll
            for (int k2 = 0; k2 < 2; ++k2) vf[dt][k2] = *(const bf16x8*)(Vc + (16 * dt + fr) * 72 + 32 * k2 + 8 * fq);
        __builtin_amdgcn_sched_barrier(0);
#pragma unroll
        for (int dt = 0; dt < 6; ++dt)
#pragma unroll
            for (int k2 = 0; k2 < 2; ++k2) O[dt][0] = MFMA16(vf[dt][k2], P[0][k2], O[dt][0]);
        softmax_qt(1);
        __builtin_amdgcn_sched_barrier(0);
#pragma unroll
        for (int dt = 0; dt < 6; ++dt)
#pragma unroll
            for (int k2 = 0; k2 < 2; ++k2) O[dt][1] = MFMA16(vf[dt][k2], P[1][k2], O[dt][1]);
      }
        if (kp + 1 < npair) lstore((kp + 1) & 1);
        __syncthreads();
        if (kp + 2 < npair) gload(kp + 2);
    }
    bf16_t* mix = (bf16_t*)(p.ws + WS_MIX);
#pragma unroll
    for (int qt = 0; qt < 2; ++qt) { float lt = lrow[qt]; lt += __shfl_xor(lt, 16); lt += __shfl_xor(lt, 32); const float inv = 1.f / lt;
        const int q = q0 + 16 * qt + fr; const size_t row = q < SEQ ? (size_t)b * SEQ + q : (size_t)TL + b * CL + (q - SEQ);
#pragma unroll
        for (int dt = 0; dt < 6; ++dt) { const f32x4 v = O[dt][qt] * inv; u32x2 o; o.x = pk2(v[0], v[1]); o.y = pk2(v[2], v[3]);
            *(u32x2*)(mix + row * D + 640 + h * 96 + 16 * dt + 4 * fq) = o; } }
    __syncthreads();
}


#ifdef DIAG
__device__ __forceinline__ float block_max(float v, float* red) {
    const int tid = ltid();
#pragma unroll
    for (int o = 1; o < 64; o <<= 1) v = fmaxf(v, __shfl_xor(v, o));
    __syncthreads(); if ((tid & 63) == 0) red[tid >> 6] = v; __syncthreads();
    float r = red[0];
#pragma unroll
    for (int i = 1; i < 8; ++i) r = fmaxf(r, red[i]);
    __syncthreads(); return r;
}
__device__ __forceinline__ float block_sum(float v, float* red) {
    const int tid = ltid();
    v = wave_sum(v);
    __syncthreads(); if ((tid & 63) == 0) red[tid >> 6] = v; __syncthreads();
    float r = 0.f;
#pragma unroll
    for (int i = 0; i < 8; ++i) r += red[i];
    __syncthreads(); return r;
}
__device__ __forceinline__ float dg_conv(const KP& p, int l, int rbase, int slen, int t, int chg) {
    const bf16_t* proj = (const bf16_t*)(p.ws + WS_PROJ); float a = 0.f;
    for (int i = 0; i < 5; ++i) { const int tt = t - 2 + i; if (tt < 0 || tt >= slen) continue;
        a += bf2f(proj[(size_t)(rbase + tt) * PW + chg]) * p.in[I_CONV][(size_t)l * 5 * 768 + i * 768 + chg]; }
    return siluf(a);
}
__device__ __forceinline__ float diag_mlstm(const KP& p, int l, int b, int h, int tsel, unsigned char* shm) {
    const int tid = ltid();
    float* Ff = (float*)shm; float* Gb = Ff + 2304; float* If = Gb + 2304; float* Ib = If + 2304; float* Wf = Ib + 2304; float* Wb = Wf + 2304; float* qt = Wb + 2304; float* red = qt + 96; float* yr = red + 16;
    const float* gates = (const float*)(p.ws + WS_GATES); const float* bg = p.in[I_BG] + l * 16;
    const bf16_t* proj = (const bf16_t*)(p.ws + WS_PROJ);
    for (int pos = tid; pos < 2304; pos += 512) { const int row = pos < 256 ? TL + b * CL + pos : b * SEQ + (pos - 256); const float* gp = gates + (size_t)row * 16;
        const int pb = pos < 256 ? 2048 + pos : pos - 256;
        If[pos] = gp[h] + bg[h]; Ff[pos] = logsig(gp[4 + h] + bg[4 + h]); Ib[pb] = gp[8 + h] + bg[8 + h]; Gb[pb] = logsig(gp[12 + h] + bg[12 + h]); }
    __syncthreads();
    if (tid == 0) { float a = 0.f; for (int i = 0; i < 2304; ++i) { a += Ff[i]; Ff[i] = a; } a = 0.f; for (int i = 2303; i >= 0; --i) { a += Gb[i]; Gb[i] = a; } }
    if (tid < 96) qt[tid] = dg_conv(p, l, b * SEQ, SEQ, tsel, h * 96 + tid) * 0.10206207261596577f;
    __syncthreads();
    const int tf = 256 + tsel, tb = tsel;
    for (int pos = tid; pos < 2304; pos += 512) { const bool isc = pos < 256; const int rbase = isc ? TL + b * CL : b * SEQ, slen = isc ? CL : SEQ, t = isc ? pos : pos - 256;
        float dot = 0.f; for (int d = 0; d < 96; ++d) dot += qt[d] * dg_conv(p, l, rbase, slen, t, 384 + h * 96 + d);
        const int pb = isc ? 2048 + pos : pos - 256;
        Wf[pos] = pos <= tf ? dot * __expf(Ff[tf] - Ff[pos] + If[pos]) : 0.f;
        Wb[pos] = pb >= tb ? dot * __expf(Gb[tb] - Gb[pb] + Ib[pb]) : 0.f; }
    __syncthreads();
    float hv = 0.f;
    if (tid < 96) { float nf = 0.f, nb = 0.f, df = 0.f, db = 0.f;
        for (int pos = 0; pos < 2304; ++pos) { const int row = pos < 256 ? TL + b * CL + pos : b * SEQ + (pos - 256); const float v = bf2f(proj[(size_t)row * PW + C_MV + h * 96 + tid]);
            nf += Wf[pos] * v; nb += Wb[pos] * v; df += Wf[pos]; db += Wb[pos]; }
        hv = nf / fmaxf(fabsf(df), 1.f) + nb / fmaxf(fabsf(db), 1.f); }
    const float ss = block_sum(tid < 96 ? hv * hv : 0.f, red);
    float diff = 0.f;
    if (tid < 96) { const int row = b * SEQ + tsel; const float mo = bf2f(proj[(size_t)row * PW + C_MO + h * 96 + tid]);
        const float y = hv * rsqrtf(ss * (1.f / 96.f) + EPS) * p.in[I_GM][l * 384 + h * 96 + tid] / (1.f + __expf(-mo));
        const float yf = bf2f(((const bf16_t*)(p.ws + WS_MIX))[(size_t)row * D + 256 + h * 96 + tid]);
        diff = fabsf(y - yf); }
    return block_max(diff, red);
}
__device__ __forceinline__ float diag_attn(const KP& p, int l, int b, int h, int qsel, unsigned char* shm) {
    const int tid = ltid();
    float* sc = (float*)shm; float* qv = sc + 2304; float* red = qv + 96; float* nq = red + 16;
    float* Vs = (float*)(p.ws + WS_HID + 100000000);
    const bf16_t* proj = (const bf16_t*)(p.ws + WS_PROJ);
    const float* wuq = p.in[I_WUQ] + (size_t)l * 256 * 384; const float* wukv = p.in[I_WUKV] + (size_t)l * 128 * 640;
    const int qrow = b * SEQ + qsel;
    { float v = tid < 256 ? bf2f(proj[(size_t)qrow * PW + C_CQ + tid]) : 0.f; const float ss = block_sum(v * v, red);
      if (tid < 256) nq[tid] = v * rsqrtf(ss * (1.f / 256.f) + EPS) * p.in[I_GQN][l * 256 + tid]; }
    __syncthreads();
    if (tid < 96) { float a = 0.f; for (int k = 0; k < 256; ++k) a += nq[k] * wuq[(size_t)k * 384 + h * 96 + tid]; qv[tid] = a; }
    __syncthreads();
    if (tid < 16) {
        const int seg = tid >> 3, f = tid & 7; float cs, sn; rope_cs(qsel, seg, f, cs, sn);
        const float x1 = qv[64 + seg * 16 + f], x2 = qv[64 + seg * 16 + 8 + f]; qv[64 + seg * 16 + f] = x1 * cs - x2 * sn; qv[64 + seg * 16 + 8 + f] = x1 * sn + x2 * cs; }
    __syncthreads();
    for (int key = tid; key < 2304; key += 512) { const bool lat = key < SEQ; const int row = lat ? b * SEQ + key : TL + b * CL + (key - SEQ);
        const bf16_t* pr = proj + (size_t)row * PW;
        float ss = 0.f; for (int k = 0; k < 128; ++k) { const float v = bf2f(pr[C_CKV + k]); ss += v * v; }
        const float rk = rsqrtf(ss * (1.f / 128.f) + EPS);
        float s = 0.f;
        for (int c = 0; c < 160; ++c) { float a = 0.f; for (int k = 0; k < 128; ++k) a += bf2f(pr[C_CKV + k]) * rk * p.in[I_GKVN][l * 128 + k] * wukv[(size_t)k * 640 + h * 160 + c];
            if (c < 64) s += qv[c] * a; else Vs[(size_t)key * 96 + (c - 64)] = a; }
        for (int seg = 0; seg < 2; ++seg) for (int f = 0; f < 8; ++f) { float x1 = bf2f(pr[C_KR + seg * 16 + f]), x2 = bf2f(pr[C_KR + seg * 16 + 8 + f]);
            if (lat) { float cs, sn; rope_cs(key, seg, f, cs, sn); const float o1 = x1 * cs - x2 * sn, o2 = x1 * sn + x2 * cs; x1 = o1; x2 = o2; }
            s += qv[64 + seg * 16 + f] * x1 + qv[64 + seg * 16 + 8 + f] * x2; }
        sc[key] = s * 0.10206207261596577f; }
    __syncthreads();
    float mx = -1e30f; for (int key = tid; key < 2304; key += 512) mx = fmaxf(mx, sc[key]); mx = block_max(mx, red);
    float sm = 0.f; for (int key = tid; key < 2304; key += 512) { const float e = __expf(sc[key] - mx); sc[key] = e; sm += e; } sm = block_sum(sm, red);
    __threadfence(); __syncthreads();
    float diff = 0.f;
    if (tid < 96) { float a = 0.f; for (int key = 0; key < 2304; ++key) a += sc[key] * Vs[(size_t)key * 96 + tid]; a /= sm;
        const float yf = bf2f(((const bf16_t*)(p.ws + WS_MIX))[(size_t)qrow * D + 640 + h * 96 + tid]); diff = fabsf(a - yf); }
    return block_max(diff, red);
}

__device__ __forceinline__ float diag_fourier(const KP& p, int b, int g, unsigned char* shm) {
    const int tid = ltid();
    float* hrow = (float*)shm; float* red = hrow + 1024;
    float* pf = (float*)(p.ws + WS_HID + 100000000);
    const float* mod = (const float*)(p.ws + WS_MOD) + (size_t)b * 6144;
    for (int n = 0; n < 2048; ++n) {
        const float* xr = p.in[I_X] + ((size_t)b * SEQ + n) * D;
        const float x0 = xr[tid], x1 = xr[tid + 512];
        const float ss = block_sum(x0 * x0 + x1 * x1, red); const float rstd = rsqrtf(ss * (1.f / D) + EPS);
        hrow[tid] = x0 * rstd * p.in[I_G1][tid] * (1.f + mod[1024 + tid]) + mod[tid];
        hrow[tid + 512] = x1 * rstd * p.in[I_G1][tid + 512] * (1.f + mod[1024 + tid + 512]) + mod[tid + 512];
        __syncthreads();
        { const int c = tid & 63, ks = tid >> 6; float a = 0.f;
          for (int k = ks * 128; k < ks * 128 + 128; ++k) a += hrow[k] * p.in[I_WIN][(size_t)k * 2224 + g * 64 + c];
          red[16 + ks * 64 + c] = a; }
        __syncthreads();
        if (tid < 64) { float a = 0.f; for (int q = 0; q < 8; ++q) a += red[16 + q * 64 + tid]; pf[n * 64 + tid] = a; }
        __syncthreads();
    }
    __threadfence(); __syncthreads();
    float worst = 0.f;
#pragma unroll 1
    for (int i = 0; i < 6; ++i) { const int k = i == 0 ? 0 : i == 1 ? 1 : i == 2 ? 5 : i == 3 ? 1000 : i == 4 ? 1024 : 2047;
        const int cp = tid & 63, ns = tid >> 6; float a = 0.f;
        for (int n = ns * 256; n < ns * 256 + 256; ++n) for (int c = 0; c < 64; ++c) { const int idx = (k * n + 32 * c * cp) & 2047; a += pf[n * 64 + c] * cospif((float)idx * (1.f / 1024.f)); }
        __syncthreads(); red[16 + ns * 64 + cp] = a; __syncthreads();
        float diff = 0.f;
        if (tid < 64) { float y = 0.f; for (int q = 0; q < 8; ++q) y += red[16 + q * 64 + tid]; y *= 0.00276213586400995f;
            const float yf = bf2f(((const bf16_t*)(p.ws + WS_MIX))[((size_t)b * SEQ + k) * D + g * 64 + tid]); diff = fabsf(y - yf); }
        worst = fmaxf(worst, block_max(diff, red));
    }
    return worst;
}

__device__ __forceinline__ int dg_row(int i) { return i == 0 ? 0 : i == 1 ? 1 : i == 2 ? 255 : i == 3 ? 256 : i == 4 ? 5000 : i == 5 ? 16383 : i == 6 ? 16384 : 18431; }
__device__ __forceinline__ float diag_g2(const KP& p, int i, unsigned char* shm) {
    const int tid = ltid(); float* red = (float*)shm;
    const int r = dg_row(i), b = r < TL ? r >> 11 : 8;
    const bf16_t* mr = (const bf16_t*)(p.ws + WS_MIX) + (size_t)r * D;
    const float* xo = r < TL ? p.in[I_X] + (size_t)r * D : p.in[I_CTX] + (size_t)(r - TL) * D;
    const float* xn = r < TL ? p.out + (size_t)r * D : (const float*)(p.ws + WS_XCTX) + (size_t)(r - TL) * D;
    const float* mod = (const float*)(p.ws + WS_MOD);
    float diff = 0.f;
    for (int c = tid; c < 1024; c += 512) { float a = 0.f; for (int j = 0; j < 1024; ++j) a += bf2f(mr[j]) * p.in[I_WOUT][(size_t)j * 1024 + c];
        diff = fmaxf(diff, fabsf(xo[c] + mod[(size_t)b * 6144 + 2048 + c] * a - xn[c])); }
#ifdef DIAG_MODONLY
    diff = 0.f;
#endif
#ifndef DIAG_G2ONLY
    { const int l = i & 1, j = (37 * tid + 11 * i) % 6144; float a = 0.f;
      for (int k = 0; k < 1024; ++k) { const float cv = b < 8 ? p.in[I_C][b * 1024 + k] : p.in[I_CCTX][k]; a += siluf(cv) * p.in[I_WMOD][(size_t)l * 1024 * 6144 + (size_t)k * 6144 + j]; }
      a += p.in[I_BMOD][l * 6144 + j]; diff = fmaxf(diff, fabsf(a - mod[(size_t)(l * 9 + b) * 6144 + j])); }
#endif
    return block_max(diff, red);
}
__device__ __forceinline__ float diag_g3(const KP& p, int i, unsigned char* shm) {
    const int tid = ltid(); float* red = (float*)shm; float* hr = red + 16;
    const int r = dg_row(i), b = r < TL ? r >> 11 : 8;
    const float* xr = r < TL ? p.out + (size_t)r * D : (const float*)(p.ws + WS_XCTX) + (size_t)(r - TL) * D;
    const float* mod = (const float*)(p.ws + WS_MOD) + (size_t)b * 6144;
    const bf16_t* hb = (const bf16_t*)(p.ws + WS_HBUF) + (size_t)r * D;
    const float x0 = xr[tid], x1 = xr[tid + 512];
    const float ss = block_sum(x0 * x0 + x1 * x1, red); const float rstd = rsqrtf(ss * (1.f / D) + EPS);
    float diff = 0.f;
    { const float h0 = x0 * rstd * p.in[I_G2][tid] * (1.f + mod[4096 + tid]) + mod[3072 + tid], h1 = x1 * rstd * p.in[I_G2][tid + 512] * (1.f + mod[4096 + tid + 512]) + mod[3072 + tid + 512];
      diff = fmaxf(fabsf(h0 - bf2f(hb[tid])), fabsf(h1 - bf2f(hb[tid + 512]))); hr[tid] = bf2f(hb[tid]); hr[tid + 512] = bf2f(hb[tid + 512]); }
    __syncthreads();
    const bf16_t* hid = (const bf16_t*)(p.ws + WS_HID) + (size_t)r * 4096;
    for (int j = tid; j < 4096; j += 512) { float a = 0.f; for (int k = 0; k < 1024; ++k) a += hr[k] * p.in[I_WUP][(size_t)k * 4096 + j];
        a = fmaxf(a, 0.f); a = a * a; diff = fmaxf(diff, fabsf(a - bf2f(hid[j])) / (1.f + fabsf(a))); }
    return block_max(diff, red);
}
#endif


#define XB_TMO      128
#define XB_XCNT(j)  (256  + 64 * (j))
#define XB_XSUB(j)  (1280 + 64 * (j))
#define XB_XGEN(j)  (2304 + 64 * (j))
#define XB_TOP      3328
#define XB_TOPGEN   3392
#define XCD_BAR_WORDS 3456
#define XB_SPIN_CAP (1u << 18)
#define LAS __attribute__((address_space(3)))
__device__ __forceinline__ unsigned xb_ld(unsigned* p)              { return __hip_atomic_load(p, __ATOMIC_RELAXED, __HIP_MEMORY_SCOPE_AGENT); }
__device__ __forceinline__ unsigned xb_add(unsigned* p, unsigned v) { return __hip_atomic_fetch_add(p, v, __ATOMIC_RELAXED, __HIP_MEMORY_SCOPE_AGENT); }
__device__ __forceinline__ unsigned xb_xcc_id() { return (unsigned)__builtin_amdgcn_s_getreg((3 << 11) | 20) & 0xFu; }
#define XB_SPIN(cond, bar) do { unsigned _sp = 0; while (cond) { __builtin_amdgcn_s_sleep(1); \
    if ((++_sp & 255u) == 0u) { if (xb_ld(&(bar)[XB_TMO])) break; if (_sp > XB_SPIN_CAP) { atomicAdd(&(bar)[XB_TMO], 1u); break; } } } } while (0)
struct XcdBarrier { unsigned* bar; unsigned x; volatile LAS unsigned* st; };
__device__ __forceinline__ XcdBarrier xcd_barrier_post(unsigned* bar, volatile LAS unsigned* st) {
    XcdBarrier b; b.bar = bar; b.x = xb_xcc_id(); b.st = st;
    if (threadIdx.x == 0) (void)xb_add(&bar[XB_XCNT(b.x)], 1u);
    return b;
}
__device__ __forceinline__ void xcd_barrier_complete(unsigned* bar, unsigned x, unsigned& nloc, unsigned& nx) {
    const unsigned G = gridDim.x * gridDim.y * gridDim.z;
    unsigned sum, cnt, mine, sp = 0u;
    for (;;) {
        sum = 0u; cnt = 0u; mine = 0u;
#pragma unroll
        for (unsigned j = 0; j < 16; ++j) { const unsigned c = xb_ld(&bar[XB_XCNT(j)]); sum += c; cnt += (c > 0u) ? 1u : 0u; mine = (j == x) ? c : mine; }
        if (sum == G) break;
        __builtin_amdgcn_s_sleep(1);
        if ((++sp & 255u) == 0u) { if (xb_ld(&bar[XB_TMO])) break; if (sp > XB_SPIN_CAP) { atomicAdd(&bar[XB_TMO], 1u); break; } }
    }
    nloc = mine > 0u ? mine : 1u; nx = cnt > 0u ? cnt : 1u;
}
__device__ __forceinline__ void xcd_barrier(const XcdBarrier& b) {
    asm volatile("s_waitcnt vmcnt(0)" ::: "memory");
    __syncthreads();
    if (threadIdx.x == 0) {
        unsigned* bar = b.bar;
        __builtin_amdgcn_s_waitcnt(0);
        unsigned nloc = b.st[0], nx = b.st[1];
        if (nloc == 0u) { xcd_barrier_complete(bar, b.x, nloc, nx); b.st[0] = nloc; b.st[1] = nx; }
        const unsigned old = xb_add(&bar[XB_XSUB(b.x)], 1u);
        const unsigned gen = old / nloc;
        if (old + 1u == (gen + 1u) * nloc) {
            __builtin_amdgcn_fence(__ATOMIC_RELEASE, "agent");
            asm volatile("s_waitcnt vmcnt(0)" ::: "memory");
            const unsigned og = xb_add(&bar[XB_TOP], 1u);
            const unsigned tg = og / nx;
            if (og + 1u == (tg + 1u) * nx) xb_add(&bar[XB_TOPGEN], 1u);
            else XB_SPIN(xb_ld(&bar[XB_TOPGEN]) == tg, bar);
            __builtin_amdgcn_fence(__ATOMIC_ACQUIRE, "agent");
            xb_add(&bar[XB_XGEN(b.x)], 1u);
            asm volatile("s_waitcnt vmcnt(0)" ::: "memory");
        } else {
            XB_SPIN(xb_ld(&bar[XB_XGEN(b.x)]) == gen, bar);
            __builtin_amdgcn_fence(__ATOMIC_ACQUIRE, "agent");
            asm volatile("s_waitcnt vmcnt(0)" ::: "memory");
        }
    }
    __syncthreads();
}

__device__ __attribute__((noinline)) void grid_sync_fn() { cg::this_grid().sync(); }
__global__ __launch_bounds__(512, 2) void mega(KP p) {
    extern __shared__ __attribute__((aligned(16))) unsigned char shm[];
    volatile LAS unsigned* xst = (volatile LAS unsigned*)(LAS unsigned char*)(shm + LDS_BYTES - 16);
    if (threadIdx.x == 0) { xst[0] = 0u; xst[1] = 0u; }
    __syncthreads();
    if (p.ph_lo < 0) grid_sync_fn();
    const XcdBarrier xbar = xcd_barrier_post((unsigned*)(p.ws + WS_BAR), xst);
    for (int s = p.ph_lo; s < p.ph_hi; ++s) {
      if (s == 16) continue;
      const int nrep = (s >= 1 && s < 19 && ((REPMASK >> ((s - 1) % 9)) & 1)) ? 2 : 1;
      for (int rep = 0; rep < nrep; ++rep) {
        const int G = gridDim.x, bid = lbid();
        unsigned char* ws = p.ws; asm volatile("" : "+s"(ws));
        float* outp = p.out; asm volatile("" : "+s"(outp));
        if (s == 0) { if (PHMASK & 512) step_prep0(p, shm);
#ifdef REP_PREP
            xcd_barrier(xbar); step_prep0(p, shm);
#endif
        }
        else if (s == 19) { if (PHMASK & 1024) step_final(p); }
        else {
            const int l = (s - 1) / 9, ph = (s - 1) % 9; const bool last = l == 1;
            const float* modl = (const float*)(ws + WS_MOD) + (size_t)l * 9 * 6144;
            const float* xl = l == 0 ? p.in[I_X] : outp; const float* xc = l == 0 ? p.in[I_CTX] : (const float*)(ws + WS_XCTX);
            const int Mrows = last ? TL : TT;
            if (ph == 0) {
                if (PHMASK & 1) {
                if (l == 1) { float* tab = (float*)shm; prep_weights(p, 1, shm, tab, 2); }
                norm_rows(xl, xc, TT, p.in[I_G1] + l * D, modl, 0, 1024, (bf16_t*)(ws + WS_HBUF), l == 1 ? (const bf16_t*)(ws + WS_PART) : nullptr, (const float*)(ws + WS_MOD) + 8 * 6144 + 5120, nullptr, l == 1 ? TL : 0); }
            } else if (ph == 1) {
                if (PHMASK & 2) {
                EpiIn E; E.proj = (bf16_t*)(ws + WS_PROJ); E.gates = (float*)(ws + WS_GATES); E.zt = (bf16_t*)(ws + WS_ZT); E.ztc = (bf16_t*)(ws + WS_ZTC);
                run_gemm(shm, (const bf16_t*)(ws + WS_HBUF), (const bf16_t*)(ws + WS_WIN), TT, NIN, 1024, G, bid, E); }
            } else if (ph == 2) {
                if (PHMASK & 4) {
                    for (int it = bid; it < 32 * NCH + TT / 64; it += G) { if (it < 32 * NCH) mlstm_a_item(p, l, it, shm); else qkv_item(p, l, it - 32 * NCH, shm); }
                    {
                        const int nlong = (32 * NCH + TT / 64) % G, f0 = bid >= nlong ? bid - nlong : -1, fs = G - nlong;
                        if (f0 >= 0) for (int f = f0; f < 256; f += fs) zt_fold_item(p, f, shm);
                        __syncthreads(); }
                }
            } else if (ph == 3 || ph == 4) {
                if (PHMASK & 8) {
                const int nF = 64;
                if (ph == 3) mlstm_scan(p);
                {
                    int a0, a1, ast;
                    if (ph == 3) { a0 = bid; a1 = 256; ast = G; } else { a0 = (!last && bid >= nF + 8) ? 256 + (bid - nF - 8) : (1 << 30); a1 = 288; ast = G - nF - 8; }
                    for (int it = a0; it < a1; it += ast) {
                        const int item = it < 256 ? (((it & 7) * 4 + (it >> 6)) << 3) + ((it >> 3) & 7) : it;
                        attn_item<0>(p, item, shm); } }
                if (ph == 4) {
                if (bid < nF) {
                    for (int pass = 0; pass < (last ? 1 : 2); ++pass) {
                        const bool fl = pass == 0;
                        if (!fl && bid >= 8) break;
                        EpiFou E; E.mix = (bf16_t*)(ws + WS_MIX); E.rows_per_b = fl ? SEQ : CL; E.row_off = fl ? 0 : TL; E.scale = fl ? 0.00276213586400995f : 0.0078125f;
                        run_gemm(shm, (const bf16_t*)(ws + (fl ? WS_FDFT : WS_FDFTC)), (const bf16_t*)(ws + (fl ? WS_ZTF : WS_ZTC)), fl ? 2048 : 256, 2048, fl ? 2048 : 512, G, bid, E);
                    }
                } else {
                    const int vb = bid - nF, nb = G - nF, per = last ? 16 : NCH, nit = 32 * per;
                    for (int it = vb; it < nit; it += nb) { const int bh = it / per, jc = (last ? 2 : 0) + it % per; mlstm_c_item(p, l, bh >> 2, bh & 3, jc, shm); }
                } } }
            } else if (ph == 6) {
                if (PHMASK & 64) norm_rows(outp, l == 0 ? p.in[I_CTX] : (const float*)(ws + WS_XCTX), Mrows, p.in[I_G2] + l * D, modl, 3072, 4096, (bf16_t*)(ws + WS_HBUF),
                                           l == 0 ? (const bf16_t*)(ws + WS_PART) : nullptr, modl + 8 * 6144 + 2048, (float*)(ws + WS_XCTX), TL);
            } else if (ph == 7) {
                if (PHMASK & 128) {
                EpiUp E; E.hid = (bf16_t*)(ws + WS_HID);
                run_gemm(shm, (const bf16_t*)(ws + WS_HBUF), (const bf16_t*)(ws + WS_WUP), Mrows, 4096, 1024, G, bid, E); }
            } else {
                if (PHMASK & 32) {
                const bool g2 = ph == 5;
                {
                    const float* mod1 = (const float*)(ws + WS_MOD) + (size_t)9 * 6144;
                    EpiResNorm E; E.xo = g2 ? xl : outp; E.xn = outp; E.ga = modl + (g2 ? 2048 : 5120);
                    E.rss = (float*)(ws + WS_RSS) + (size_t)(2 * l + (g2 ? 0 : 1)) * TL; E.cnt = (unsigned*)(ws + WS_RCNT) + (2 * l + (g2 ? 0 : 1)) * 64 * 64;
                    E.mode = (!g2 && last) ? 1 : 0;
                    E.g = g2 ? p.in[I_G2] + l * D : (last ? p.in[I_GFIN] : p.in[I_G1] + D);
                    E.sc = g2 ? modl + 4096 : mod1 + 1024; E.sh = g2 ? modl + 3072 : mod1; E.hb = (bf16_t*)(ws + WS_HBUF);
                    pg8::Gemm gm; gm.A = (const bf16_t*)(ws + (g2 ? WS_MIX : WS_HID)); gm.Bt = (const bf16_t*)(ws + (g2 ? WS_WOUT : WS_WDOWN)); gm.M = TL; gm.N = 1024; gm.K = g2 ? 1024 : 4096; gm.ld = gm.K;
                    pg8::StaticOrder S; S.init(TL, 1024, G, bid);
                    pg8::gemm_phase<EpiResNorm, pg8::StaticOrder, false>((PG8_LAS unsigned char*)shm, gm, S, E, nullptr); }
                if (!last && !g2 && bid >= 128) { float* tab = (float*)shm; build_costab(tab); prep_weights(p, 1, shm, tab, 1, 128, G - 128); }
                if (!last) for (int su = bid; su < 128; su += G) {
                    const int ks = su >> 5, ui = su & 31, ld = g2 ? 1024 : 4096, Ks = ld >> 2;
                    EpiPart E; E.part = (bf16_t*)(ws + WS_PART) + (size_t)ks * TC * D;
                    run_gemm_ctx_split(shm, (const bf16_t*)(ws + (g2 ? WS_MIX : WS_HID)) + (size_t)TL * ld + ks * Ks, (const bf16_t*)(ws + (g2 ? WS_WOUT : WS_WDOWN)) + ks * Ks, Ks, ld, ui >> 2, ui & 3, E); }
                }
            }
        }
        if (s + 1 < p.ph_hi || rep + 1 < nrep) xcd_barrier(xbar);
      }
    }
#ifdef EXTRA_SYNCS
    for (int i = 0; i < EXTRA_SYNCS; ++i) xcd_barrier(xbar);
#endif
#ifdef DIAG
    grid_sync_fn();
    if (blockIdx.x == 0) {
        float worst = 0.f;
#pragma unroll 1
        for (int i = 0; i < 8; ++i) {
            const int tk = i == 0 ? 0 : i == 1 ? 1 : i == 2 ? 127 : i == 3 ? 128 : i == 4 ? 129 : i == 5 ? 1000 : i == 6 ? 2046 : 2047;
#if DIAG == 1
            const float d = diag_mlstm(p, 0, 3, 2, tk, shm);
#elif DIAG == 2
            const float d = diag_attn(p, 0, 3, 2, tk, shm);
#elif DIAG == 3
            const float d = i == 0 ? diag_fourier(p, 3, 2, shm) : 0.f;
#elif DIAG == 4
            const float d = fmaxf(diag_mlstm(p, 1, 5, 1, tk, shm), diag_attn(p, 1, 5, 1, tk, shm));
#elif DIAG == 5
            const float d = diag_g2(p, i, shm);
#else
            const float d = diag_g3(p, i, shm);
#endif
#ifdef DIAG_TOK
            if (i == DIAG_TOK) worst = d;
#else
            worst = fmaxf(worst, d);
#endif
        }
        if (threadIdx.x == 0) p.out[0] = 1e4f * worst;
    }
#endif
}

extern "C" void kernel_launch(void* const* d_in, const int* in_sizes, int n_in, void* d_out, int out_size, void* d_ws, size_t ws_size, hipStream_t stream) {
    static int grid_blocks = 0;
    if (grid_blocks == 0) {
        if (n_in != 20 || ws_size < WS_NEED) { fprintf(stderr, "kernel_launch: unexpected inputs (n_in %d, ws %zu, need %zu)\n", n_in, ws_size, (size_t)WS_NEED); grid_blocks = -1; return; }
        int dev = 0, cus = 0, per_cu = 0;
        hipGetDevice(&dev);
        hipDeviceGetAttribute(&cus, hipDeviceAttributeMultiprocessorCount, dev);
        hipFuncSetAttribute((const void*)mega, hipFuncAttributeMaxDynamicSharedMemorySize, LDS_BYTES);
        hipOccupancyMaxActiveBlocksPerMultiprocessor(&per_cu, (const void*)mega, 512, LDS_BYTES);
        if (per_cu < 1) per_cu = 1;
        grid_blocks = cus * per_cu;
        if (grid_blocks != 256) { fprintf(stderr, "kernel_launch: this build needs exactly 256 resident workgroups (got %d)\n", grid_blocks); grid_blocks = -1; (void)hipGetLastError(); return; }
        (void)hipGetLastError();
    }
    if (grid_blocks < 0) return;
    KP p{};
    for (int i = 0; i < 20; ++i) p.in[i] = (const float*)d_in[i];
    p.out = (float*)d_out; p.ws = (unsigned char*)d_ws; p.ph_lo = 0; p.ph_hi = 19;
#ifdef DIAG
    p.ph_hi = DIAG == 4 ? 15 : DIAG == 5 ? 7 : DIAG == 6 ? 9 : 6;
#endif
    (void)hipMemsetAsync((unsigned char*)d_ws + WS_BAR, 0, 16384, stream);
    void* args[] = {&p};
    hipError_t e = hipLaunchCooperativeKernel((const void*)mega, dim3(grid_blocks), dim3(512), args, LDS_BYTES, stream);
    if (e != hipSuccess) fprintf(stderr, "cooperative launch failed: %s (grid %d)\n", hipGetErrorString(e), grid_blocks);
}
```

```cpp
#include <hip/hip_runtime.h>
#include <hip/hip_cooperative_groups.h>
#include <cstdio>
namespace cg = cooperative_groups;
namespace pg8 {
#define PG8_LAS __attribute__((address_space(3)))
typedef unsigned short bf16_t;
typedef short bf16x8 __attribute__((ext_vector_type(8)));
typedef float f32x4 __attribute__((ext_vector_type(4)));
typedef unsigned u32x4 __attribute__((ext_vector_type(4)));
constexpr int BM = 256, BK = 64, HALF = 128, HTB = HALF * BK * 2  , STAGE_BYTES = 8 * HTB, NXCD = 8, WGM = 8;

__host__ __device__ __forceinline__ int lds_byte(int r, int c) { const int st = (r >> 4) * 2 + (c >> 5), rr = r & 15, cc = c & 31, ob = rr * 64 + cc * 2; return st * 1024 + (ob ^ (((ob >> 9) & 1) << 5)); }
__host__ __device__ __forceinline__ void stage_rc(int b, int& R, int& C) { const int st = b / 1024, sb = b % 1024, swz = sb ^ (((sb >> 9) & 1) << 5); R = (st >> 1) * 16 + swz / 64; C = (st & 1) * 32 + (swz % 64) / 2; }
__host__ __device__ __forceinline__ int perm32(int rho) { const int n = rho >> 4, i = rho & 15; return 8 * (i >> 2) + 4 * n + (i & 3); }

struct Unit { int pm, pn; };
struct Gemm { const bf16_t* A; const bf16_t* Bt; int M, N, K, ld; };

struct StaticOrder {
    int nM, nN, nwg, G, c;
    __host__ __device__ void init(int M, int N, int G_, int c_) { nM = M / BM; nN = N / BM; nwg = nM * nN; G = G_; c = c_; }
    __host__ __device__ bool next(int i, Unit& u) const {
        const long L = (long)i * G + c; if (L >= nwg) return false;
        int wgid = (int)L; { const int q = nwg / NXCD, r = nwg % NXCD, xcd = wgid % NXCD, off = wgid / NXCD; wgid = (xcd < r ? xcd * (q + 1) : r * (q + 1) + (xcd - r) * q) + off; }
        const int nig = WGM * nN, gid = wgid / nig, fm = gid * WGM, gsz = (nM - fm) < WGM ? (nM - fm) : WGM;
        u.pm = fm + ((wgid % nig) % gsz); u.pn = (wgid % nig) / gsz; return true;
    }
    __device__ __forceinline__ void a_ready(const Unit&) const {}
    __device__ __forceinline__ void done(const Unit&) const {}
};
__device__ __forceinline__ unsigned cvt_pk_bf16(float lo, float hi) { unsigned r; asm volatile("v_cvt_pk_bf16_f32 %0, %1, %2" : "=v"(r) : "v"(lo), "v"(hi)); return r; }
template <class Epi, class Sched, bool STAMP = false>
__device__ __forceinline__ void gemm_phase(PG8_LAS unsigned char* lds, const Gemm g, const Sched& S, const Epi& E, unsigned long long* stamps) {
    int tid_l = threadIdx.x; asm volatile("" : "+v"(tid_l)); const int tid = tid_l, wid = __builtin_amdgcn_readfirstlane(tid >> 6), lane = tid & 63, wr = wid >> 2, wc = wid & 3, fr = lane & 15, fq = lane >> 4;
    const int K = g.K, nt = K / BK, LD = g.ld;
    int ts_lo = 0, ts_hi = 0, nts = 0; const unsigned long long rt_entry = STAMP ? (unsigned long long)wall_clock64() : 0ull;
#define PG8_STAMP() do { if (STAMP && wid == 0 && nts < 64) { const unsigned long long _c = (unsigned long long)clock64(); \
        ts_lo = (lane == nts) ? (int)(unsigned)_c : ts_lo; ts_hi = (lane == nts) ? (int)(unsigned)(_c >> 32) : ts_hi; ++nts; } } while (0)
    PG8_STAMP();
    unsigned voffA[2], voffB[2];
#pragma unroll
    for (int i = 0; i < 2; ++i) { int R, C; stage_rc(tid * 16 + i * 8192, R, C); const int Rb = Epi::PERM ? ((R & ~31) + perm32(R & 31)) : R;
        voffA[i] = (unsigned)(R * LD + C) * 2u; voffB[i] = (unsigned)(Rb * LD + C) * 2u; }
    const size_t kstep = (size_t)(BK * 2);
    const size_t hstep = (size_t)HALF * LD * 2;
    const size_t tstep = 2 * hstep;
    const unsigned ldsw = (unsigned)wid * 1024u;
    const int aoff = lds_byte(wr * 64 + fr, fq * 8), boff = lds_byte(wc * 32 + fr, fq * 8);
#define PG8_SA(b, h) (((b) * 2 + (h)) * HTB)
#define PG8_SB(b, h) ((4 + (b) * 2 + (h)) * HTB)
#define PG8_STAGE(bufoff, gbase, voff) do { _Pragma("unroll") for (int _i = 0; _i < 2; ++_i) \
        __builtin_amdgcn_global_load_lds((const unsigned*)((const char*)(gbase) + (voff)[_i]), (PG8_LAS unsigned*)(lds + (bufoff) + ldsw + _i * 8192), 16, 0, 0); } while (0)
#define PG8_LDA(dst, b, h) do { _Pragma("unroll") for (int m = 0; m < 4; ++m) _Pragma("unroll") for (int k = 0; k < 2; ++k) dst[m][k] = *(const PG8_LAS bf16x8*)(lds + PG8_SA(b, h) + aoff + m * 2048 + k * 1024); } while (0)
#define PG8_LDB(dst, b, h) do { _Pragma("unroll") for (int n = 0; n < 2; ++n) _Pragma("unroll") for (int k = 0; k < 2; ++k) dst[n][k] = *(const PG8_LAS bf16x8*)(lds + PG8_SB(b, h) + boff + n * 2048 + k * 1024); } while (0)
#define PG8_MMA(ai, bj, At, Bt) do { __builtin_amdgcn_s_setprio(1); _Pragma("unroll") for (int m = 0; m < 4; ++m) _Pragma("unroll") for (int n = 0; n < 2; ++n) _Pragma("unroll") for (int k = 0; k < 2; ++k) \
        acc[ai][bj][m][n] = __builtin_amdgcn_mfma_f32_16x16x32_bf16(Bt[n][k], At[m][k], acc[ai][bj][m][n], 0, 0, 0); __builtin_amdgcn_s_setprio(0); } while (0)
#define PG8_WAIT_V(n) asm volatile("s_waitcnt vmcnt(" #n ")" ::: "memory")
#define PG8_WAIT_L(n) asm volatile("s_waitcnt lgkmcnt(" #n ")" ::: "memory")
#define PG8_BAR __builtin_amdgcn_s_barrier()
#define PG8_SCHED __builtin_amdgcn_sched_barrier(0)
    Unit cur, nxt; int ui = 0;
    if (!S.next(0, cur)) return;
    f32x4 acc[2][2][4][2];
#pragma unroll
    for (int a = 0; a < 2; ++a)
#pragma unroll
        for (int b = 0; b < 2; ++b)
#pragma unroll
            for (int m = 0; m < 4; ++m)
#pragma unroll
                for (int n = 0; n < 2; ++n) acc[a][b][m][n] = (f32x4){0.f, 0.f, 0.f, 0.f};
    bf16x8 At[4][2], B0[2][2], B1[2][2];
    const char* cA = (const char*)g.A + (size_t)cur.pm * tstep; const char* cB = (const char*)g.Bt + (size_t)cur.pn * tstep;
    S.a_ready(cur);
    PG8_STAGE(PG8_SB(0, 0), cB, voffB); PG8_STAGE(PG8_SA(0, 0), cA, voffA); PG8_STAGE(PG8_SB(0, 1), cB + hstep, voffB); PG8_STAGE(PG8_SA(0, 1), cA + hstep, voffA);
    if (wr == 1) PG8_BAR;
    PG8_WAIT_V(4); PG8_BAR;
    PG8_STAGE(PG8_SB(1, 0), cB + kstep, voffB); PG8_STAGE(PG8_SA(1, 0), cA + kstep, voffA); PG8_STAGE(PG8_SB(1, 1), cB + hstep + kstep, voffB);
    PG8_WAIT_V(6); PG8_BAR;
    PG8_STAMP();
    for (;;) {
        const bool has_next = S.next(ui + 1, nxt);
        const char* nA = has_next ? (const char*)g.A + (size_t)nxt.pm * tstep : cA; const char* nB = has_next ? (const char*)g.Bt + (size_t)nxt.pn * tstep : cB;
        for (int t = 0; t < nt; t += 2) {
            const bool last = (t == nt - 2);
            const char* a1 = cA + (size_t)(t + 1) * kstep;
            const char* a2 = last ? nA : cA + (size_t)(t + 2) * kstep; const char* b2 = last ? nB : cB + (size_t)(t + 2) * kstep;
            const char* a3 = a2 + kstep; const char* b3 = b2 + kstep;
            if (last && has_next) S.a_ready(nxt);
            PG8_LDB(B0, 0, 0); PG8_SCHED; PG8_LDA(At, 0, 0); PG8_STAGE(PG8_SA(1, 1), a1 + hstep, voffA);
            PG8_WAIT_L(8); PG8_BAR; PG8_WAIT_L(0); PG8_MMA(0, 0, At, B0); PG8_BAR; PG8_SCHED;
            PG8_LDB(B1, 0, 1); PG8_STAGE(PG8_SB(0, 0), b2, voffB);
            PG8_BAR; PG8_WAIT_L(0); PG8_MMA(0, 1, At, B1); PG8_BAR;
            PG8_LDA(At, 0, 1); PG8_STAGE(PG8_SA(0, 0), a2, voffA);
            PG8_BAR; PG8_WAIT_L(0); PG8_MMA(1, 0, At, B0); PG8_BAR; PG8_SCHED;
            PG8_STAGE(PG8_SB(0, 1), b2 + hstep, voffB);
            PG8_WAIT_V(6); PG8_BAR; PG8_MMA(1, 1, At, B1); PG8_BAR;
            PG8_LDB(B0, 1, 0); PG8_SCHED; PG8_LDA(At, 1, 0); PG8_STAGE(PG8_SA(0, 1), a2 + hstep, voffA);
            PG8_WAIT_L(8); PG8_BAR; PG8_WAIT_L(0); PG8_MMA(0, 0, At, B0); PG8_BAR; PG8_SCHED;
            PG8_LDB(B1, 1, 1); PG8_STAGE(PG8_SB(1, 0), b3, voffB);
            PG8_BAR; PG8_WAIT_L(0); PG8_MMA(0, 1, At, B1); PG8_BAR;
            PG8_LDA(At, 1, 1); PG8_STAGE(PG8_SA(1, 0), a3, voffA);
            PG8_BAR; PG8_WAIT_L(0); PG8_MMA(1, 0, At, B0); PG8_BAR; PG8_SCHED;
            PG8_STAGE(PG8_SB(1, 1), b3 + hstep, voffB);
            PG8_WAIT_V(6); PG8_BAR; PG8_MMA(1, 1, At, B1); PG8_BAR;
        }
        PG8_STAMP();
        if constexpr (!Epi::AFTER_DRAIN) { E(acc, cur, wr, wc, fr, fq); S.done(cur); }
        PG8_STAMP();
        if (!has_next) break;
#pragma unroll
        for (int a = 0; a < 2; ++a)
#pragma unroll
            for (int b = 0; b < 2; ++b)
#pragma unroll
                for (int m = 0; m < 4; ++m)
#pragma unroll
                    for (int n = 0; n < 2; ++n) acc[a][b][m][n] = (f32x4){0.f, 0.f, 0.f, 0.f};
        cur = nxt; cA = nA; cB = nB; ++ui;
    }
    PG8_WAIT_V(0);
    if (wr == 0) PG8_BAR;
    PG8_BAR;
    if constexpr (Epi::AFTER_DRAIN) { E.fused(acc, cur, wr, wc, fr, fq, lds, wid, lane); S.done(cur); }
    PG8_STAMP();
    if (STAMP && wid == 0) { stamps[lane] = lane < nts ? (((unsigned long long)(unsigned)ts_hi << 32) | (unsigned)ts_lo) : 0ull;
        if (lane == 62) stamps[62] = rt_entry; if (lane == 63) stamps[63] = (unsigned long long)wall_clock64(); }
#undef PG8_STAMP
#undef PG8_SA
#undef PG8_SB
#undef PG8_STAGE
#undef PG8_LDA
#undef PG8_LDB
#undef PG8_MMA
#undef PG8_WAIT_V
#undef PG8_WAIT_L
#undef PG8_BAR
#undef PG8_SCHED
}
}

using pg8::bf16_t; using pg8::bf16x8; using pg8::f32x4; using pg8::u32x4;
typedef unsigned u32x2 __attribute__((ext_vector_type(2)));
#define MFMA16(a, b, c) __builtin_amdgcn_mfma_f32_16x16x32_bf16((a), (b), (c), 0, 0, 0)

constexpr int D = 1024, NB = 8, SEQ = 2048, CL = 256, TL = NB * SEQ, TC = NB * CL, TT = TL + TC;
constexpr int NIN = 2560;
constexpr int PW = 2048;
constexpr int C_MQ = 0, C_MK = 384, C_MV = 768, C_MO = 1152, C_CQ = 1552, C_CKV = 1808, C_KR = 1936;
constexpr int KEYS = SEQ + CL;
constexpr int LCH = 128, NCH = 18;
constexpr int VC = 112, STSZ = VC * 96;
constexpr int LDS_BYTES = 147456;
constexpr float EPS = 1e-6f;
#ifndef ATT_REP
#define ATT_REP 1
#endif
#ifndef REPMASK
#define REPMASK 0
#endif
#ifndef PHMASK
#define PHMASK 0xFFFF
#endif

constexpr size_t WS_MOD = 0;
constexpr size_t WS_WIN = WS_MOD + 442368;
constexpr size_t WS_WOUT = WS_WIN + 5242880;
constexpr size_t WS_WUP = WS_WOUT + 2097152;
constexpr size_t WS_WDOWN = WS_WUP + 8388608;
constexpr size_t WS_WUQ = WS_WDOWN + 8388608;
constexpr size_t WS_WUKV = WS_WUQ + 196608;
constexpr size_t WS_FDFT = WS_WUKV + 163840;
constexpr size_t WS_FDFTC = WS_FDFT + 16777216;
constexpr size_t WS_XCTX = WS_FDFTC + 262144;
constexpr size_t WS_S0 = WS_XCTX + 8388608;
constexpr size_t WS_HBUF = WS_S0;
constexpr size_t WS_HID = WS_S0 + 37748736;
constexpr size_t WS_MIX = WS_S0;
constexpr size_t WS_PROJ = WS_S0 + 37748736;
constexpr size_t WS_GATES = WS_PROJ + 75497472;
constexpr size_t WS_QB = WS_GATES + 1179648;
constexpr size_t WS_KB = WS_QB + 14155776;
constexpr size_t WS_VT = WS_KB + 14155776;
constexpr size_t WS_DC = WS_VT + 14155776;
constexpr size_t WS_DEC = WS_DC + 24772608;
constexpr size_t WS_ZT = WS_DEC + 8192;
constexpr size_t WS_ZTC = WS_ZT + 16777216;
constexpr size_t WS_ZTF = WS_ZTC + 2097152;
constexpr size_t WS_CST = WS_DC;
constexpr size_t WS_END_MIX = WS_ZTF + 8388608;
constexpr size_t WS_END_MLP = WS_HID + 150994944;
constexpr size_t WS_PART = WS_HID + 150994944;
constexpr size_t WS_RSS = 268435456 - 16384 - 262144 - 262144;
constexpr size_t WS_RCNT = WS_RSS - 65536;
constexpr size_t WS_ROPE = 268435456 - 16384 - 262144;
constexpr size_t WS_BAR = 268435456 - 16384;
constexpr size_t WS_NEED = 268435456;
static_assert(WS_END_MIX <= WS_RCNT && WS_PART + 4 * 4194304 <= WS_RCNT, "workspace map");

struct KP { const float* in[20]; float* out; unsigned char* ws; int ph_lo, ph_hi; };
enum { I_X, I_C, I_CTX, I_CCTX, I_WMOD, I_BMOD, I_G1, I_G2, I_WIN, I_BG, I_CONV, I_GM, I_GQN, I_GKVN, I_WUQ, I_WUKV, I_WOUT, I_WUP, I_WDOWN, I_GFIN };

__device__ __forceinline__ int ltid() { int t = threadIdx.x; asm volatile("" : "+v"(t)); return t; }
__device__ __forceinline__ int lbid() { int t = blockIdx.x; asm volatile("" : "+s"(t)); return t; }
__device__ __forceinline__ float bf2f(bf16_t v) { return __uint_as_float(((unsigned)v) << 16); }
__device__ __forceinline__ bf16_t f2bf(float f) { unsigned u = __float_as_uint(f); u += 0x7FFFu + ((u >> 16) & 1u); return (bf16_t)(u >> 16); }
__device__ __forceinline__ unsigned pk2(float lo, float hi) { unsigned r; asm("v_cvt_pk_bf16_f32 %0, %1, %2" : "=v"(r) : "v"(lo), "v"(hi)); return r; }
__device__ __forceinline__ float lo_bf(unsigned u) { return __uint_as_float(u << 16); }
__device__ __forceinline__ float hi_bf(unsigned u) { return __uint_as_float(u & 0xFFFF0000u); }
__device__ __forceinline__ float wave_sum(float v) {
#pragma unroll
    for (int o = 1; o < 64; o <<= 1) v += __shfl_xor(v, o);
    return v;
}
__device__ __forceinline__ float max_over_fq(float x) {
    const unsigned u = __float_as_uint(x);
    const auto r = __builtin_amdgcn_permlane32_swap(u, u, false, false);
    const float m = fmaxf(__uint_as_float(r[0]), __uint_as_float(r[1]));
    const unsigned v = __float_as_uint(m);
    const auto s = __builtin_amdgcn_permlane16_swap(v, v, false, false);
    return fmaxf(__uint_as_float(s[0]), __uint_as_float(s[1]));
}
__device__ __forceinline__ float sum_over_fq(float x) {
    const unsigned u = __float_as_uint(x);
    const auto r = __builtin_amdgcn_permlane32_swap(u, u, false, false);
    const float m = __uint_as_float(r[0]) + __uint_as_float(r[1]);
    const unsigned v = __float_as_uint(m);
    const auto s = __builtin_amdgcn_permlane16_swap(v, v, false, false);
    return __uint_as_float(s[0]) + __uint_as_float(s[1]);
}
__device__ __forceinline__ float logsig(float f) { const float e = __expf(-fabsf(f)); return fminf(f, 0.f) - __logf(1.f + e); }
__device__ __forceinline__ float siluf(float v) { return v / (1.f + __expf(-v)); }
__device__ __forceinline__ bf16x8 mk8(u32x2 lo, u32x2 hi) { u32x4 t = {lo.x, lo.y, hi.x, hi.y}; return __builtin_bit_cast(bf16x8, t); }

struct EpiIn {
    static constexpr bool PERM = true, AFTER_DRAIN = false;
    bf16_t* proj; float* gates; bf16_t* zt; bf16_t* ztc;
    __device__ __forceinline__ void operator()(const f32x4 (&acc)[2][2][4][2], const pg8::Unit& u, int wr, int wc, int fr, int fq) const {
        const int row0 = u.pm * 256 + wr * 64 + fr;
        if (u.pn < 2) {
            const bool latu = u.pm < 64;
            unsigned char* zb = latu ? (unsigned char*)zt : (unsigned char*)ztc;
            const unsigned ldzb = latu ? 8192u : 1024u;
            const unsigned cofs = (unsigned)(wc * 32 + 8 * fq) * ldzb;
#pragma unroll
            for (int ai = 0; ai < 2; ++ai)
#pragma unroll
                for (int m = 0; m < 4; ++m) {
                    const int r = row0 + ai * 128 + m * 16;
                    unsigned off;
                    if (latu) { const int b = r >> 11, n = r & 2047; off = (unsigned)((b * 256) * 4096 + u.pn * 2048 + n) * 2u + cofs; }
                    else { const int rc = r - TL, b = rc >> 8, n = rc & 255; off = (unsigned)((b * 256) * 512 + u.pn * 256 + n) * 2u + cofs; }
#pragma unroll
                    for (int bj = 0; bj < 2; ++bj)
#pragma unroll
                        for (int n2 = 0; n2 < 2; ++n2) {
                            const f32x4 v = acc[ai][bj][m][n2];
#pragma unroll
                            for (int j = 0; j < 4; ++j) *(bf16_t*)(zb + (off + (unsigned)(bj * 128 + 4 * n2 + j) * ldzb)) = f2bf(v[j]);
                        }
                    asm volatile("" ::: "memory");
                }
        } else {
            const int colbase = (u.pn - 2) * 256 + wc * 32 + 8 * fq;
            const bool isg = (u.pn == 8) && (wc == 0) && (fq < 2);
#pragma unroll
            for (int ai = 0; ai < 2; ++ai)
#pragma unroll
                for (int m = 0; m < 4; ++m) {
                    const int r = row0 + ai * 128 + m * 16;
                    bf16_t* rowp = proj + (size_t)r * PW + colbase;
#pragma unroll
                    for (int bj = 0; bj < 2; ++bj) {
                        const f32x4 v0 = acc[ai][bj][m][0], v1 = acc[ai][bj][m][1];
                        u32x4 o; o.x = pk2(v0[0], v0[1]); o.y = pk2(v0[2], v0[3]); o.z = pk2(v1[0], v1[1]); o.w = pk2(v1[2], v1[3]);
                        *(u32x4*)(rowp + bj * 128) = o;
                    }
                    if (isg) { float* gp = gates + (size_t)r * 16 + 8 * fq; *(f32x4*)gp = acc[ai][0][m][0]; *(f32x4*)(gp + 4) = acc[ai][0][m][1]; }
                    asm volatile("" ::: "memory");
                }
        }
    }
};
struct EpiRes {
    static constexpr bool PERM = false, AFTER_DRAIN = false;
    const float* xol; const float* xoc; float* xnl; float* xnc; const float* ga;
    __device__ __forceinline__ void operator()(const f32x4 (&acc)[2][2][4][2], const pg8::Unit& u, int wr, int wc, int fr, int fq) const {
        const int row0 = u.pm * 256 + wr * 64 + fr, col0 = u.pn * 256 + wc * 32 + 4 * fq;
#pragma unroll
        for (int ai = 0; ai < 2; ++ai)
#pragma unroll
            for (int m = 0; m < 4; ++m) {
                const int r = row0 + ai * 128 + m * 16;
                const float* xo; float* xn; int b;
                if (r < TL) { xo = xol + (size_t)r * D; xn = xnl + (size_t)r * D; b = r >> 11; } else { xo = xoc + (size_t)(r - TL) * D; xn = xnc + (size_t)(r - TL) * D; b = 8; }
                const float* gp = ga + (size_t)b * 6144;
#pragma unroll
                for (int bj = 0; bj < 2; ++bj)
#pragma unroll
                    for (int n = 0; n < 2; ++n) {
                        const int c = col0 + bj * 128 + n * 16;
                        const f32x4 g = *(const f32x4*)(gp + c), xv = *(const f32x4*)(xo + c);
                        *(f32x4*)(xn + c) = xv + g * acc[ai][bj][m][n];
                    }
            }
    }
};
struct EpiResNorm {
    static constexpr bool PERM = false, AFTER_DRAIN = true;
    const float* xo; float* xn; const float* ga; float* rss; unsigned* cnt; int mode; const float* g; const float* sc; const float* sh; bf16_t* hb;
    __device__ __forceinline__ void fused(f32x4 (&acc)[2][2][4][2], const pg8::Unit& u, int wr, int wc, int fr, int fq, PG8_LAS unsigned char* lds, int wid, int lane) const {
        const int row0 = u.pm * 256 + wr * 64 + fr, col0 = u.pn * 256 + wc * 32 + 4 * fq, b = (u.pm * 256) >> 11;
        float ps[2][4];
        {   const float* gp = ga + (size_t)b * 6144 + col0;
            f32x4 gv[2][2];
#pragma unroll
            for (int bj = 0; bj < 2; ++bj)
#pragma unroll
                for (int n = 0; n < 2; ++n) gv[bj][n] = *(const f32x4*)(gp + bj * 128 + n * 16);
#pragma unroll
            for (int ai = 0; ai < 2; ++ai) {
                f32x4 xt[4][2][2];
#pragma unroll
                for (int m = 0; m < 4; ++m) { const float* xr = xo + (size_t)(row0 + ai * 128 + m * 16) * D + col0;
#pragma unroll
                    for (int bj = 0; bj < 2; ++bj)
#pragma unroll
                        for (int n = 0; n < 2; ++n) xt[m][bj][n] = *(const f32x4*)(xr + bj * 128 + n * 16); }
#pragma unroll
                for (int m = 0; m < 4; ++m) { float s = 0.f;
#pragma unroll
                    for (int bj = 0; bj < 2; ++bj)
#pragma unroll
                        for (int n = 0; n < 2; ++n) { const f32x4 v = xt[m][bj][n] + gv[bj][n] * acc[ai][bj][m][n]; acc[ai][bj][m][n] = v;
                            s += v[0] * v[0] + v[1] * v[1] + v[2] * v[2] + v[3] * v[3]; }
                    ps[ai][m] = sum_over_fq(s); }
                asm volatile("" ::: "memory");
            } }
        PG8_LAS float* red = (PG8_LAS float*)lds;
        if (fq == 0) {
#pragma unroll
            for (int ai = 0; ai < 2; ++ai)
#pragma unroll
                for (int m = 0; m < 4; ++m) red[wc * 256 + ai * 128 + wr * 64 + m * 16 + fr] = ps[ai][m]; }
        __syncthreads();
        const int tid = wid * 64 + lane;
        if (tid < 256) { const float tot = (red[tid] + red[256 + tid]) + (red[512 + tid] + red[768 + tid]);
            (void)__hip_atomic_fetch_add(rss + u.pm * 256 + tid, tot, __ATOMIC_RELAXED, __HIP_MEMORY_SCOPE_AGENT); }
        asm volatile("s_waitcnt vmcnt(0)" ::: "memory");
        __syncthreads();
        if (tid == 0) { unsigned* c = cnt + u.pm * 64;
            (void)__hip_atomic_fetch_add(c, 1u, __ATOMIC_RELAXED, __HIP_MEMORY_SCOPE_AGENT);
            unsigned spins = 0; while (__hip_atomic_load(c, __ATOMIC_RELAXED, __HIP_MEMORY_SCOPE_AGENT) < 4u && ++spins < (1u << 22)) __builtin_amdgcn_s_sleep(1); }
        __syncthreads();
        float rs[2][4];
#pragma unroll
        for (int ai = 0; ai < 2; ++ai)
#pragma unroll
            for (int m = 0; m < 4; ++m) rs[ai][m] = __hip_atomic_load(rss + row0 + ai * 128 + m * 16, __ATOMIC_RELAXED, __HIP_MEMORY_SCOPE_AGENT);
#pragma unroll
        for (int ai = 0; ai < 2; ++ai)
#pragma unroll
            for (int m = 0; m < 4; ++m) rs[ai][m] = rsqrtf(rs[ai][m] * (1.f / D) + EPS);
        const size_t bo = (size_t)b * 6144;
#pragma unroll
        for (int bj = 0; bj < 2; ++bj) {
            f32x4 gq[2], sv[2];
#pragma unroll
            for (int n = 0; n < 2; ++n) { const int c = col0 + bj * 128 + n * 16; const f32x4 gg = *(const f32x4*)(g + c);
                if (mode == 0) { gq[n] = gg * (*(const f32x4*)(sc + bo + c) + 1.f); sv[n] = *(const f32x4*)(sh + bo + c); }
                else { gq[n] = gg; sv[n] = (f32x4){0.f, 0.f, 0.f, 0.f}; } }
#pragma unroll
            for (int ai = 0; ai < 2; ++ai)
#pragma unroll
                for (int m = 0; m < 4; ++m) {
                    const int r = row0 + ai * 128 + m * 16; const float rstd = rs[ai][m];
#pragma unroll
                    for (int n = 0; n < 2; ++n) { const int c = col0 + bj * 128 + n * 16; const f32x4 v = acc[ai][bj][m][n];
                        const f32x4 hh = v * rstd * gq[n] + sv[n];
                        if (mode == 0) { *(f32x4*)(xn + (size_t)r * D + c) = v;
                            u32x2 o; o.x = pk2(hh[0], hh[1]); o.y = pk2(hh[2], hh[3]); *(u32x2*)(hb + (size_t)r * D + c) = o; }
                        else *(f32x4*)(xn + (size_t)r * D + c) = hh; }
                }
            asm volatile("" ::: "memory");
        }
    }
};
struct EpiUp {
    static constexpr bool PERM = true, AFTER_DRAIN = false;
    bf16_t* hid;
    __device__ __forceinline__ void operator()(const f32x4 (&acc)[2][2][4][2], const pg8::Unit& u, int wr, int wc, int fr, int fq) const {
        const int row0 = u.pm * 256 + wr * 64 + fr, col0 = u.pn * 256 + wc * 32 + 8 * fq;
#pragma unroll
        for (int ai = 0; ai < 2; ++ai)
#pragma unroll
            for (int m = 0; m < 4; ++m) {
                bf16_t* rowp = hid + (size_t)(row0 + ai * 128 + m * 16) * 4096 + col0;
#pragma unroll
                for (int bj = 0; bj < 2; ++bj) {
                    f32x4 v0 = acc[ai][bj][m][0], v1 = acc[ai][bj][m][1];
#pragma unroll
                    for (int j = 0; j < 4; ++j) { float a = fmaxf(v0[j], 0.f); v0[j] = a * a; float b = fmaxf(v1[j], 0.f); v1[j] = b * b; }
                    u32x4 o; o.x = pk2(v0[0], v0[1]); o.y = pk2(v0[2], v0[3]); o.z = pk2(v1[0], v1[1]); o.w = pk2(v1[2], v1[3]);
                    *(u32x4*)(rowp + bj * 128) = o;
                }
            }
    }
};
struct EpiFou {
    static constexpr bool PERM = true, AFTER_DRAIN = false;
    bf16_t* mix; int rows_per_b; int row_off; float scale;
    __device__ __forceinline__ void operator()(const f32x4 (&acc)[2][2][4][2], const pg8::Unit& u, int wr, int wc, int fr, int fq) const {
        const int row0 = u.pm * 256 + wr * 64 + fr, col0 = wc * 32 + 8 * fq;
        const size_t rb = (size_t)row_off + (size_t)u.pn * rows_per_b;
#pragma unroll
        for (int ai = 0; ai < 2; ++ai)
#pragma unroll
            for (int m = 0; m < 4; ++m) {
                bf16_t* rowp = mix + (rb + row0 + ai * 128 + m * 16) * D + col0;
#pragma unroll
                for (int bj = 0; bj < 2; ++bj) {
                    const f32x4 v0 = acc[ai][bj][m][0] * scale, v1 = acc[ai][bj][m][1] * scale;
                    u32x4 o; o.x = pk2(v0[0], v0[1]); o.y = pk2(v0[2], v0[3]); o.z = pk2(v1[0], v1[1]); o.w = pk2(v1[2], v1[3]);
                    *(u32x4*)(rowp + bj * 128) = o;
                }
            }
    }
};

template <class Epi>
__device__ __forceinline__ void run_gemm(unsigned char* shm, const bf16_t* A, const bf16_t* Bt, int M, int N, int K, int G, int c, const Epi& E) {
    pg8::Gemm g; g.A = A; g.Bt = Bt; g.M = M; g.N = N; g.K = K; g.ld = K;
    pg8::StaticOrder S; S.init(M, N, G, c);
    pg8::gemm_phase<Epi, pg8::StaticOrder, false>((PG8_LAS unsigned char*)shm, g, S, E, nullptr);
}

struct OneUnit {
    int pm, pn;
    __device__ bool next(int i, pg8::Unit& u) const { if (i) return false; u.pm = pm; u.pn = pn; return true; }
    __device__ __forceinline__ void a_ready(const pg8::Unit&) const {}
    __device__ __forceinline__ void done(const pg8::Unit&) const {}
};
struct EpiPart {
    static constexpr bool PERM = true, AFTER_DRAIN = false;
    bf16_t* part;
    __device__ __forceinline__ void operator()(const f32x4 (&acc)[2][2][4][2], const pg8::Unit& u, int wr, int wc, int fr, int fq) const {
        const int row0 = u.pm * 256 + wr * 64 + fr, col0 = u.pn * 256 + wc * 32 + 8 * fq;
#pragma unroll
        for (int ai = 0; ai < 2; ++ai)
#pragma unroll
            for (int m = 0; m < 4; ++m) {
                bf16_t* rowp = part + (size_t)(row0 + ai * 128 + m * 16) * D + col0;
#pragma unroll
                for (int bj = 0; bj < 2; ++bj) { const f32x4 v0 = acc[ai][bj][m][0], v1 = acc[ai][bj][m][1];
                    u32x4 o; o.x = pk2(v0[0], v0[1]); o.y = pk2(v0[2], v0[3]); o.z = pk2(v1[0], v1[1]); o.w = pk2(v1[2], v1[3]);
                    *(u32x4*)(rowp + bj * 128) = o; }
            }
    }
};
__device__ __forceinline__ void run_gemm_ctx_split(unsigned char* shm, const bf16_t* A, const bf16_t* Bt, int K, int ld, int pm, int pn, const EpiPart& E) {
    pg8::Gemm g; g.A = A; g.Bt = Bt; g.M = TC; g.N = 1024; g.K = K; g.ld = ld;
    OneUnit S; S.pm = pm; S.pn = pn;
    pg8::gemm_phase<EpiPart, OneUnit, false>((PG8_LAS unsigned char*)shm, g, S, E, nullptr);
}

__device__ __forceinline__ void build_costab(float* tab) {
    for (int i = ltid(); i < 2048; i += 512) tab[i] = cospif((float)i * (1.0f / 1024.0f));
    __syncthreads();
}
__device__ __forceinline__ void tr_load(const float* __restrict__ src, int ldn, int nmax, int k0, int nsrc0, float* tile) {
    const int tid = ltid(), r = tid >> 4, c4 = (tid & 15) * 4;
#pragma unroll
    for (int h = 0; h < 2; ++h) {
        const int rr = r + 32 * h, nc = nsrc0 + c4;
        f32x4 v = {0.f, 0.f, 0.f, 0.f};
        if (nc < nmax) v = *(const f32x4*)(src + (size_t)(k0 + rr) * ldn + nc);
        float* t = tile + rr * 65 + c4; t[0] = v[0]; t[1] = v[1]; t[2] = v[2]; t[3] = v[3];
    }
    __syncthreads();
}
__device__ __forceinline__ void tr_tile(const float* __restrict__ src, int ldn, int nmax, int k0, int nsrc0, bf16_t* __restrict__ dst, int ldk, int ndst0, float* tile) {
    tr_load(src, ldn, nmax, k0, nsrc0, tile);
    const int tid = ltid(), n = tid >> 3, kq = tid & 7;
    const float* s = tile + (kq * 8) * 65 + n;
    u32x4 o; o.x = pk2(s[0], s[65]); o.y = pk2(s[130], s[195]); o.z = pk2(s[260], s[325]); o.w = pk2(s[390], s[455]);
    *(u32x4*)(dst + (size_t)(ndst0 + n) * ldk + k0 + kq * 8) = o;
    __syncthreads();
}
__device__ __forceinline__ void fold_tile(const float* __restrict__ win, int k0, int g, bf16_t* __restrict__ dst, float* tile, const float* tab) {
    tr_load(win, 2224, 2224, k0, g * 64, tile);
    const int tid = ltid(), cp = tid >> 3, kq = tid & 7;
    float ac[8], as[8];
#pragma unroll
    for (int i = 0; i < 8; ++i) { ac[i] = 0.f; as[i] = 0.f; }
    for (int c = 0; c < 64; ++c) {
        const int idx = ((c * cp) & 63) * 32;
        const float cs = tab[idx], sn = tab[(idx - 512) & 2047];
#pragma unroll
        for (int i = 0; i < 8; ++i) { const float v = tile[(kq * 8 + i) * 65 + c]; ac[i] += v * cs; as[i] += v * sn; }
    }
    u32x4 o; o.x = pk2(ac[0], ac[1]); o.y = pk2(ac[2], ac[3]); o.z = pk2(ac[4], ac[5]); o.w = pk2(ac[6], ac[7]);
    *(u32x4*)(dst + (size_t)(g * 64 + cp) * 1024 + k0 + kq * 8) = o;
    u32x4 q; q.x = pk2(as[0], as[1]); q.y = pk2(as[2], as[3]); q.z = pk2(as[4], as[5]); q.w = pk2(as[6], as[7]);
    *(u32x4*)(dst + (size_t)(256 + g * 64 + cp) * 1024 + k0 + kq * 8) = q;
    __syncthreads();
}
__device__ __forceinline__ void tr_tile_wave(const float* __restrict__ src, int ldn, int nmax, int k0, int nsrc0, bf16_t* __restrict__ dst, int ldk, int ndst0, float* tile, int lane) {
    const int r = lane >> 4, c4 = (lane & 15) * 4;
    f32x4 tv[16];
#pragma unroll
    for (int h = 0; h < 16; ++h) { const int rr = r + 4 * h, nc = nsrc0 + c4; tv[h] = (f32x4){0.f, 0.f, 0.f, 0.f};
        if (nc < nmax) tv[h] = *(const f32x4*)(src + (size_t)(k0 + rr) * ldn + nc); }
#pragma unroll
    for (int h = 0; h < 16; ++h) { const int rr = r + 4 * h; float* t = tile + rr * 65 + c4; t[0] = tv[h][0]; t[1] = tv[h][1]; t[2] = tv[h][2]; t[3] = tv[h][3]; }
    asm volatile("s_waitcnt lgkmcnt(0)" ::: "memory");
    const int c = lane & 7, nl = lane >> 3;
#pragma unroll
    for (int j = 0; j < 8; ++j) { const int n = nl + 8 * j; const float* s = tile + (8 * c) * 65 + n;
        u32x4 o; o.x = pk2(s[0], s[65]); o.y = pk2(s[130], s[195]); o.z = pk2(s[260], s[325]); o.w = pk2(s[390], s[455]);
        *(u32x4*)(dst + (size_t)(ndst0 + n) * ldk + k0 + 8 * c) = o; }
    asm volatile("s_waitcnt lgkmcnt(0)" ::: "memory");
}
constexpr int NWV_ITEMS = 512 + 256 + 1024 + 1024 + 24 + 20;
__device__ __forceinline__ void prep_weight_item_wave(const KP& p, int l, int it, float* tile, int lane) {
    unsigned char* ws = p.ws;
    if (it < 512) { const int ct = it & 31, kt = it >> 5;
        tr_tile_wave(p.in[I_WIN] + (size_t)l * 1024 * 2224, 2224, 2224, kt * 64, 256 + ct * 64, (bf16_t*)(ws + WS_WIN), 1024, 512 + ct * 64, tile, lane); return; }
    it -= 512;
    if (it < 256) { tr_tile_wave(p.in[I_WOUT] + (size_t)l * 1024 * 1024, 1024, 1024, (it >> 4) * 64, (it & 15) * 64, (bf16_t*)(ws + WS_WOUT), 1024, (it & 15) * 64, tile, lane); return; }
    it -= 256;
    if (it < 1024) { tr_tile_wave(p.in[I_WUP] + (size_t)l * 1024 * 4096, 4096, 4096, (it >> 6) * 64, (it & 63) * 64, (bf16_t*)(ws + WS_WUP), 1024, (it & 63) * 64, tile, lane); return; }
    it -= 1024;
    if (it < 1024) { tr_tile_wave(p.in[I_WDOWN] + (size_t)l * 4096 * 1024, 1024, 1024, (it >> 4) * 64, (it & 15) * 64, (bf16_t*)(ws + WS_WDOWN), 4096, (it & 15) * 64, tile, lane); return; }
    it -= 1024;
    if (it < 24) { tr_tile_wave(p.in[I_WUQ] + (size_t)l * 256 * 384, 384, 384, (it / 6) * 64, (it % 6) * 64, (bf16_t*)(ws + WS_WUQ), 256, (it % 6) * 64, tile, lane); return; }
    it -= 24;
    tr_tile_wave(p.in[I_WUKV] + (size_t)l * 128 * 640, 640, 640, (it / 10) * 64, (it % 10) * 64, (bf16_t*)(ws + WS_WUKV), 128, (it % 10) * 64, tile, lane);
}
__device__ __forceinline__ void prep_weights(const KP& p, int l, unsigned char* shm, const float* tab, int part = 0, int b0 = 0, int nb = 0) {
    const int tid = ltid(), bid = lbid() - b0, G = nb ? nb : (int)gridDim.x;
    if (part != 2 && part != 4) for (int it = bid; it < 64; it += G) fold_tile(p.in[I_WIN] + (size_t)l * 1024 * 2224, (it >> 2) * 64, it & 3, (bf16_t*)(p.ws + WS_WIN), (float*)(shm + 8192), tab);
    __syncthreads();
    float* wt = (float*)(shm + 8192) + (tid >> 6) * (64 * 65);
    const int ilo = part == 4 ? 1024 : 0, ihi = part == 3 ? 1024 : NWV_ITEMS;
    for (int it = ilo + bid * 8 + (tid >> 6); it < ihi; it += G * 8) {
        const bool isdown = it >= 1792 && it < 2816;
        if ((part == 1 && isdown) || (part == 2 && !isdown)) continue;
        prep_weight_item_wave(p, l, it, wt, tid & 63); }
    __syncthreads();
}
constexpr int NW_ITEMS = 512 + 64 + 256 + 1024 + 1024 + 24 + 20;
__device__ __forceinline__ void prep_weight_item(const KP& p, int l, int it, float* tile, const float* tab) {
    unsigned char* ws = p.ws;
    if (it < 512) { const int ct = it & 31, kt = it >> 5;
        tr_tile(p.in[I_WIN] + (size_t)l * 1024 * 2224, 2224, 2224, kt * 64, 256 + ct * 64, (bf16_t*)(ws + WS_WIN), 1024, 512 + ct * 64, tile); return; }
    it -= 512;
    if (it < 64) { fold_tile(p.in[I_WIN] + (size_t)l * 1024 * 2224, (it >> 2) * 64, it & 3, (bf16_t*)(ws + WS_WIN), tile, tab); return; }
    it -= 64;
    if (it < 256) { tr_tile(p.in[I_WOUT] + (size_t)l * 1024 * 1024, 1024, 1024, (it >> 4) * 64, (it & 15) * 64, (bf16_t*)(ws + WS_WOUT), 1024, (it & 15) * 64, tile); return; }
    it -= 256;
    if (it < 1024) { tr_tile(p.in[I_WUP] + (size_t)l * 1024 * 4096, 4096, 4096, (it >> 6) * 64, (it & 63) * 64, (bf16_t*)(ws + WS_WUP), 1024, (it & 63) * 64, tile); return; }
    it -= 1024;
    if (it < 1024) { tr_tile(p.in[I_WDOWN] + (size_t)l * 4096 * 1024, 1024, 1024, (it >> 4) * 64, (it & 15) * 64, (bf16_t*)(ws + WS_WDOWN), 4096, (it & 15) * 64, tile); return; }
    it -= 1024;
    if (it < 24) { tr_tile(p.in[I_WUQ] + (size_t)l * 256 * 384, 384, 384, (it / 6) * 64, (it % 6) * 64, (bf16_t*)(ws + WS_WUQ), 256, (it % 6) * 64, tile); return; }
    it -= 24;
    tr_tile(p.in[I_WUKV] + (size_t)l * 128 * 640, 640, 640, (it / 10) * 64, (it % 10) * 64, (bf16_t*)(ws + WS_WUKV), 128, (it % 10) * 64, tile);
}
__device__ __forceinline__ void prep_mod_item(const KP& p, int it, float* sl) {
    const int tid = ltid(), l = it / 96, cgp = it % 96;
    for (int i = tid; i < 9216; i += 512) { const int r = i >> 10, k = i & 1023; const float v = r < 8 ? p.in[I_C][r * 1024 + k] : p.in[I_CCTX][k]; sl[i] = siluf(v); }
    __syncthreads();
    const int j4 = (tid & 15) * 4, ks = tid >> 4;
    f32x4 acc[9];
#pragma unroll
    for (int r = 0; r < 9; ++r) acc[r] = (f32x4){0.f, 0.f, 0.f, 0.f};
    const float* w = p.in[I_WMOD] + (size_t)l * 1024 * 6144 + cgp * 64 + j4;
#pragma unroll 8
    for (int k = ks * 32; k < ks * 32 + 32; ++k) {
        const f32x4 wv = *(const f32x4*)(w + (size_t)k * 6144);
#pragma unroll
        for (int r = 0; r < 9; ++r) acc[r] += wv * sl[r * 1024 + k];
    }
    float* red = sl + 9216;
#pragma unroll
    for (int r = 0; r < 9; ++r) *(f32x4*)(red + (ks * 9 + r) * 64 + j4) = acc[r];
    __syncthreads();
    for (int o = tid; o < 576; o += 512) { const int r = o >> 6, jl = o & 63; float s = 0.f;
#pragma unroll
        for (int q = 0; q < 32; ++q) s += red[(q * 9 + r) * 64 + jl];
        ((float*)(p.ws + WS_MOD))[(size_t)(l * 9 + r) * 6144 + cgp * 64 + jl] = s + p.in[I_BMOD][l * 6144 + cgp * 64 + jl]; }
    __syncthreads();
}
__device__ __forceinline__ void prep_dft_row(const KP& p, int rowid, const float* tab) {
    const int tid = ltid();
    if (rowid < 2048) {
        const int k = rowid; float v[4];
#pragma unroll
        for (int e = 0; e < 4; ++e) { const int j = tid * 4 + e;
            if (j <= 1024) v[e] = tab[(k * j) & 2047]; else { const int n = j - 1024; v[e] = -tab[(((k * n) & 2047) - 512) & 2047]; } }
        u32x2 ov; ov.x = pk2(v[0], v[1]); ov.y = pk2(v[2], v[3]);
        *(u32x2*)((bf16_t*)(p.ws + WS_FDFT) + (size_t)k * 2048 + tid * 4) = ov;
    } else if (tid < 64) {
        const int k = rowid - 2048; unsigned o[4];
#pragma unroll
        for (int i = 0; i < 4; ++i) { float v[2];
#pragma unroll
            for (int e = 0; e < 2; ++e) { const int np = tid * 8 + i * 2 + e, n = np & 255, j = ((k * n) & 255) * 8; v[e] = (np >> 8) ? -tab[(j - 512) & 2047] : tab[j]; }
            o[i] = pk2(v[0], v[1]); }
        u32x4 ov = {o[0], o[1], o[2], o[3]};
        *(u32x4*)((bf16_t*)(p.ws + WS_FDFTC) + (size_t)k * 512 + tid * 8) = ov;
    }
}
__device__ __forceinline__ void rope_cs(int tpos, int seg, int f, float& cs, float& sn);
__device__ __forceinline__ void step_prep0(const KP& p, unsigned char* shm) {
    float* tab = (float*)shm; float* work = (float*)(shm + 8192);
    build_costab(tab);
    {
        unsigned* z = (unsigned*)(p.ws + WS_RCNT);
        for (int i = lbid() * 512 + ltid(); i < (65536 + 262144) / 4; i += gridDim.x * 512) z[i] = 0u; }
    {
        float* rt = (float*)(p.ws + WS_ROPE);
        for (int i = lbid() * 512 + ltid(); i < 2048 * 16; i += gridDim.x * 512) { float cs, sn; rope_cs(i >> 4, (i >> 3) & 1, i & 7, cs, sn); rt[2 * i] = cs; rt[2 * i + 1] = sn; } }
    const int NT = 192 + 2304;
    const bool nomod = (int)gridDim.x == 256 && lbid() >= 192;
    if (nomod) prep_weights(p, 0, shm, tab, 3, 192, 64);
    for (int it = lbid(); it < NT; it += gridDim.x) {
        if (it < 192) prep_mod_item(p, it, work);
        else prep_dft_row(p, it - 192, tab);
    }
    __syncthreads();
    if ((int)gridDim.x == 256) prep_weights(p, 0, shm, tab, 4); else prep_weights(p, 0, shm, tab);
}

__device__ __forceinline__ void norm_rows(const float* xl, const float* xc, int nrows, const float* g, const float* modl, int shoff, int scoff, bf16_t* dst, const bf16_t* part = nullptr, const float* pga = nullptr, float* xcw = nullptr, int rlo = 0) {
    const int tid = ltid(), lane = tid & 63, gw = lbid() * 8 + (tid >> 6), NW = gridDim.x * 8;
    for (int r0 = rlo + gw; r0 < nrows; r0 += 3 * NW) {
        f32x4 v[3][4]; float ss[3];
#pragma unroll
        for (int q = 0; q < 3; ++q) { const int r = r0 + q * NW; ss[q] = 0.f;
            if (r < nrows) { const float* xr = r < TL ? xl + (size_t)r * D : xc + (size_t)(r - TL) * D;
#pragma unroll
                for (int j = 0; j < 4; ++j) v[q][j] = *(const f32x4*)(xr + lane * 4 + 256 * j);
                if (part != nullptr && r >= TL) {
#pragma unroll
                    for (int j = 0; j < 4; ++j) { const int c = lane * 4 + 256 * j; f32x4 a = {0.f, 0.f, 0.f, 0.f};
#pragma unroll
                        for (int sp = 0; sp < 4; ++sp) { const u32x2 pv = *(const u32x2*)(part + ((size_t)sp * TC + (r - TL)) * D + c); a[0] += lo_bf(pv.x); a[1] += hi_bf(pv.x); a[2] += lo_bf(pv.y); a[3] += hi_bf(pv.y); }
                        v[q][j] += *(const f32x4*)(pga + c) * a;
                        if (xcw != nullptr) *(f32x4*)(xcw + (size_t)(r - TL) * D + c) = v[q][j]; } } }
            else {
#pragma unroll
                for (int j = 0; j < 4; ++j) v[q][j] = (f32x4){0.f, 0.f, 0.f, 0.f}; } }
#pragma unroll
        for (int q = 0; q < 3; ++q) {
#pragma unroll
            for (int j = 0; j < 4; ++j) ss[q] += v[q][j][0] * v[q][j][0] + v[q][j][1] * v[q][j][1] + v[q][j][2] * v[q][j][2] + v[q][j][3] * v[q][j][3];
            ss[q] = wave_sum(ss[q]); }
#pragma unroll
        for (int q = 0; q < 3; ++q) { const int r = r0 + q * NW;
            if (r < nrows) { const int b = r < TL ? (r >> 11) : 8; const float rstd = rsqrtf(ss[q] * (1.f / D) + EPS); const float* mp = modl + (size_t)b * 6144;
#pragma unroll
                for (int j = 0; j < 4; ++j) { const int c = lane * 4 + 256 * j;
                    const f32x4 gg = *(const f32x4*)(g + c), sc = *(const f32x4*)(mp + scoff + c), sh = *(const f32x4*)(mp + shoff + c);
                    const f32x4 y = v[q][j] * rstd * gg, hh = y * (sc + 1.f) + sh;
                    u32x2 o; o.x = pk2(hh[0], hh[1]); o.y = pk2(hh[2], hh[3]);
                    *(u32x2*)(dst + (size_t)r * D + c) = o; } } }
    }
}
__device__ __forceinline__ void step_final(const KP& p) {
    const int tid = ltid(), lane = tid & 63, gw = lbid() * 8 + (tid >> 6), NW = gridDim.x * 8;
    const float* g = p.in[I_GFIN];
    for (int r0 = gw; r0 < TL; r0 += 2 * NW) {
        f32x4 v[2][4]; float ss[2];
#pragma unroll
        for (int q = 0; q < 2; ++q) { const float* xr = p.out + (size_t)(r0 + q * NW) * D; ss[q] = 0.f;
#pragma unroll
            for (int j = 0; j < 4; ++j) v[q][j] = *(const f32x4*)(xr + lane * 4 + 256 * j); }
#pragma unroll
        for (int q = 0; q < 2; ++q) {
#pragma unroll
            for (int j = 0; j < 4; ++j) ss[q] += v[q][j][0] * v[q][j][0] + v[q][j][1] * v[q][j][1] + v[q][j][2] * v[q][j][2] + v[q][j][3] * v[q][j][3];
            ss[q] = wave_sum(ss[q]); }
#pragma unroll
        for (int q = 0; q < 2; ++q) { float* xr = p.out + (size_t)(r0 + q * NW) * D; const float rstd = rsqrtf(ss[q] * (1.f / D) + EPS);
#pragma unroll
            for (int j = 0; j < 4; ++j) { const int c = lane * 4 + 256 * j; *(f32x4*)(xr + c) = v[q][j] * rstd * *(const f32x4*)(g + c); } }
    }
}

constexpr int ML_GA = 0;
constexpr int ML_CW = 3072;
constexpr int ML_Q = 7168;
constexpr int ML_K = 33792;
constexpr int ML_VT = 60416;
constexpr int ML_RAW = 90880;
__device__ __forceinline__ int ml_rowbase(int b, int jc) { return jc < 2 ? TL + b * CL + jc * LCH : b * SEQ + (jc - 2) * LCH; }

__device__ __forceinline__ void ml_stage(const KP& p, int l, int b, int h, int jc, unsigned char* shm) {
    const int tid = ltid();
    const bf16_t* proj = (const bf16_t*)(p.ws + WS_PROJ);
    const float* gates = (const float*)(p.ws + WS_GATES);
    float* GA = (float*)(shm + ML_GA); float* CW = (float*)(shm + ML_CW);
    bf16_t* vT = (bf16_t*)(shm + ML_VT); bf16_t* RAW = (bf16_t*)(shm + ML_RAW);
    const int rowbase = ml_rowbase(b, jc);
    const int t0 = jc < 2 ? jc * LCH : (jc - 2) * LCH, slen = jc < 2 ? CL : SEQ;
    float i_f = 0.f, i_b = 0.f, pf = 0.f, sf = 0.f;
    if (tid < 128) {
        const int lane = tid & 63;
        const float* gp = gates + (size_t)(rowbase + tid) * 16; const float* bg = p.in[I_BG] + l * 16;
        const f32x4 g0 = *(const f32x4*)gp, g1 = *(const f32x4*)(gp + 4), g2 = *(const f32x4*)(gp + 8), g3 = *(const f32x4*)(gp + 12);
        i_f = g0[h] + bg[h]; i_b = g2[h] + bg[8 + h];
        pf = logsig(g1[h] + bg[4 + h]); sf = logsig(g3[h] + bg[12 + h]);
#pragma unroll
        for (int o = 1; o < 64; o <<= 1) { const float t = __shfl_up(pf, o); if (lane >= o) pf += t; const float u = __shfl_down(sf, o); if (lane + o < 64) sf += u; }
        if (lane == 63) GA[4 * 128 + (tid >> 6)] = pf;
        if (lane == 0) GA[5 * 128 + (tid >> 6)] = sf;
    }
    float cwv[2]; u32x4 rv[7], vv[3];
#pragma unroll
    for (int q = 0; q < 2; ++q) { const int i = tid + 512 * q; cwv[q] = 0.f;
        if (i < 5 * 192) { const int k = i / 192, ch = i % 192; cwv[q] = p.in[I_CONV][(size_t)l * 5 * 768 + k * 768 + (ch < 96 ? h * 96 + ch : 384 + h * 96 + (ch - 96))]; } }
#pragma unroll
    for (int q = 0; q < 7; ++q) { const int i = tid + 512 * q; rv[q] = (u32x4){0u, 0u, 0u, 0u};
        if (i < 132 * 24) { const int rr = i / 24, ck = i % 24, t = t0 - 2 + rr;
            if (t >= 0 && t < slen) { const int col = ck < 12 ? C_MQ + h * 96 + ck * 8 : C_MK + h * 96 + (ck - 12) * 8; rv[q] = *(const u32x4*)(proj + (size_t)(rowbase - 2 + rr) * PW + col); } } }
#pragma unroll
    for (int q = 0; q < 3; ++q) { const int i = tid + 512 * q, s = i / 12, ck = i % 12; vv[q] = *(const u32x4*)(proj + (size_t)(rowbase + s) * PW + C_MV + h * 96 + ck * 8); }
#pragma unroll
    for (int q = 0; q < 2; ++q) { const int i = tid + 512 * q; if (i < 5 * 192) CW[i] = cwv[q]; }
#pragma unroll
    for (int q = 0; q < 7; ++q) { const int i = tid + 512 * q; if (i < 132 * 24) { const int rr = i / 24, ck = i % 24; *(u32x4*)(RAW + rr * 192 + ck * 8) = rv[q]; } }
#pragma unroll
    for (int q = 0; q < 3; ++q) { const int i = tid + 512 * q, s = i / 12, ck = i % 12; const u32x4 v = vv[q];
        bf16_t* d = vT + (ck * 8) * 136 + s;
        d[0] = (bf16_t)(v.x & 0xFFFF); d[136] = (bf16_t)(v.x >> 16); d[2 * 136] = (bf16_t)(v.y & 0xFFFF); d[3 * 136] = (bf16_t)(v.y >> 16);
        d[4 * 136] = (bf16_t)(v.z & 0xFFFF); d[5 * 136] = (bf16_t)(v.z >> 16); d[6 * 136] = (bf16_t)(v.w & 0xFFFF); d[7 * 136] = (bf16_t)(v.w >> 16); }
    for (int i = tid; i < 16 * 128; i += 512) { const int r = i >> 7, s = i & 127; vT[(96 + r) * 136 + s] = r == 0 ? (bf16_t)0x3F80 : (bf16_t)0; }
    __syncthreads();
    if (tid < 128) {
        const float bf = pf + (tid >= 64 ? GA[4 * 128 + 0] : 0.f), bb = sf + (tid < 64 ? GA[5 * 128 + 1] : 0.f);
        GA[0 * 128 + tid] = i_f; GA[1 * 128 + tid] = bf; GA[2 * 128 + tid] = i_b; GA[3 * 128 + tid] = bb;
    }
    __syncthreads();
}

__device__ __forceinline__ void conv8(const bf16_t* RAW, const float* CW, int s0, int ch, float (&o0)[8], float (&o1)[8]) {
    float w0[5], w1[5];
#pragma unroll
    for (int i = 0; i < 5; ++i) { w0[i] = CW[i * 192 + ch]; w1[i] = CW[i * 192 + ch + 1]; }
    unsigned rv[12];
#pragma unroll
    for (int i = 0; i < 12; ++i) rv[i] = *(const unsigned*)(RAW + (s0 + i) * 192 + ch);
#pragma unroll
    for (int o = 0; o < 8; ++o) { float a0 = 0.f, a1 = 0.f;
#pragma unroll
        for (int i = 0; i < 5; ++i) { a0 += lo_bf(rv[o + i]) * w0[i]; a1 += hi_bf(rv[o + i]) * w1[i]; }
        o0[o] = siluf(a0); o1[o] = siluf(a1); }
}
__device__ __forceinline__ void mlstm_a_item(const KP& p, int l, int item, unsigned char* shm) {
    const int tid = ltid(), w = tid >> 6, lane = tid & 63, fr = lane & 15, fq = lane >> 4;
    const int jc = item % NCH, bh = item / NCH, h = bh & 3, b = bh >> 2;
    ml_stage(p, l, b, h, jc, shm);
    float* GA = (float*)(shm + ML_GA); const float* CW = (const float*)(shm + ML_CW);
    bf16_t* kwf = (bf16_t*)(shm + ML_Q); bf16_t* kwb = (bf16_t*)(shm + ML_K);
    const bf16_t* vT = (const bf16_t*)(shm + ML_VT); const bf16_t* RAW = (const bf16_t*)(shm + ML_RAW);
    const float Bf = GA[1 * 128 + 127], Bb = GA[3 * 128 + 0];
    if (tid < 128) { GA[4 * 128 + tid] = __expf(Bf - GA[1 * 128 + tid] + GA[0 * 128 + tid]); GA[5 * 128 + tid] = __expf(Bb - GA[3 * 128 + tid] + GA[2 * 128 + tid]); }
    if (tid == 0) { float* dec = (float*)(p.ws + WS_DEC); dec[(bh * 2 + 0) * NCH + jc] = __expf(Bf); dec[(bh * 2 + 1) * NCH + jc] = __expf(Bb); }
    __syncthreads();
    for (int task = tid; task < 48 * 16; task += 512) { const int cp = task % 48, s0 = (task / 48) * 8, ch = 96 + 2 * cp, dk = 2 * cp;
        float o0[8], o1[8]; conv8(RAW, CW, s0, ch, o0, o1);
        const f32x4 wfa = *(const f32x4*)(GA + 4 * 128 + s0), wfb = *(const f32x4*)(GA + 4 * 128 + s0 + 4), wba = *(const f32x4*)(GA + 5 * 128 + s0), wbb = *(const f32x4*)(GA + 5 * 128 + s0 + 4);
        u32x4 t;
        t.x = pk2(o0[0] * wfa[0], o0[1] * wfa[1]); t.y = pk2(o0[2] * wfa[2], o0[3] * wfa[3]); t.z = pk2(o0[4] * wfb[0], o0[5] * wfb[1]); t.w = pk2(o0[6] * wfb[2], o0[7] * wfb[3]); *(u32x4*)(kwf + dk * 136 + s0) = t;
        t.x = pk2(o1[0] * wfa[0], o1[1] * wfa[1]); t.y = pk2(o1[2] * wfa[2], o1[3] * wfa[3]); t.z = pk2(o1[4] * wfb[0], o1[5] * wfb[1]); t.w = pk2(o1[6] * wfb[2], o1[7] * wfb[3]); *(u32x4*)(kwf + (dk + 1) * 136 + s0) = t;
        t.x = pk2(o0[0] * wba[0], o0[1] * wba[1]); t.y = pk2(o0[2] * wba[2], o0[3] * wba[3]); t.z = pk2(o0[4] * wbb[0], o0[5] * wbb[1]); t.w = pk2(o0[6] * wbb[2], o0[7] * wbb[3]); *(u32x4*)(kwb + dk * 136 + s0) = t;
        t.x = pk2(o1[0] * wba[0], o1[1] * wba[1]); t.y = pk2(o1[2] * wba[2], o1[3] * wba[3]); t.z = pk2(o1[4] * wbb[0], o1[5] * wbb[1]); t.w = pk2(o1[6] * wbb[2], o1[7] * wbb[3]); *(u32x4*)(kwb + (dk + 1) * 136 + s0) = t; }
    __syncthreads();
    bf16_t* dC = (bf16_t*)(p.ws + WS_DC);
    for (int tix = w; tix < 84; tix += 8) { const int dir = tix / 42, tt = tix % 42, vt = tt / 6, nt = tt % 6;
        const bf16_t* kw = dir ? kwb : kwf;
        f32x4 acc = {0.f, 0.f, 0.f, 0.f};
        bf16x8 af[4], bf4[4];
#pragma unroll
        for (int ks = 0; ks < 4; ++ks) { af[ks] = *(const bf16x8*)(vT + (16 * vt + fr) * 136 + 32 * ks + 8 * fq); bf4[ks] = *(const bf16x8*)(kw + (16 * nt + fr) * 136 + 32 * ks + 8 * fq); }
        __builtin_amdgcn_sched_barrier(0);
#pragma unroll
        for (int ks = 0; ks < 4; ++ks) acc = MFMA16(af[ks], bf4[ks], acc);
        bf16_t* o = dC + ((size_t)(bh * 2 + dir) * NCH + jc) * STSZ + (16 * vt + 4 * fq) * 96 + 16 * nt + fr;
        o[0] = f2bf(acc[0]); o[96] = f2bf(acc[1]); o[192] = f2bf(acc[2]); o[288] = f2bf(acc[3]); }
    __syncthreads();
}

__device__ __forceinline__ void mlstm_scan(const KP& p) {
    const bf16_t* dC = (const bf16_t*)(p.ws + WS_DC); bf16_t* Cst = (bf16_t*)(p.ws + WS_CST); const float* dec = (const float*)(p.ws + WS_DEC);
    const int nthr = gridDim.x * 512;
    for (int wi = lbid() * 512 + ltid(); wi < 64 * (STSZ / 8); wi += nthr) {
        const int chain = wi / (STSZ / 8), e = (wi % (STSZ / 8)) * 8, dir = chain & 1;
        u32x4 dv[NCH]; float dd[NCH];
#pragma unroll
        for (int pz = 0; pz < NCH; ++pz) { const int jc = dir == 0 ? pz : (pz < 2 ? 1 - pz : NCH + 1 - pz);
            dv[pz] = *(const u32x4*)(dC + ((size_t)chain * NCH + jc) * STSZ + e); dd[pz] = dec[chain * NCH + jc]; }
        float S[8];
#pragma unroll
        for (int i = 0; i < 8; ++i) S[i] = 0.f;
#pragma unroll
        for (int pz = 0; pz < NCH; ++pz) {
            const int jc = dir == 0 ? pz : (pz < 2 ? 1 - pz : NCH + 1 - pz);
            u32x4 o; o.x = pk2(S[0], S[1]); o.y = pk2(S[2], S[3]); o.z = pk2(S[4], S[5]); o.w = pk2(S[6], S[7]);
            *(u32x4*)(Cst + ((size_t)chain * NCH + jc) * STSZ + e) = o;
            const u32x4 d = dv[pz]; const float f = dd[pz];
            S[0] = S[0] * f + lo_bf(d.x); S[1] = S[1] * f + hi_bf(d.x); S[2] = S[2] * f + lo_bf(d.y); S[3] = S[3] * f + hi_bf(d.y);
            S[4] = S[4] * f + lo_bf(d.z); S[5] = S[5] * f + hi_bf(d.z); S[6] = S[6] * f + lo_bf(d.w); S[7] = S[7] * f + hi_bf(d.w);
        }
    }
}

__device__ __forceinline__ void mlstm_c_item(const KP& p, int l, int b, int h, int jc, unsigned char* shm) {
    const int tid = ltid(), w = tid >> 6, lane = tid & 63, fr = lane & 15, fq = lane >> 4;
    const int bh = b * 4 + h;
    ml_stage(p, l, b, h, jc, shm);
    const float* GA = (const float*)(shm + ML_GA); const float* CW = (const float*)(shm + ML_CW);
    bf16_t* qL = (bf16_t*)(shm + ML_Q); bf16_t* kL = (bf16_t*)(shm + ML_K);
    const bf16_t* vT = (const bf16_t*)(shm + ML_VT); const bf16_t* RAW = (const bf16_t*)(shm + ML_RAW);
    bf16_t* CsL = (bf16_t*)(shm + ML_RAW);
    const float qscale = 0.10206207261596577f;
    u32x4 cpre[6];
    {   const bf16_t* Cst = (const bf16_t*)(p.ws + WS_CST);
#pragma unroll
        for (int i = 0; i < 6; ++i) { const int c = tid + 512 * i; if (c < 2 * 112 * 12) { const int dir = c / 1344, r = (c % 1344) / 12, ck = c % 12;
            cpre[i] = *(const u32x4*)(Cst + ((size_t)(bh * 2 + dir) * NCH + jc) * STSZ + r * 96 + ck * 8); } else cpre[i] = (u32x4){0u, 0u, 0u, 0u}; } }
    for (int task = tid; task < 96 * 16; task += 512) { const int cp = task % 96, s0 = (task / 96) * 8, ch = 2 * cp;
        float o0[8], o1[8]; conv8(RAW, CW, s0, ch, o0, o1);
        if (ch < 96) {
#pragma unroll
            for (int i = 0; i < 8; ++i) *(unsigned*)(qL + (s0 + i) * 104 + ch) = pk2(o0[i] * qscale, o1[i] * qscale);
        } else {
#pragma unroll
            for (int i = 0; i < 8; ++i) *(unsigned*)(kL + (s0 + i) * 104 + (ch - 96)) = pk2(o0[i], o1[i]); } }
    __syncthreads();
    {
        for (int i = 0; i < 6; ++i) { const int c = tid + 512 * i; if (c < 2 * 112 * 12) { const int dir = c / 1344, r = (c % 1344) / 12, ck = c % 12; *(u32x4*)(CsL + dir * (112 * 104) + r * 104 + ck * 8) = cpre[i]; } }
    }
    __syncthreads();
    const int t = 16 * w + fr;
    const int row = ml_rowbase(b, jc) + t;
    const bf16_t* proj = (const bf16_t*)(p.ws + WS_PROJ);
    u32x2 mov[6];
#pragma unroll
    for (int vt = 0; vt < 6; ++vt) mov[vt] = *(const u32x2*)(proj + (size_t)row * PW + C_MO + h * 96 + 16 * vt + 4 * fq);
    bf16x8 qf[3];
#pragma unroll
    for (int ks = 0; ks < 3; ++ks) qf[ks] = *(const bf16x8*)(qL + t * 104 + 32 * ks + 8 * fq);
    const float bft = GA[128 + t], bbt = GA[3 * 128 + t];
    bf16x8 PF[4], PB[4];
#pragma unroll
    for (int half = 0; half < 2; ++half) {
        bf16x8 kf[4][3];
#pragma unroll
        for (int i = 0; i < 4; ++i)
#pragma unroll
            for (int ks = 0; ks < 3; ++ks) kf[i][ks] = *(const bf16x8*)(kL + (16 * (4 * half + i) + fr) * 104 + 32 * ks + 8 * fq);
        __builtin_amdgcn_sched_barrier(0);
        f32x4 sa[4];
#pragma unroll
        for (int i = 0; i < 4; ++i) { sa[i] = (f32x4){0.f, 0.f, 0.f, 0.f};
#pragma unroll
            for (int ks = 0; ks < 3; ++ks) sa[i] = MFMA16(kf[i][ks], qf[ks], sa[i]); }
        __builtin_amdgcn_sched_barrier(0);
#pragma unroll
        for (int k2 = 0; k2 < 2; ++k2) {
            unsigned pf[4], pb[4];
#pragma unroll
            for (int hh = 0; hh < 2; ++hh) { const int i = 2 * k2 + hh, st = 4 * half + i;
                const int s0 = 16 * st + 4 * fq;
                const f32x4 gif = *(const f32x4*)(GA + s0), gbf = *(const f32x4*)(GA + 128 + s0), gib = *(const f32x4*)(GA + 256 + s0), gbb = *(const f32x4*)(GA + 384 + s0);
                float vf[4], vb[4];
#pragma unroll
                for (int j = 0; j < 4; ++j) { const int s = s0 + j;
                    vf[j] = (s <= t) ? sa[i][j] * __expf(bft - gbf[j] + gif[j]) : 0.f;
                    vb[j] = (s >= t) ? sa[i][j] * __expf(bbt - gbb[j] + gib[j]) : 0.f; }
                pf[2 * hh] = pk2(vf[0], vf[1]); pf[2 * hh + 1] = pk2(vf[2], vf[3]); pb[2 * hh] = pk2(vb[0], vb[1]); pb[2 * hh + 1] = pk2(vb[2], vb[3]); }
            u32x4 tf = {pf[0], pf[1], pf[2], pf[3]}, tb = {pb[0], pb[1], pb[2], pb[3]};
            PF[2 * half + k2] = __builtin_bit_cast(bf16x8, tf); PB[2 * half + k2] = __builtin_bit_cast(bf16x8, tb);
        }
    }
    const float ebf = __expf(bft), ebb = __expf(bbt);
    f32x4 nf[7], nb[7];
#pragma unroll
    for (int vt = 0; vt < 7; ++vt) {
        bf16x8 cf[3], cb[3]; u32x2 vlo[4], vhi[4];
#pragma unroll
        for (int ks = 0; ks < 3; ++ks) { cf[ks] = *(const bf16x8*)(CsL + (16 * vt + fr) * 104 + 32 * ks + 8 * fq); cb[ks] = *(const bf16x8*)(CsL + 112 * 104 + (16 * vt + fr) * 104 + 32 * ks + 8 * fq); }
#pragma unroll
        for (int kk = 0; kk < 4; ++kk) { vlo[kk] = *(const u32x2*)(vT + (16 * vt + fr) * 136 + 32 * kk + 4 * fq); vhi[kk] = *(const u32x2*)(vT + (16 * vt + fr) * 136 + 32 * kk + 16 + 4 * fq); }
        __builtin_amdgcn_sched_barrier(0);
        f32x4 af = {0.f, 0.f, 0.f, 0.f}, ab = {0.f, 0.f, 0.f, 0.f};
#pragma unroll
        for (int ks = 0; ks < 3; ++ks) { af = MFMA16(cf[ks], qf[ks], af); ab = MFMA16(cb[ks], qf[ks], ab); }
        af *= ebf; ab *= ebb;
#pragma unroll
        for (int kk = 0; kk < 4; ++kk) { const bf16x8 a = mk8(vlo[kk], vhi[kk]); af = MFMA16(a, PF[kk], af); ab = MFMA16(a, PB[kk], ab); }
        nf[vt] = af; nb[vt] = ab;
    }
    const float denf = __shfl(nf[6][0], fr), denb = __shfl(nb[6][0], fr);
    const float rf = 1.f / fmaxf(fabsf(denf), 1.f), rb = 1.f / fmaxf(fabsf(denb), 1.f);
    float ss = 0.f;
#pragma unroll
    for (int vt = 0; vt < 6; ++vt) { nf[vt] = nf[vt] * rf + nb[vt] * rb; ss += nf[vt][0] * nf[vt][0] + nf[vt][1] * nf[vt][1] + nf[vt][2] * nf[vt][2] + nf[vt][3] * nf[vt][3]; }
    ss = sum_over_fq(ss);
    const float rn = rsqrtf(ss * (1.f / 96.f) + EPS);
    bf16_t* mix = (bf16_t*)(p.ws + WS_MIX);
    const float* gm = p.in[I_GM] + l * 384 + h * 96;
#pragma unroll
    for (int vt = 0; vt < 6; ++vt) { const int vc = 16 * vt + 4 * fq;
        const u32x2 mo = mov[vt]; const f32x4 g = *(const f32x4*)(gm + vc);
        const float m0 = lo_bf(mo.x), m1 = hi_bf(mo.x), m2 = lo_bf(mo.y), m3 = hi_bf(mo.y);
        const float y0 = nf[vt][0] * rn * g[0] / (1.f + __expf(-m0)), y1 = nf[vt][1] * rn * g[1] / (1.f + __expf(-m1));
        const float y2 = nf[vt][2] * rn * g[2] / (1.f + __expf(-m2)), y3 = nf[vt][3] * rn * g[3] / (1.f + __expf(-m3));
        u32x2 o; o.x = pk2(y0, y1); o.y = pk2(y2, y3);
        *(u32x2*)(mix + (size_t)row * D + 256 + h * 96 + vc) = o; }
    __syncthreads();
}

__device__ __forceinline__ void zt_fold_item(const KP& p, int item, unsigned char* shm) {
    const int tid = ltid(), w = tid >> 6, lane = tid & 63;
    const int col = item * 8 + w;
    const bf16_t* zr = (const bf16_t*)(p.ws + WS_ZT) + (size_t)col * 4096;
    bf16_t* la = (bf16_t*)(shm + w * 8192); bf16_t* lb = la + 2048;
#pragma unroll
    for (int q = 0; q < 4; ++q) { *(u32x4*)(la + (q * 64 + lane) * 8) = *(const u32x4*)(zr + (q * 64 + lane) * 8); *(u32x4*)(lb + (q * 64 + lane) * 8) = *(const u32x4*)(zr + 2048 + (q * 64 + lane) * 8); }
    asm volatile("s_waitcnt vmcnt(0) lgkmcnt(0)" ::: "memory");
    bf16_t* out = (bf16_t*)(p.ws + WS_ZTF) + (size_t)col * 2048;
#pragma unroll
    for (int q = 0; q < 4; ++q) { const int j0 = (q * 64 + lane) * 8; unsigned o[4];
#pragma unroll
        for (int e2 = 0; e2 < 4; ++e2) { float v[2];
#pragma unroll
            for (int e = 0; e < 2; ++e) { const int j = j0 + 2 * e2 + e;
                if (j == 0 || j == 1024) v[e] = bf2f(la[j]);
                else if (j < 1024) v[e] = bf2f(la[j]) + bf2f(la[2048 - j]);
                else { const int n = j - 1024; v[e] = bf2f(lb[n]) - bf2f(lb[2048 - n]); } }
            o[e2] = pk2(v[0], v[1]); }
        u32x4 ov = {o[0], o[1], o[2], o[3]};
        *(u32x4*)(out + j0) = ov; }
    asm volatile("s_waitcnt lgkmcnt(0)" ::: "memory");
}

__device__ __forceinline__ void rope_cs_tab(const float* rt, int tpos, int seg, int f, float& cs, float& sn) { const float2 v = *(const float2*)(rt + ((tpos * 2 + seg) * 8 + f) * 2); cs = v.x; sn = v.y; }
__device__ __forceinline__ void rope_cs(int tpos, int seg, int f, float& cs, float& sn) {
    const float pos = (float)(seg == 0 ? (tpos >> 6) : (tpos & 63));
    const float fr = exp2f(-(float)f * 1.6609640474436813f);
    sincosf(pos * fr, &sn, &cs);
}
__device__ __forceinline__ void qkv_item(const KP& p, int l, int item, unsigned char* shm) {
    const int tid = ltid(), w = tid >> 6, lane = tid & 63, fr = lane & 15, fq = lane >> 4;
    const int r0 = item * 64; const bool lat = r0 < TL;
    const int b = lat ? (r0 >> 11) : ((r0 - TL) >> 8), tl0 = lat ? (r0 & 2047) : ((r0 - TL) & 255), key0 = lat ? tl0 : SEQ + tl0;
    const bf16_t* proj = (const bf16_t*)(p.ws + WS_PROJ); const float* rt = (const float*)(p.ws + WS_ROPE);
    bf16_t* aq = (bf16_t*)shm; bf16_t* akv = (bf16_t*)(shm + 64 * 264 * 2);
    {
        const int tk = tid >> 3, sub = tid & 7; const bf16_t* pr = proj + (size_t)(r0 + tk) * PW;
        u32x4 cq[4], ck[2]; float sq = 0.f, sk = 0.f;
#pragma unroll
        for (int i = 0; i < 4; ++i) { cq[i] = *(const u32x4*)(pr + C_CQ + sub * 32 + i * 8);
#pragma unroll
            for (int e = 0; e < 4; ++e) { const float a = lo_bf(cq[i][e]), c = hi_bf(cq[i][e]); sq += a * a + c * c; } }
#pragma unroll
        for (int i = 0; i < 2; ++i) { ck[i] = *(const u32x4*)(pr + C_CKV + sub * 16 + i * 8);
#pragma unroll
            for (int e = 0; e < 4; ++e) { const float a = lo_bf(ck[i][e]), c = hi_bf(ck[i][e]); sk += a * a + c * c; } }
        sq += __shfl_xor(sq, 1); sq += __shfl_xor(sq, 2); sq += __shfl_xor(sq, 4);
        sk += __shfl_xor(sk, 1); sk += __shfl_xor(sk, 2); sk += __shfl_xor(sk, 4);
        const float rq = rsqrtf(sq * (1.f / 256.f) + EPS), rk = rsqrtf(sk * (1.f / 128.f) + EPS);
        const float* gq = p.in[I_GQN] + l * 256 + sub * 32; const float* gk = p.in[I_GKVN] + l * 128 + sub * 16;
#pragma unroll
        for (int i = 0; i < 4; ++i) { u32x4 o;
#pragma unroll
            for (int e = 0; e < 4; ++e) o[e] = pk2(lo_bf(cq[i][e]) * rq * gq[i * 8 + 2 * e], hi_bf(cq[i][e]) * rq * gq[i * 8 + 2 * e + 1]);
            *(u32x4*)(aq + tk * 264 + sub * 32 + i * 8) = o; }
#pragma unroll
        for (int i = 0; i < 2; ++i) { u32x4 o;
#pragma unroll
            for (int e = 0; e < 4; ++e) o[e] = pk2(lo_bf(ck[i][e]) * rk * gk[i * 8 + 2 * e], hi_bf(ck[i][e]) * rk * gk[i * 8 + 2 * e + 1]);
            *(u32x4*)(akv + tk * 136 + sub * 16 + i * 8) = o; }
    }
    bf16_t* Qb = (bf16_t*)(p.ws + WS_QB); bf16_t* Kb = (bf16_t*)(p.ws + WS_KB); bf16_t* Vt = (bf16_t*)(p.ws + WS_VT);
    {
        const int tk = tid >> 3, i0 = (tid & 7) * 4, seg = i0 >> 4, half = (i0 >> 3) & 1, f0 = i0 & 7;
        const bf16_t* pr = proj + (size_t)(r0 + tk) * PW + C_KR;
        const u32x2 me = *(const u32x2*)(pr + i0), pa = *(const u32x2*)(pr + (i0 ^ 8));
        float mv[4] = {lo_bf(me.x), hi_bf(me.x), lo_bf(me.y), hi_bf(me.y)}, pv[4] = {lo_bf(pa.x), hi_bf(pa.x), lo_bf(pa.y), hi_bf(pa.y)}, ov[4];
#pragma unroll
        for (int j = 0; j < 4; ++j) {
            if (lat) { float cs, sn; rope_cs_tab(rt, tl0 + tk, seg, f0 + j, cs, sn); ov[j] = half ? (pv[j] * sn + mv[j] * cs) : (mv[j] * cs - pv[j] * sn); }
            else ov[j] = mv[j]; }
        u32x2 o; o.x = pk2(ov[0], ov[1]); o.y = pk2(ov[2], ov[3]);
#pragma unroll
        for (int hh = 0; hh < 4; ++hh) *(u32x2*)(Kb + ((size_t)(b * 4 + hh) * KEYS + key0 + tk) * 96 + 64 + i0) = o;
    }
    __syncthreads();
    const bf16_t* WuqT = (const bf16_t*)(p.ws + WS_WUQ); const bf16_t* WukvT = (const bf16_t*)(p.ws + WS_WUKV);
    const float qs = 0.10206207261596577f * 1.4426950408889634f;
    for (int ct = w; ct < 24; ct += 8) {
        f32x4 acc[4];
#pragma unroll
        for (int tt = 0; tt < 4; ++tt) acc[tt] = (f32x4){0.f, 0.f, 0.f, 0.f};
        bf16x8 wa[8];
#pragma unroll
        for (int ks = 0; ks < 8; ++ks) wa[ks] = *(const bf16x8*)(WuqT + (size_t)(16 * ct + fr) * 256 + 32 * ks + 8 * fq);
#pragma unroll
        for (int kh = 0; kh < 4; ++kh) { bf16x8 bb[2][4];
#pragma unroll
            for (int k2 = 0; k2 < 2; ++k2)
#pragma unroll
                for (int tt = 0; tt < 4; ++tt) bb[k2][tt] = *(const bf16x8*)(aq + (16 * tt + fr) * 264 + 32 * (2 * kh + k2) + 8 * fq);
            __builtin_amdgcn_sched_barrier(0);
#pragma unroll
            for (int k2 = 0; k2 < 2; ++k2)
#pragma unroll
                for (int tt = 0; tt < 4; ++tt) acc[tt] = MFMA16(wa[2 * kh + k2], bb[k2][tt], acc[tt]); }
        const int hq = ct / 6, dt = ct % 6;
#pragma unroll
        for (int tt = 0; tt < 4; ++tt) { const int tk = 16 * tt + fr; f32x4 v = acc[tt];
            if (dt >= 4 && lat) { const int seg = dt - 4, half = fq >> 1;
#pragma unroll
                for (int j = 0; j < 4; ++j) { const float pa = __shfl_xor(v[j], 32); float cs, sn; rope_cs_tab(rt, tl0 + tk, seg, 4 * (fq & 1) + j, cs, sn);
                    v[j] = half ? (pa * sn + v[j] * cs) : (v[j] * cs - pa * sn); } }
            u32x2 o; o.x = pk2(v[0] * qs, v[1] * qs); o.y = pk2(v[2] * qs, v[3] * qs);
            *(u32x2*)(Qb + ((size_t)(b * 4 + hq) * KEYS + key0 + tk) * 96 + 16 * dt + 4 * fq) = o; }
    }
    for (int ct = w; ct < 40; ct += 8) {
        const int hk = ct / 10, dt = ct % 10;
        f32x4 acc[4];
#pragma unroll
        for (int tt = 0; tt < 4; ++tt) acc[tt] = (f32x4){0.f, 0.f, 0.f, 0.f};
        bf16x8 wa[4];
#pragma unroll
        for (int ks = 0; ks < 4; ++ks) wa[ks] = *(const bf16x8*)(WukvT + (size_t)(16 * ct + fr) * 128 + 32 * ks + 8 * fq);
#pragma unroll
        for (int kh = 0; kh < 2; ++kh) { bf16x8 bb[2][4];
#pragma unroll
            for (int k2 = 0; k2 < 2; ++k2)
#pragma unroll
                for (int tt = 0; tt < 4; ++tt) bb[k2][tt] = *(const bf16x8*)(akv + (16 * tt + fr) * 136 + 32 * (2 * kh + k2) + 8 * fq);
            __builtin_amdgcn_sched_barrier(0);
#pragma unroll
            for (int k2 = 0; k2 < 2; ++k2)
#pragma unroll
                for (int tt = 0; tt < 4; ++tt) acc[tt] = dt < 4 ? MFMA16(wa[2 * kh + k2], bb[k2][tt], acc[tt]) : MFMA16(bb[k2][tt], wa[2 * kh + k2], acc[tt]); }
#pragma unroll
        for (int tt = 0; tt < 4; ++tt) { const f32x4 v = acc[tt]; u32x2 o; o.x = pk2(v[0], v[1]); o.y = pk2(v[2], v[3]);
            if (dt < 4) *(u32x2*)(Kb + ((size_t)(b * 4 + hk) * KEYS + key0 + 16 * tt + fr) * 96 + 16 * dt + 4 * fq) = o;
            else *(u32x2*)(Vt + ((size_t)(b * 4 + hk) * 96 + 16 * (dt - 4) + fr) * KEYS + key0 + 32 * (tt >> 1) + 8 * fq + 4 * (tt & 1)) = o; }
    }
    __syncthreads();
}

template <int VAR>
__device__ __forceinline__ void attn_item(const KP& p, int item, unsigned char* shm) {
    const int tid = ltid(), w = tid >> 6, lane = tid & 63, fr = lane & 15, fq = lane >> 4;
    const int qb = item < 256 ? (item & 7) : 8, bh = item < 256 ? (item >> 3) : item - 256, b = bh >> 2, h = bh & 3;
    const int kbeg = qb < 8 ? 0 : SEQ, ntile = qb < 8 ? KEYS / 64 : CL / 64;
    const bf16_t* Qb = (const bf16_t*)(p.ws + WS_QB) + (size_t)bh * KEYS * 96;
    const bf16_t* Kb = (const bf16_t*)(p.ws + WS_KB) + (size_t)bh * KEYS * 96;
    const bf16_t* Vt = (const bf16_t*)(p.ws + WS_VT) + (size_t)bh * 96 * KEYS;
    const int q0 = qb * 256 + 32 * w;
    bf16x8 qf[2][3];
#pragma unroll
    for (int qt = 0; qt < 2; ++qt)
#pragma unroll
        for (int ks = 0; ks < 3; ++ks) qf[qt][ks] = *(const bf16x8*)(Qb + (size_t)(q0 + 16 * qt + fr) * 96 + 32 * ks + 8 * fq);
    f32x4 O[6][2];
#pragma unroll
    for (int dt = 0; dt < 6; ++dt) { O[dt][0] = (f32x4){0.f, 0.f, 0.f, 0.f}; O[dt][1] = (f32x4){0.f, 0.f, 0.f, 0.f}; }
    float mrow[2] = {-1e30f, -1e30f}, lrow[2] = {0.f, 0.f};
    u32x4 pre[6];
    constexpr int ABUF = (64 * 104 + 96 * 72) * 2;
    auto gload = [&](int kp) {
#pragma unroll
        for (int sub = 0; sub < 2; ++sub) { const int key0 = kbeg + (2 * kp + sub) * 64;
#pragma unroll
            for (int i = 0; i < 3; ++i) { const int c = tid + 512 * i;
                if (c < 768) pre[3 * sub + i] = *(const u32x4*)(Kb + (size_t)key0 * 96 + c * 8);
                else { const int cc = c - 768, dv = cc >> 3, part = cc & 7; pre[3 * sub + i] = *(const u32x4*)(Vt + (size_t)dv * KEYS + key0 + part * 8); } } }
    };
    auto lstore = [&](int buf) {
#pragma unroll
        for (int sub = 0; sub < 2; ++sub) { bf16_t* Kw = (bf16_t*)(shm + (2 * buf + sub) * ABUF); bf16_t* Vw = Kw + 64 * 104;
#pragma unroll
            for (int i = 0; i < 3; ++i) { const int c = tid + 512 * i;
                if (c < 768) { const int key = c / 12, part = c % 12; *(u32x4*)(Kw + key * 104 + part * 8) = pre[3 * sub + i]; }
                else { const int cc = c - 768, dv = cc >> 3, part = cc & 7; *(u32x4*)(Vw + dv * 72 + part * 8) = pre[3 * sub + i]; } } }
    };
    const int npair = ntile >> 1;
    gload(0);
    lstore(0);
    __syncthreads();
    if (npair > 1) gload(1);
    for (int kp = 0; kp < npair; ++kp) {
#pragma unroll
      for (int sub = 0; sub < 2; ++sub) {
        const bf16_t* Kc = (const bf16_t*)(shm + (2 * (kp & 1) + sub) * ABUF); const bf16_t* Vc = Kc + 64 * 104;
        bf16x8 kf[4][3];
#pragma unroll
        for (int kk = 0; kk < 4; ++kk)
#pragma unroll
            for (int ks = 0; ks < 3; ++ks) kf[kk][ks] = *(const bf16x8*)(Kc + (16 * kk + fr) * 104 + 32 * ks + 8 * fq);
        __builtin_amdgcn_sched_barrier(0);
        f32x4 S[4][2];
#pragma unroll
        for (int kk = 0; kk < 4; ++kk) { S[kk][0] = (f32x4){0.f, 0.f, 0.f, 0.f}; S[kk][1] = (f32x4){0.f, 0.f, 0.f, 0.f}; }
        bf16x8 P[2][2];
        auto softmax_qt = [&](const int qt) {
            float mx = S[0][qt][0];
#pragma unroll
            for (int kk = 0; kk < 4; ++kk)
#pragma unroll
                for (int j = 0; j < 4; ++j) mx = fmaxf(mx, S[kk][qt][j]);
            mx = max_over_fq(mx);
            if (__any(mx > mrow[qt] + 8.f)) {
                const float mnew = fmaxf(mrow[qt], mx), alpha = __builtin_amdgcn_exp2f(mrow[qt] - mnew); mrow[qt] = mnew;
                lrow[qt] *= alpha;
#pragma unroll
                for (int dt = 0; dt < 6; ++dt) O[dt][qt] *= alpha;
            }
            const float mn = mrow[qt];
            float ps = 0.f; unsigned pk[8];
#pragma unroll
            for (int kk = 0; kk < 4; ++kk) { const float e0 = __builtin_amdgcn_exp2f(S[kk][qt][0] - mn), e1 = __builtin_amdgcn_exp2f(S[kk][qt][1] - mn), e2 = __builtin_amdgcn_exp2f(S[kk][qt][2] - mn), e3 = __builtin_amdgcn_exp2f(S[kk][qt][3] - mn);
                ps += (e0 + e1) + (e2 + e3); pk[2 * kk] = pk2(e0, e1); pk[2 * kk + 1] = pk2(e2, e3); }
            lrow[qt] += ps;
            u32x4 t0 = {pk[0], pk[1], pk[2], pk[3]}, t1 = {pk[4], pk[5], pk[6], pk[7]};
            P[qt][0] = __builtin_bit_cast(bf16x8, t0); P[qt][1] = __builtin_bit_cast(bf16x8, t1);
        };
#pragma unroll
        for (int ks = 0; ks < 3; ++ks)
#pragma unroll
            for (int kk = 0; kk < 4; ++kk) S[kk][0] = MFMA16(kf[kk][ks], qf[0][ks], S[kk][0]);
        __builtin_amdgcn_sched_barrier(0);
#pragma unroll
        for (int ks = 0; ks < 3; ++ks)
#pragma unroll
            for (int kk = 0; kk < 4; ++kk) S[kk][1] = MFMA16(kf[kk][ks], qf[1][ks], S[kk][1]);
        softmax_qt(0);
        __builtin_amdgcn_sched_barrier(0);
        bf16x8 vf[6][2];
#pragma unroll
        for (int dt = 0; dt < 6; ++dt)
#pragma unroll
            for (int k2 = 0; k2 < 2; ++k2) vf[dt][k2] = *(const bf16x8*)(Vc + (16 * dt + fr) * 72 + 32 * k2 + 8 * fq);
        __builtin_amdgcn_sched_barrier(0);
#pragma unroll
        for (int dt = 0; dt < 6; ++dt)
#pragma unroll
            for (int k2 = 0; k2 < 2; ++k2) O[dt][0] = MFMA16(vf[dt][k2], P[0][k2], O[dt][0]);
        softmax_qt(1);
        __builtin_amdgcn_sched_barrier(0);
#pragma unroll
        for (int dt = 0; dt < 6; ++dt)
#pragma unroll
            for (int k2 = 0; k2 < 2; ++k2) O[dt][1] = MFMA16(vf[dt][k2], P[1][k2], O[dt][1]);
      }
        if (kp + 1 < npair) lstore((kp + 1) & 1);
        __syncthreads();
        if (kp + 2 < npair) gload(kp + 2);
    }
    bf16_t* mix = (bf16_t*)(p.ws + WS_MIX);
#pragma unroll
    for (int qt = 0; qt < 2; ++qt) { float lt = lrow[qt]; lt += __shfl_xor(lt, 16); lt += __shfl_xor(lt, 32); const float inv = 1.f / lt;
        const int q = q0 + 16 * qt + fr; const size_t row = q < SEQ ? (size_t)b * SEQ + q : (size_t)TL + b * CL + (q - SEQ);
#pragma unroll
        for (int dt = 0; dt < 6; ++dt) { const f32x4 v = O[dt][qt] * inv; u32x2 o; o.x = pk2(v[0], v[1]); o.y = pk2(v[2], v[3]);
            *(u32x2*)(mix + row * D + 640 + h * 96 + 16 * dt + 4 * fq) = o; } }
    __syncthreads();
}


#ifdef DIAG
__device__ __forceinline__ float block_max(float v, float* red) {
    const int tid = ltid();
#pragma unroll
    for (int o = 1; o < 64; o <<= 1) v = fmaxf(v, __shfl_xor(v, o));
    __syncthreads(); if ((tid & 63) == 0) red[tid >> 6] = v; __syncthreads();
    float r = red[0];
#pragma unroll
    for (int i = 1; i < 8; ++i) r = fmaxf(r, red[i]);
    __syncthreads(); return r;
}
__device__ __forceinline__ float block_sum(float v, float* red) {
    const int tid = ltid();
    v = wave_sum(v);
    __syncthreads(); if ((tid & 63) == 0) red[tid >> 6] = v; __syncthreads();
    float r = 0.f;
#pragma unroll
    for (int i = 0; i < 8; ++i) r += red[i];
    __syncthreads(); return r;
}
__device__ __forceinline__ float dg_conv(const KP& p, int l, int rbase, int slen, int t, int chg) {
    const bf16_t* proj = (const bf16_t*)(p.ws + WS_PROJ); float a = 0.f;
    for (int i = 0; i < 5; ++i) { const int tt = t - 2 + i; if (tt < 0 || tt >= slen) continue;
        a += bf2f(proj[(size_t)(rbase + tt) * PW + chg]) * p.in[I_CONV][(size_t)l * 5 * 768 + i * 768 + chg]; }
    return siluf(a);
}
__device__ __forceinline__ float diag_mlstm(const KP& p, int l, int b, int h, int tsel, unsigned char* shm) {
    const int tid = ltid();
    float* Ff = (float*)shm; float* Gb = Ff + 2304; float* If = Gb + 2304; float* Ib = If + 2304; float* Wf = Ib + 2304; float* Wb = Wf + 2304; float* qt = Wb + 2304; float* red = qt + 96; float* yr = red + 16;
    const float* gates = (const float*)(p.ws + WS_GATES); const float* bg = p.in[I_BG] + l * 16;
    const bf16_t* proj = (const bf16_t*)(p.ws + WS_PROJ);
    for (int pos = tid; pos < 2304; pos += 512) { const int row = pos < 256 ? TL + b * CL + pos : b * SEQ + (pos - 256); const float* gp = gates + (size_t)row * 16;
        const int pb = pos < 256 ? 2048 + pos : pos - 256;
        If[pos] = gp[h] + bg[h]; Ff[pos] = logsig(gp[4 + h] + bg[4 + h]); Ib[pb] = gp[8 + h] + bg[8 + h]; Gb[pb] = logsig(gp[12 + h] + bg[12 + h]); }
    __syncthreads();
    if (tid == 0) { float a = 0.f; for (int i = 0; i < 2304; ++i) { a += Ff[i]; Ff[i] = a; } a = 0.f; for (int i = 2303; i >= 0; --i) { a += Gb[i]; Gb[i] = a; } }
    if (tid < 96) qt[tid] = dg_conv(p, l, b * SEQ, SEQ, tsel, h * 96 + tid) * 0.10206207261596577f;
    __syncthreads();
    const int tf = 256 + tsel, tb = tsel;
    for (int pos = tid; pos < 2304; pos += 512) { const bool isc = pos < 256; const int rbase = isc ? TL + b * CL : b * SEQ, slen = isc ? CL : SEQ, t = isc ? pos : pos - 256;
        float dot = 0.f; for (int d = 0; d < 96; ++d) dot += qt[d] * dg_conv(p, l, rbase, slen, t, 384 + h * 96 + d);
        const int pb = isc ? 2048 + pos : pos - 256;
        Wf[pos] = pos <= tf ? dot * __expf(Ff[tf] - Ff[pos] + If[pos]) : 0.f;
        Wb[pos] = pb >= tb ? dot * __expf(Gb[tb] - Gb[pb] + Ib[pb]) : 0.f; }
    __syncthreads();
    float hv = 0.f;
    if (tid < 96) { float nf = 0.f, nb = 0.f, df = 0.f, db = 0.f;
        for (int pos = 0; pos < 2304; ++pos) { const int row = pos < 256 ? TL + b * CL + pos : b * SEQ + (pos - 256); const float v = bf2f(proj[(size_t)row * PW + C_MV + h * 96 + tid]);
            nf += Wf[pos] * v; nb += Wb[pos] * v; df += Wf[pos]; db += Wb[pos]; }
        hv = nf / fmaxf(fabsf(df), 1.f) + nb / fmaxf(fabsf(db), 1.f); }
    const float ss = block_sum(tid < 96 ? hv * hv : 0.f, red);
    float diff = 0.f;
    if (tid < 96) { const int row = b * SEQ + tsel; const float mo = bf2f(proj[(size_t)row * PW + C_MO + h * 96 + tid]);
        const float y = hv * rsqrtf(ss * (1.f / 96.f) + EPS) * p.in[I_GM][l * 384 + h * 96 + tid] / (1.f + __expf(-mo));
        const float yf = bf2f(((const bf16_t*)(p.ws + WS_MIX))[(size_t)row * D + 256 + h * 96 + tid]);
        diff = fabsf(y - yf); }
    return block_max(diff, red);
}
__device__ __forceinline__ float diag_attn(const KP& p, int l, int b, int h, int qsel, unsigned char* shm) {
    const int tid = ltid();
    float* sc = (float*)shm; float* qv = sc + 2304; float* red = qv + 96; float* nq = red + 16;
    float* Vs = (float*)(p.ws + WS_HID + 100000000);
    const bf16_t* proj = (const bf16_t*)(p.ws + WS_PROJ);
    const float* wuq = p.in[I_WUQ] + (size_t)l * 256 * 384; const float* wukv = p.in[I_WUKV] + (size_t)l * 128 * 640;
    const int qrow = b * SEQ + qsel;
    { float v = tid < 256 ? bf2f(proj[(size_t)qrow * PW + C_CQ + tid]) : 0.f; const float ss = block_sum(v * v, red);
      if (tid < 256) nq[tid] = v * rsqrtf(ss * (1.f / 256.f) + EPS) * p.in[I_GQN][l * 256 + tid]; }
    __syncthreads();
    if (tid < 96) { float a = 0.f; for (int k = 0; k < 256; ++k) a += nq[k] * wuq[(size_t)k * 384 + h * 96 + tid]; qv[tid] = a; }
    __syncthreads();
    if (tid < 16) {
        const int seg = tid >> 3, f = tid & 7; float cs, sn; rope_cs(qsel, seg, f, cs, sn);
        const float x1 = qv[64 + seg * 16 + f], x2 = qv[64 + seg * 16 + 8 + f]; qv[64 + seg * 16 + f] = x1 * cs - x2 * sn; qv[64 + seg * 16 + 8 + f] = x1 * sn + x2 * cs; }
    __syncthreads();
    for (int key = tid; key < 2304; key += 512) { const bool lat = key < SEQ; const int row = lat ? b * SEQ + key : TL + b * CL + (key - SEQ);
        const bf16_t* pr = proj + (size_t)row * PW;
        float ss = 0.f; for (int k = 0; k < 128; ++k) { const float v = bf2f(pr[C_CKV + k]); ss += v * v; }
        const float rk = rsqrtf(ss * (1.f / 128.f) + EPS);
        float s = 0.f;
        for (int c = 0; c < 160; ++c) { float a = 0.f; for (int k = 0; k < 128; ++k) a += bf2f(pr[C_CKV + k]) * rk * p.in[I_GKVN][l * 128 + k] * wukv[(size_t)k * 640 + h * 160 + c];
            if (c < 64) s += qv[c] * a; else Vs[(size_t)key * 96 + (c - 64)] = a; }
        for (int seg = 0; seg < 2; ++seg) for (int f = 0; f < 8; ++f) { float x1 = bf2f(pr[C_KR + seg * 16 + f]), x2 = bf2f(pr[C_KR + seg * 16 + 8 + f]);
            if (lat) { float cs, sn; rope_cs(key, seg, f, cs, sn); const float o1 = x1 * cs - x2 * sn, o2 = x1 * sn + x2 * cs; x1 = o1; x2 = o2; }
            s += qv[64 + seg * 16 + f] * x1 + qv[64 + seg * 16 + 8 + f] * x2; }
        sc[key] = s * 0.10206207261596577f; }
    __syncthreads();
    float mx = -1e30f; for (int key = tid; key < 2304; key += 512) mx = fmaxf(mx, sc[key]); mx = block_max(mx, red);
    float sm = 0.f; for (int key = tid; key < 2304; key += 512) { const float e = __expf(sc[key] - mx); sc[key] = e; sm += e; } sm = block_sum(sm, red);
    __threadfence(); __syncthreads();
    float diff = 0.f;
    if (tid < 96) { float a = 0.f; for (int key = 0; key < 2304; ++key) a += sc[key] * Vs[(size_t)key * 96 + tid]; a /= sm;
        const float yf = bf2f(((const bf16_t*)(p.ws + WS_MIX))[(size_t)qrow * D + 640 + h * 96 + tid]); diff = fabsf(a - yf); }
    return block_max(diff, red);
}

__device__ __forceinline__ float diag_fourier(const KP& p, int b, int g, unsigned char* shm) {
    const int tid = ltid();
    float* hrow = (float*)shm; float* red = hrow + 1024;
    float* pf = (float*)(p.ws + WS_HID + 100000000);
    const float* mod = (const float*)(p.ws + WS_MOD) + (size_t)b * 6144;
    for (int n = 0; n < 2048; ++n) {
        const float* xr = p.in[I_X] + ((size_t)b * SEQ + n) * D;
        const float x0 = xr[tid], x1 = xr[tid + 512];
        const float ss = block_sum(x0 * x0 + x1 * x1, red); const float rstd = rsqrtf(ss * (1.f / D) + EPS);
        hrow[tid] = x0 * rstd * p.in[I_G1][tid] * (1.f + mod[1024 + tid]) + mod[tid];
        hrow[tid + 512] = x1 * rstd * p.in[I_G1][tid + 512] * (1.f + mod[1024 + tid + 512]) + mod[tid + 512];
        __syncthreads();
        { const int c = tid & 63, ks = tid >> 6; float a = 0.f;
          for (int k = ks * 128; k < ks * 128 + 128; ++k) a += hrow[k] * p.in[I_WIN][(size_t)k * 2224 + g * 64 + c];
          red[16 + ks * 64 + c] = a; }
        __syncthreads();
        if (tid < 64) { float a = 0.f; for (int q = 0; q < 8; ++q) a += red[16 + q * 64 + tid]; pf[n * 64 + tid] = a; }
        __syncthreads();
    }
    __threadfence(); __syncthreads();
    float worst = 0.f;
#pragma unroll 1
    for (int i = 0; i < 6; ++i) { const int k = i == 0 ? 0 : i == 1 ? 1 : i == 2 ? 5 : i == 3 ? 1000 : i == 4 ? 1024 : 2047;
        const int cp = tid & 63, ns = tid >> 6; float a = 0.f;
        for (int n = ns * 256; n < ns * 256 + 256; ++n) for (int c = 0; c < 64; ++c) { const int idx = (k * n + 32 * c * cp) & 2047; a += pf[n * 64 + c] * cospif((float)idx * (1.f / 1024.f)); }
        __syncthreads(); red[16 + ns * 64 + cp] = a; __syncthreads();
        float diff = 0.f;
        if (tid < 64) { float y = 0.f; for (int q = 0; q < 8; ++q) y += red[16 + q * 64 + tid]; y *= 0.00276213586400995f;
            const float yf = bf2f(((const bf16_t*)(p.ws + WS_MIX))[((size_t)b * SEQ + k) * D + g * 64 + tid]); diff = fabsf(y - yf); }
        worst = fmaxf(worst, block_max(diff, red));
    }
    return worst;
}

__device__ __forceinline__ int dg_row(int i) { return i == 0 ? 0 : i == 1 ? 1 : i == 2 ? 255 : i == 3 ? 256 : i == 4 ? 5000 : i == 5 ? 16383 : i == 6 ? 16384 : 18431; }
__device__ __forceinline__ float diag_g2(const KP& p, int i, unsigned char* shm) {
    const int tid = ltid(); float* red = (float*)shm;
    const int r = dg_row(i), b = r < TL ? r >> 11 : 8;
    const bf16_t* mr = (const bf16_t*)(p.ws + WS_MIX) + (size_t)r * D;
    const float* xo = r < TL ? p.in[I_X] + (size_t)r * D : p.in[I_CTX] + (size_t)(r - TL) * D;
    const float* xn = r < TL ? p.out + (size_t)r * D : (const float*)(p.ws + WS_XCTX) + (size_t)(r - TL) * D;
    const float* mod = (const float*)(p.ws + WS_MOD);
    float diff = 0.f;
    for (int c = tid; c < 1024; c += 512) { float a = 0.f; for (int j = 0; j < 1024; ++j) a += bf2f(mr[j]) * p.in[I_WOUT][(size_t)j * 1024 + c];
        diff = fmaxf(diff, fabsf(xo[c] + mod[(size_t)b * 6144 + 2048 + c] * a - xn[c])); }
#ifdef DIAG_MODONLY
    diff = 0.f;
#endif
#ifndef DIAG_G2ONLY
    { const int l = i & 1, j = (37 * tid + 11 * i) % 6144; float a = 0.f;
      for (int k = 0; k < 1024; ++k) { const float cv = b < 8 ? p.in[I_C][b * 1024 + k] : p.in[I_CCTX][k]; a += siluf(cv) * p.in[I_WMOD][(size_t)l * 1024 * 6144 + (size_t)k * 6144 + j]; }
      a += p.in[I_BMOD][l * 6144 + j]; diff = fmaxf(diff, fabsf(a - mod[(size_t)(l * 9 + b) * 6144 + j])); }
#endif
    return block_max(diff, red);
}
__device__ __forceinline__ float diag_g3(const KP& p, int i, unsigned char* shm) {
    const int tid = ltid(); float* red = (float*)shm; float* hr = red + 16;
    const int r = dg_row(i), b = r < TL ? r >> 11 : 8;
    const float* xr = r < TL ? p.out + (size_t)r * D : (const float*)(p.ws + WS_XCTX) + (size_t)(r - TL) * D;
    const float* mod = (const float*)(p.ws + WS_MOD) + (size_t)b * 6144;
    const bf16_t* hb = (const bf16_t*)(p.ws + WS_HBUF) + (size_t)r * D;
    const float x0 = xr[tid], x1 = xr[tid + 512];
    const float ss = block_sum(x0 * x0 + x1 * x1, red); const float rstd = rsqrtf(ss * (1.f / D) + EPS);
    float diff = 0.f;
    { const float h0 = x0 * rstd * p.in[I_G2][tid] * (1.f + mod[4096 + tid]) + mod[3072 + tid], h1 = x1 * rstd * p.in[I_G2][tid + 512] * (1.f + mod[4096 + tid + 512]) + mod[3072 + tid + 512];
      diff = fmaxf(fabsf(h0 - bf2f(hb[tid])), fabsf(h1 - bf2f(hb[tid + 512]))); hr[tid] = bf2f(hb[tid]); hr[tid + 512] = bf2f(hb[tid + 512]); }
    __syncthreads();
    const bf16_t* hid = (const bf16_t*)(p.ws + WS_HID) + (size_t)r * 4096;
    for (int j = tid; j < 4096; j += 512) { float a = 0.f; for (int k = 0; k < 1024; ++k) a += hr[k] * p.in[I_WUP][(size_t)k * 4096 + j];
        a = fmaxf(a, 0.f); a = a * a; diff = fmaxf(diff, fabsf(a - bf2f(hid[j])) / (1.f + fabsf(a))); }
    return block_max(diff, red);
}
#endif


#define XB_TMO      128
#define XB_XCNT(j)  (256  + 64 * (j))
#define XB_XSUB(j)  (1280 + 64 * (j))
#define XB_XGEN(j)  (2304 + 64 * (j))
#define XB_TOP      3328
#define XB_TOPGEN   3392
#define XCD_BAR_WORDS 3456
#define XB_SPIN_CAP (1u << 18)
#define LAS __attribute__((address_space(3)))
__device__ __forceinline__ unsigned xb_ld(unsigned* p)              { return __hip_atomic_load(p, __ATOMIC_RELAXED, __HIP_MEMORY_SCOPE_AGENT); }
__device__ __forceinline__ unsigned xb_add(unsigned* p, unsigned v) { return __hip_atomic_fetch_add(p, v, __ATOMIC_RELAXED, __HIP_MEMORY_SCOPE_AGENT); }
__device__ __forceinline__ unsigned xb_xcc_id() { return (unsigned)__builtin_amdgcn_s_getreg((3 << 11) | 20) & 0xFu; }
#define XB_SPIN(cond, bar) do { unsigned _sp = 0; while (cond) { __builtin_amdgcn_s_sleep(1); \
    if ((++_sp & 255u) == 0u) { if (xb_ld(&(bar)[XB_TMO])) break; if (_sp > XB_SPIN_CAP) { atomicAdd(&(bar)[XB_TMO], 1u); break; } } } } while (0)
struct XcdBarrier { unsigned* bar; unsigned x; volatile LAS unsigned* st; };
__device__ __forceinline__ XcdBarrier xcd_barrier_post(unsigned* bar, volatile LAS unsigned* st) {
    XcdBarrier b; b.bar = bar; b.x = xb_xcc_id(); b.st = st;
    if (threadIdx.x == 0) (void)xb_add(&bar[XB_XCNT(b.x)], 1u);
    return b;
}
__device__ __forceinline__ void xcd_barrier_complete(unsigned* bar, unsigned x, unsigned& nloc, unsigned& nx) {
    const unsigned G = gridDim.x * gridDim.y * gridDim.z;
    unsigned sum, cnt, mine, sp = 0u;
    for (;;) {
        sum = 0u; cnt = 0u; mine = 0u;
#pragma unroll
        for (unsigned j = 0; j < 16; ++j) { const unsigned c = xb_ld(&bar[XB_XCNT(j)]); sum += c; cnt += (c > 0u) ? 1u : 0u; mine = (j == x) ? c : mine; }
        if (sum == G) break;
        __builtin_amdgcn_s_sleep(1);
        if ((++sp & 255u) == 0u) { if (xb_ld(&bar[XB_TMO])) break; if (sp > XB_SPIN_CAP) { atomicAdd(&bar[XB_TMO], 1u); break; } }
    }
    nloc = mine > 0u ? mine : 1u; nx = cnt > 0u ? cnt : 1u;
}
__device__ __forceinline__ void xcd_barrier(const XcdBarrier& b) {
    asm volatile("s_waitcnt vmcnt(0)" ::: "memory");
    __syncthreads();
    if (threadIdx.x == 0) {
        unsigned* bar = b.bar;
        __builtin_amdgcn_s_waitcnt(0);
        unsigned nloc = b.st[0], nx = b.st[1];
        if (nloc == 0u) { xcd_barrier_complete(bar, b.x, nloc, nx); b.st[0] = nloc; b.st[1] = nx; }
        const unsigned old = xb_add(&bar[XB_XSUB(b.x)], 1u);
        const unsigned gen = old / nloc;
        if (old + 1u == (gen + 1u) * nloc) {
            __builtin_amdgcn_fence(__ATOMIC_RELEASE, "agent");
            asm volatile("s_waitcnt vmcnt(0)" ::: "memory");
            const unsigned og = xb_add(&bar[XB_TOP], 1u);
            const unsigned tg = og / nx;
            if (og + 1u == (tg + 1u) * nx) xb_add(&bar[XB_TOPGEN], 1u);
            else XB_SPIN(xb_ld(&bar[XB_TOPGEN]) == tg, bar);
            __builtin_amdgcn_fence(__ATOMIC_ACQUIRE, "agent");
            xb_add(&bar[XB_XGEN(b.x)], 1u);
            asm volatile("s_waitcnt vmcnt(0)" ::: "memory");
        } else {
            XB_SPIN(xb_ld(&bar[XB_XGEN(b.x)]) == gen, bar);
            __builtin_amdgcn_fence(__ATOMIC_ACQUIRE, "agent");
            asm volatile("s_waitcnt vmcnt(0)" ::: "memory");
        }
    }
    __syncthreads();
}

__device__ __attribute__((noinline)) void grid_sync_fn() { cg::this_grid().sync(); }
__global__ __launch_bounds__(512, 2) void mega(KP p) {
    extern __shared__ __attribute__((aligned(16))) unsigned char shm[];
    volatile LAS unsigned* xst = (volatile LAS unsigned*)(LAS unsigned char*)(shm + LDS_BYTES - 16);
    if (threadIdx.x == 0) { xst[0] = 0u; xst[1] = 0u; }
    __syncthreads();
    if (p.ph_lo < 0) grid_sync_fn();
    const XcdBarrier xbar = xcd_barrier_post((unsigned*)(p.ws + WS_BAR), xst);
    for (int s = p.ph_lo; s < p.ph_hi; ++s) {
      if (s == 16) continue;
      const int nrep = (s >= 1 && s < 19 && ((REPMASK >> ((s - 1) % 9)) & 1)) ? 2 : 1;
      for (int rep = 0; rep < nrep; ++rep) {
        const int G = gridDim.x, bid = lbid();
        unsigned char* ws = p.ws; asm volatile("" : "+s"(ws));
        float* outp = p.out; asm volatile("" : "+s"(outp));
        if (s == 0) { if (PHMASK & 512) step_prep0(p, shm);
#ifdef REP_PREP
            xcd_barrier(xbar); step_prep0(p, shm);
#endif
        }
        else if (s == 19) { if (PHMASK & 1024) step_final(p); }
        else {
            const int l = (s - 1) / 9, ph = (s - 1) % 9; const bool last = l == 1;
            const float* modl = (const float*)(ws + WS_MOD) + (size_t)l * 9 * 6144;
            const float* xl = l == 0 ? p.in[I_X] : outp; const float* xc = l == 0 ? p.in[I_CTX] : (const float*)(ws + WS_XCTX);
            const int Mrows = last ? TL : TT;
            if (ph == 0) {
                if (PHMASK & 1) {
                if (l == 1) { float* tab = (float*)shm; prep_weights(p, 1, shm, tab, 2); }
                norm_rows(xl, xc, TT, p.in[I_G1] + l * D, modl, 0, 1024, (bf16_t*)(ws + WS_HBUF), l == 1 ? (const bf16_t*)(ws + WS_PART) : nullptr, (const float*)(ws + WS_MOD) + 8 * 6144 + 5120, nullptr, l == 1 ? TL : 0); }
            } else if (ph == 1) {
                if (PHMASK & 2) {
                EpiIn E; E.proj = (bf16_t*)(ws + WS_PROJ); E.gates = (float*)(ws + WS_GATES); E.zt = (bf16_t*)(ws + WS_ZT); E.ztc = (bf16_t*)(ws + WS_ZTC);
                run_gemm(shm, (const bf16_t*)(ws + WS_HBUF), (const bf16_t*)(ws + WS_WIN), TT, NIN, 1024, G, bid, E); }
            } else if (ph == 2) {
                if (PHMASK & 4) {
                    for (int it = bid; it < 32 * NCH + TT / 64; it += G) { if (it < 32 * NCH) mlstm_a_item(p, l, it, shm); else qkv_item(p, l, it - 32 * NCH, shm); }
                    {
                        const int nlong = (32 * NCH + TT / 64) % G, f0 = bid >= nlong ? bid - nlong : -1, fs = G - nlong;
                        if (f0 >= 0) for (int f = f0; f < 256; f += fs) zt_fold_item(p, f, shm);
                        __syncthreads(); }
                }
            } else if (ph == 3 || ph == 4) {
                if (PHMASK & 8) {
                const int nF = 64;
                if (ph == 3) mlstm_scan(p);
                {
                    int a0, a1, ast;
                    if (ph == 3) { a0 = bid; a1 = 256; ast = G; } else { a0 = (!last && bid >= nF + 8) ? 256 + (bid - nF - 8) : (1 << 30); a1 = 288; ast = G - nF - 8; }
                    for (int it = a0; it < a1; it += ast) {
                        const int item = it < 256 ? (((it & 7) * 4 + (it >> 6)) << 3) + ((it >> 3) & 7) : it;
                        attn_item<0>(p, item, shm); } }
                if (ph == 4) {
                if (bid < nF) {
                    for (int pass = 0; pass < (last ? 1 : 2); ++pass) {
                        const bool fl = pass == 0;
                        if (!fl && bid >= 8) break;
                        EpiFou E; E.mix = (bf16_t*)(ws + WS_MIX); E.rows_per_b = fl ? SEQ : CL; E.row_off = fl ? 0 : TL; E.scale = fl ? 0.00276213586400995f : 0.0078125f;
                        run_gemm(shm, (const bf16_t*)(ws + (fl ? WS_FDFT : WS_FDFTC)), (const bf16_t*)(ws + (fl ? WS_ZTF : WS_ZTC)), fl ? 2048 : 256, 2048, fl ? 2048 : 512, G, bid, E);
                    }
                } else {
                    const int vb = bid - nF, nb = G - nF, per = last ? 16 : NCH, nit = 32 * per;
                    for (int it = vb; it < nit; it += nb) { const int bh = it / per, jc = (last ? 2 : 0) + it % per; mlstm_c_item(p, l, bh >> 2, bh & 3, jc, shm); }
                } } }
            } else if (ph == 6) {
                if (PHMASK & 64) norm_rows(outp, l == 0 ? p.in[I_CTX] : (const float*)(ws + WS_XCTX), Mrows, p.in[I_G2] + l * D, modl, 3072, 4096, (bf16_t*)(ws + WS_HBUF),
                                           l == 0 ? (const bf16_t*)(ws + WS_PART) : nullptr, modl + 8 * 6144 + 2048, (float*)(ws + WS_XCTX), TL);
            } else if (ph == 7) {
                if (PHMASK & 128) {
                EpiUp E; E.hid = (bf16_t*)(ws + WS_HID);
                run_gemm(shm, (const bf16_t*)(ws + WS_HBUF), (const bf16_t*)(ws + WS_WUP), Mrows, 4096, 1024, G, bid, E); }
            } else {
                if (PHMASK & 32) {
                const bool g2 = ph == 5;
                {
                    const float* mod1 = (const float*)(ws + WS_MOD) + (size_t)9 * 6144;
                    EpiResNorm E; E.xo = g2 ? xl : outp; E.xn = outp; E.ga = modl + (g2 ? 2048 : 5120);
                    E.rss = (float*)(ws + WS_RSS) + (size_t)(2 * l + (g2 ? 0 : 1)) * TL; E.cnt = (unsigned*)(ws + WS_RCNT) + (2 * l + (g2 ? 0 : 1)) * 64 * 64;
                    E.mode = (!g2 && last) ? 1 : 0;
                    E.g = g2 ? p.in[I_G2] + l * D : (last ? p.in[I_GFIN] : p.in[I_G1] + D);
                    E.sc = g2 ? modl + 4096 : mod1 + 1024; E.sh = g2 ? modl + 3072 : mod1; E.hb = (bf16_t*)(ws + WS_HBUF);
                    pg8::Gemm gm; gm.A = (const bf16_t*)(ws + (g2 ? WS_MIX : WS_HID)); gm.Bt = (const bf16_t*)(ws + (g2 ? WS_WOUT : WS_WDOWN)); gm.M = TL; gm.N = 1024; gm.K = g2 ? 1024 : 4096; gm.ld = gm.K;
                    pg8::StaticOrder S; S.init(TL, 1024, G, bid);
                    pg8::gemm_phase<EpiResNorm, pg8::StaticOrder, false>((PG8_LAS unsigned char*)shm, gm, S, E, nullptr); }
                if (!last && !g2 && bid >= 128) { float* tab = (float*)shm; build_costab(tab); prep_weights(p, 1, shm, tab, 1, 128, G - 128); }
                if (!last) for (int su = bid; su < 128; su += G) {
                    const int ks = su >> 5, ui = su & 31, ld = g2 ? 1024 : 4096, Ks = ld >> 2;
                    EpiPart E; E.part = (bf16_t*)(ws + WS_PART) + (size_t)ks * TC * D;
                    run_gemm_ctx_split(shm, (const bf16_t*)(ws + (g2 ? WS_MIX : WS_HID)) + (size_t)TL * ld + ks * Ks, (const bf16_t*)(ws + (g2 ? WS_WOUT : WS_WDOWN)) + ks * Ks, Ks, ld, ui >> 2, ui & 3, E); }
                }
            }
        }
        if (s + 1 < p.ph_hi || rep + 1 < nrep) xcd_barrier(xbar);
      }
    }
#ifdef EXTRA_SYNCS
    for (int i = 0; i < EXTRA_SYNCS; ++i) xcd_barrier(xbar);
#endif
#ifdef DIAG
    grid_sync_fn();
    if (blockIdx.x == 0) {
        float worst = 0.f;
#pragma unroll 1
        for (int i = 0; i < 8; ++i) {
            const int tk = i == 0 ? 0 : i == 1 ? 1 : i == 2 ? 127 : i == 3 ? 128 : i == 4 ? 129 : i == 5 ? 1000 : i == 6 ? 2046 : 2047;
#if DIAG == 1
            const float d = diag_mlstm(p, 0, 3, 2, tk, shm);
#elif DIAG == 2
            const float d = diag_attn(p, 0, 3, 2, tk, shm);
#elif DIAG == 3
            const float d = i == 0 ? diag_fourier(p, 3, 2, shm) : 0.f;
#elif DIAG == 4
            const float d = fmaxf(diag_mlstm(p, 1, 5, 1, tk, shm), diag_attn(p, 1, 5, 1, tk, shm));
#elif DIAG == 5
            const float d = diag_g2(p, i, shm);
#else
            const float d = diag_g3(p, i, shm);
#endif
#ifdef DIAG_TOK
            if (i == DIAG_TOK) worst = d;
#else
            worst = fmaxf(worst, d);
#endif
        }
        if (threadIdx.x == 0) p.out[0] = 1e4f * worst;
    }
#endif
}

extern "C" void kernel_launch(void* const* d_in, const int* in_sizes, int n_in, void* d_out, int out_size, void* d_ws, size_t ws_size, hipStream_t stream) {
    static int grid_blocks = 0;
    if (grid_blocks == 0) {
        if (n_in != 20 || ws_size < WS_NEED) { fprintf(stderr, "kernel_launch: unexpected inputs (n_in %d, ws %zu, need %zu)\n", n_in, ws_size, (size_t)WS_NEED); grid_blocks = -1; return; }
        int dev = 0, cus = 0, per_cu = 0;
        hipGetDevice(&dev);
        hipDeviceGetAttribute(&cus, hipDeviceAttributeMultiprocessorCount, dev);
        hipFuncSetAttribute((const void*)mega, hipFuncAttributeMaxDynamicSharedMemorySize, LDS_BYTES);
        hipOccupancyMaxActiveBlocksPerMultiprocessor(&per_cu, (const void*)mega, 512, LDS_BYTES);
        if (per_cu < 1) per_cu = 1;
        grid_blocks = cus * per_cu;
        if (grid_blocks != 256) { fprintf(stderr, "kernel_launch: this build needs exactly 256 resident workgroups (got %d)\n", grid_blocks); grid_blocks = -1; (void)hipGetLastError(); return; }
        (void)hipGetLastError();
    }
    if (grid_blocks < 0) return;
    KP p{};
    for (int i = 0; i < 20; ++i) p.in[i] = (const float*)d_in[i];
    p.out = (float*)d_out; p.ws = (unsigned char*)d_ws; p.ph_lo = 0; p.ph_hi = 19;
#ifdef DIAG
    p.ph_hi = DIAG == 4 ? 15 : DIAG == 5 ? 7 : DIAG == 6 ? 9 : 6;
#endif
    (void)hipMemsetAsync((unsigned char*)d_ws + WS_BAR, 0, 16384, stream);
    void* args[] = {&p};
    hipError_t e = hipLaunchCooperativeKernel((const void*)mega, dim3(grid_blocks), dim3(512), args, LDS_BYTES, stream);
    if (e != hipSuccess) fprintf(stderr, "cooperative launch failed: %s (grid %d)\n", hipGetErrorString(e), grid_blocks);
}
```

```cpp
#include <hip/hip_runtime.h>
#include <hip/hip_cooperative_groups.h>
#include <cstdio>
namespace cg = cooperative_groups;
namespace pg8 {
#define PG8_LAS __attribute__((address_space(3)))
typedef unsigned short bf16_t;
typedef short bf16x8 __attribute__((ext_vector_type(8)));
typedef float f32x4 __attribute__((ext_vector_type(4)));
typedef unsigned u32x4 __attribute__((ext_vector_type(4)));
constexpr int BM = 256, BK = 64, HALF = 128, HTB = HALF * BK * 2  , STAGE_BYTES = 8 * HTB, NXCD = 8, WGM = 8;

__host__ __device__ __forceinline__ int lds_byte(int r, int c) { const int st = (r >> 4) * 2 + (c >> 5), rr = r & 15, cc = c & 31, ob = rr * 64 + cc * 2; return st * 1024 + (ob ^ (((ob >> 9) & 1) << 5)); }
__host__ __device__ __forceinline__ void stage_rc(int b, int& R, int& C) { const int st = b / 1024, sb = b % 1024, swz = sb ^ (((sb >> 9) & 1) << 5); R = (st >> 1) * 16 + swz / 64; C = (st & 1) * 32 + (swz % 64) / 2; }
__host__ __device__ __forceinline__ int perm32(int rho) { const int n = rho >> 4, i = rho & 15; return 8 * (i >> 2) + 4 * n + (i & 3); }

struct Unit { int pm, pn; };
struct Gemm { const bf16_t* A; const bf16_t* Bt; int M, N, K, ld; };

struct StaticOrder {
    int nM, nN, nwg, G, c;
    __host__ __device__ void init(int M, int N, int G_, int c_) { nM = M / BM; nN = N / BM; nwg = nM * nN; G = G_; c = c_; }
    __host__ __device__ bool next(int i, Unit& u) const {
        const long L = (long)i * G + c; if (L >= nwg) return false;
        int wgid = (int)L; { const int q = nwg / NXCD, r = nwg % NXCD, xcd = wgid % NXCD, off = wgid / NXCD; wgid = (xcd < r ? xcd * (q + 1) : r * (q + 1) + (xcd - r) * q) + off; }
        const int nig = WGM * nN, gid = wgid / nig, fm = gid * WGM, gsz = (nM - fm) < WGM ? (nM - fm) : WGM;
        u.pm = fm + ((wgid % nig) % gsz); u.pn = (wgid % nig) / gsz; return true;
    }
    __device__ __forceinline__ void a_ready(const Unit&) const {}
    __device__ __forceinline__ void done(const Unit&) const {}
};
__device__ __forceinline__ unsigned cvt_pk_bf16(float lo, float hi) { unsigned r; asm volatile("v_cvt_pk_bf16_f32 %0, %1, %2" : "=v"(r) : "v"(lo), "v"(hi)); return r; }
template <class Epi, class Sched, bool STAMP = false>
__device__ __forceinline__ void gemm_phase(PG8_LAS unsigned char* lds, const Gemm g, const Sched& S, const Epi& E, unsigned long long* stamps) {
    int tid_l = threadIdx.x; asm volatile("" : "+v"(tid_l)); const int tid = tid_l, wid = __builtin_amdgcn_readfirstlane(tid >> 6), lane = tid & 63, wr = wid >> 2, wc = wid & 3, fr = lane & 15, fq = lane >> 4;
    const int K = g.K, nt = K / BK, LD = g.ld;
    int ts_lo = 0, ts_hi = 0, nts = 0; const unsigned long long rt_entry = STAMP ? (unsigned long long)wall_clock64() : 0ull;
#define PG8_STAMP() do { if (STAMP && wid == 0 && nts < 64) { const unsigned long long _c = (unsigned long long)clock64(); \
        ts_lo = (lane == nts) ? (int)(unsigned)_c : ts_lo; ts_hi = (lane == nts) ? (int)(unsigned)(_c >> 32) : ts_hi; ++nts; } } while (0)
    PG8_STAMP();
    unsigned voffA[2], voffB[2];
#pragma unroll
    for (int i = 0; i < 2; ++i) { int R, C; stage_rc(tid * 16 + i * 8192, R, C); const int Rb = Epi::PERM ? ((R & ~31) + perm32(R & 31)) : R;
        voffA[i] = (unsigned)(R * LD + C) * 2u; voffB[i] = (unsigned)(Rb * LD + C) * 2u; }
    const size_t kstep = (size_t)(BK * 2);
    const size_t hstep = (size_t)HALF * LD * 2;
    const size_t tstep = 2 * hstep;
    const unsigned ldsw = (unsigned)wid * 1024u;
    const int aoff = lds_byte(wr * 64 + fr, fq * 8), boff = lds_byte(wc * 32 + fr, fq * 8);
#define PG8_SA(b, h) (((b) * 2 + (h)) * HTB)
#define PG8_SB(b, h) ((4 + (b) * 2 + (h)) * HTB)
#define PG8_STAGE(bufoff, gbase, voff) do { _Pragma("unroll") for (int _i = 0; _i < 2; ++_i) \
        __builtin_amdgcn_global_load_lds((const unsigned*)((const char*)(gbase) + (voff)[_i]), (PG8_LAS unsigned*)(lds + (bufoff) + ldsw + _i * 8192), 16, 0, 0); } while (0)
#define PG8_LDA(dst, b, h) do { _Pragma("unroll") for (int m = 0; m < 4; ++m) _Pragma("unroll") for (int k = 0; k < 2; ++k) dst[m][k] = *(const PG8_LAS bf16x8*)(lds + PG8_SA(b, h) + aoff + m * 2048 + k * 1024); } while (0)
#define PG8_LDB(dst, b, h) do { _Pragma("unroll") for (int n = 0; n < 2; ++n) _Pragma("unroll") for (int k = 0; k < 2; ++k) dst[n][k] = *(const PG8_LAS bf16x8*)(lds + PG8_SB(b, h) + boff + n * 2048 + k * 1024); } while (0)
#define PG8_MMA(ai, bj, At, Bt) do { __builtin_amdgcn_s_setprio(1); _Pragma("unroll") for (int m = 0; m < 4; ++m) _Pragma("unroll") for (int n = 0; n < 2; ++n) _Pragma("unroll") for (int k = 0; k < 2; ++k) \
        acc[ai][bj][m][n] = __builtin_amdgcn_mfma_f32_16x16x32_bf16(Bt[n][k], At[m][k], acc[ai][bj][m][n], 0, 0, 0); __builtin_amdgcn_s_setprio(0); } while (0)
#define PG8_WAIT_V(n) asm volatile("s_waitcnt vmcnt(" #n ")" ::: "memory")
#define PG8_WAIT_L(n) asm volatile("s_waitcnt lgkmcnt(" #n ")" ::: "memory")
#define PG8_BAR __builtin_amdgcn_s_barrier()
#define PG8_SCHED __builtin_amdgcn_sched_barrier(0)
    Unit cur, nxt; int ui = 0;
    if (!S.next(0, cur)) return;
    f32x4 acc[2][2][4][2];
#pragma unroll
    for (int a = 0; a < 2; ++a)
#pragma unroll
        for (int b = 0; b < 2; ++b)
#pragma unroll
            for (int m = 0; m < 4; ++m)
#pragma unroll
                for (int n = 0; n < 2; ++n) acc[a][b][m][n] = (f32x4){0.f, 0.f, 0.f, 0.f};
    bf16x8 At[4][2], B0[2][2], B1[2][2];
    const char* cA = (const char*)g.A + (size_t)cur.pm * tstep; const char* cB = (const char*)g.Bt + (size_t)cur.pn * tstep;
    S.a_ready(cur);
    PG8_STAGE(PG8_SB(0, 0), cB, voffB); PG8_STAGE(PG8_SA(0, 0), cA, voffA); PG8_STAGE(PG8_SB(0, 1), cB + hstep, voffB); PG8_STAGE(PG8_SA(0, 1), cA + hstep, voffA);
    if (wr == 1) PG8_BAR;
    PG8_WAIT_V(4); PG8_BAR;
    PG8_STAGE(PG8_SB(1, 0), cB + kstep, voffB); PG8_STAGE(PG8_SA(1, 0), cA + kstep, voffA); PG8_STAGE(PG8_SB(1, 1), cB + hstep + kstep, voffB);
    PG8_WAIT_V(6); PG8_BAR;
    PG8_STAMP();
    for (;;) {
        const bool has_next = S.next(ui + 1, nxt);
        const char* nA = has_next ? (const char*)g.A + (size_t)nxt.pm * tstep : cA; const char* nB = has_next ? (const char*)g.Bt + (size_t)nxt.pn * tstep : cB;
        for (int t = 0; t < nt; t += 2) {
            const bool last = (t == nt - 2);
            const char* a1 = cA + (size_t)(t + 1) * kstep;
            const char* a2 = last ? nA : cA + (size_t)(t + 2) * kstep; const char* b2 = last ? nB : cB + (size_t)(t + 2) * kstep;
            const char* a3 = a2 + kstep; const char* b3 = b2 + kstep;
            if (last && has_next) S.a_ready(nxt);
            PG8_LDB(B0, 0, 0); PG8_SCHED; PG8_LDA(At, 0, 0); PG8_STAGE(PG8_SA(1, 1), a1 + hstep, voffA);
            PG8_WAIT_L(8); PG8_BAR; PG8_WAIT_L(0); PG8_MMA(0, 0, At, B0); PG8_BAR; PG8_SCHED;
            PG8_LDB(B1, 0, 1); PG8_STAGE(PG8_SB(0, 0), b2, voffB);
            PG8_BAR; PG8_WAIT_L(0); PG8_MMA(0, 1, At, B1); PG8_BAR;
            PG8_LDA(At, 0, 1); PG8_STAGE(PG8_SA(0, 0), a2, voffA);
            PG8_BAR; PG8_WAIT_L(0); PG8_MMA(1, 0, At, B0); PG8_BAR; PG8_SCHED;
            PG8_STAGE(PG8_SB(0, 1), b2 + hstep, voffB);
            PG8_WAIT_V(6); PG8_BAR; PG8_MMA(1, 1, At, B1); PG8_BAR;
            PG8_LDB(B0, 1, 0); PG8_SCHED; PG8_LDA(At, 1, 0); PG8_STAGE(PG8_SA(0, 1), a2 + hstep, voffA);
            PG8_WAIT_L(8); PG8_BAR; PG8_WAIT_L(0); PG8_MMA(0, 0, At, B0); PG8_BAR; PG8_SCHED;
            PG8_LDB(B1, 1, 1); PG8_STAGE(PG8_SB(1, 0), b3, voffB);
            PG8_BAR; PG8_WAIT_L(0); PG8_MMA(0, 1, At, B1); PG8_BAR;
            PG8_LDA(At, 1, 1); PG8_STAGE(PG8_SA(1, 0), a3, voffA);
            PG8_BAR; PG8_WAIT_L(0); PG8_MMA(1, 0, At, B0); PG8_BAR; PG8_SCHED;
            PG8_STAGE(PG8_SB(1, 1), b3 + hstep, voffB);
            PG8_WAIT_V(6); PG8_BAR; PG8_MMA(1, 1, At, B1); PG8_BAR;
        }
        PG8_STAMP();
        if constexpr (!Epi::AFTER_DRAIN) { E(acc, cur, wr, wc, fr, fq); S.done(cur); }
        PG8_STAMP();
        if (!has_next) break;
#pragma unroll
        for (int a = 0; a < 2; ++a)
#pragma unroll
            for (int b = 0; b < 2; ++b)
#pragma unroll
                for (int m = 0; m < 4; ++m)
#pragma unroll
                    for (int n = 0; n < 2; ++n) acc[a][b][m][n] = (f32x4){0.f, 0.f, 0.f, 0.f};
        cur = nxt; cA = nA; cB = nB; ++ui;
    }
    PG8_WAIT_V(0);
    if (wr == 0) PG8_BAR;
    PG8_BAR;
    if constexpr (Epi::AFTER_DRAIN) { E.fused(acc, cur, wr, wc, fr, fq, lds, wid, lane); S.done(cur); }
    PG8_STAMP();
    if (STAMP && wid == 0) { stamps[lane] = lane < nts ? (((unsigned long long)(unsigned)ts_hi << 32) | (unsigned)ts_lo) : 0ull;
        if (lane == 62) stamps[62] = rt_entry; if (lane == 63) stamps[63] = (unsigned long long)wall_clock64(); }
#undef PG8_STAMP
#undef PG8_SA
#undef PG8_SB
#undef PG8_STAGE
#undef PG8_LDA
#undef PG8_LDB
#undef PG8_MMA
#undef PG8_WAIT_V
#undef PG8_WAIT_L
#undef PG8_BAR
#undef PG8_SCHED
}
}

using pg8::bf16_t; using pg8::bf16x8; using pg8::f32x4; using pg8::u32x4;
typedef unsigned u32x2 __attribute__((ext_vector_type(2)));
#define MFMA16(a, b, c) __builtin_amdgcn_mfma_f32_16x16x32_bf16((a), (b), (c), 0, 0, 0)

constexpr int D = 1024, NB = 8, SEQ = 2048, CL = 256, TL = NB * SEQ, TC = NB * CL, TT = TL + TC;
constexpr int NIN = 2560;
constexpr int PW = 2048;
constexpr int C_MQ = 0, C_MK = 384, C_MV = 768, C_MO = 1152, C_CQ = 1552, C_CKV = 1808, C_KR = 1936;
constexpr int KEYS = SEQ + CL;
constexpr int LCH = 128, NCH = 18;
constexpr int VC = 112, STSZ = VC * 96;
constexpr int LDS_BYTES = 147456;
constexpr float EPS = 1e-6f;
#ifndef ATT_REP
#define ATT_REP 1
#endif
#ifndef REPMASK
#define REPMASK 0
#endif
#ifndef PHMASK
#define PHMASK 0xFFFF
#endif

constexpr size_t WS_MOD = 0;
constexpr size_t WS_WIN = WS_MOD + 442368;
constexpr size_t WS_WOUT = WS_WIN + 5242880;
constexpr size_t WS_WUP = WS_WOUT + 2097152;
constexpr size_t WS_WDOWN = WS_WUP + 8388608;
constexpr size_t WS_WUQ = WS_WDOWN + 8388608;
constexpr size_t WS_WUKV = WS_WUQ + 196608;
constexpr size_t WS_FDFT = WS_WUKV + 163840;
constexpr size_t WS_FDFTC = WS_FDFT + 16777216;
constexpr size_t WS_XCTX = WS_FDFTC + 262144;
constexpr size_t WS_S0 = WS_XCTX + 8388608;
constexpr size_t WS_HBUF = WS_S0;
constexpr size_t WS_HID = WS_S0 + 37748736;
constexpr size_t WS_MIX = WS_S0;
constexpr size_t WS_PROJ = WS_S0 + 37748736;
constexpr size_t WS_GATES = WS_PROJ + 75497472;
constexpr size_t WS_QB = WS_GATES + 1179648;
constexpr size_t WS_KB = WS_QB + 14155776;
constexpr size_t WS_VT = WS_KB + 14155776;
constexpr size_t WS_DC = WS_VT + 14155776;
constexpr size_t WS_DEC = WS_DC + 24772608;
constexpr size_t WS_ZT = WS_DEC + 8192;
constexpr size_t WS_ZTC = WS_ZT + 16777216;
constexpr size_t WS_ZTF = WS_ZTC + 2097152;
constexpr size_t WS_CST = WS_DC;
constexpr size_t WS_END_MIX = WS_ZTF + 8388608;
constexpr size_t WS_END_MLP = WS_HID + 150994944;
constexpr size_t WS_PART = WS_HID + 150994944;
constexpr size_t WS_RSS = 268435456 - 16384 - 262144 - 262144;
constexpr size_t WS_RCNT = WS_RSS - 65536;
constexpr size_t WS_ROPE = 268435456 - 16384 - 262144;
constexpr size_t WS_BAR = 268435456 - 16384;
constexpr size_t WS_NEED = 268435456;
static_assert(WS_END_MIX <= WS_RCNT && WS_PART + 4 * 4194304 <= WS_RCNT, "workspace map");

struct KP { const float* in[20]; float* out; unsigned char* ws; int ph_lo, ph_hi; };
enum { I_X, I_C, I_CTX, I_CCTX, I_WMOD, I_BMOD, I_G1, I_G2, I_WIN, I_BG, I_CONV, I_GM, I_GQN, I_GKVN, I_WUQ, I_WUKV, I_WOUT, I_WUP, I_WDOWN, I_GFIN };

__device__ __forceinline__ int ltid() { int t = threadIdx.x; asm volatile("" : "+v"(t)); return t; }
__device__ __forceinline__ int lbid() { int t = blockIdx.x; asm volatile("" : "+s"(t)); return t; }
__device__ __forceinline__ float bf2f(bf16_t v) { return __uint_as_float(((unsigned)v) << 16); }
__device__ __forceinline__ bf16_t f2bf(float f) { unsigned u = __float_as_uint(f); u += 0x7FFFu + ((u >> 16) & 1u); return (bf16_t)(u >> 16); }
__device__ __forceinline__ unsigned pk2(float lo, float hi) { unsigned r; asm("v_cvt_pk_bf16_f32 %0, %1, %2" : "=v"(r) : "v"(lo), "v"(hi)); return r; }
__device__ __forceinline__ float lo_bf(unsigned u) { return __uint_as_float(u << 16); }
__device__ __forceinline__ float hi_bf(unsigned u) { return __uint_as_float(u & 0xFFFF0000u); }
__device__ __forceinline__ float wave_sum(float v) {
#pragma unroll
    for (int o = 1; o < 64; o <<= 1) v += __shfl_xor(v, o);
    return v;
}
__device__ __forceinline__ float max_over_fq(float x) {
    const unsigned u = __float_as_uint(x);
    const auto r = __builtin_amdgcn_permlane32_swap(u, u, false, false);
    const float m = fmaxf(__uint_as_float(r[0]), __uint_as_float(r[1]));
    const unsigned v = __float_as_uint(m);
    const auto s = __builtin_amdgcn_permlane16_swap(v, v, false, false);
    return fmaxf(__uint_as_float(s[0]), __uint_as_float(s[1]));
}
__device__ __forceinline__ float sum_over_fq(float x) {
    const unsigned u = __float_as_uint(x);
    const auto r = __builtin_amdgcn_permlane32_swap(u, u, false, false);
    const float m = __uint_as_float(r[0]) + __uint_as_float(r[1]);
    const unsigned v = __float_as_uint(m);
    const auto s = __builtin_amdgcn_permlane16_swap(v, v, false, false);
    return __uint_as_float(s[0]) + __uint_as_float(s[1]);
}
__device__ __forceinline__ float logsig(float f) { const float e = __expf(-fabsf(f)); return fminf(f, 0.f) - __logf(1.f + e); }
__device__ __forceinline__ float siluf(float v) { return v / (1.f + __expf(-v)); }
__device__ __forceinline__ bf16x8 mk8(u32x2 lo, u32x2 hi) { u32x4 t = {lo.x, lo.y, hi.x, hi.y}; return __builtin_bit_cast(bf16x8, t); }

struct EpiIn {
    static constexpr bool PERM = true, AFTER_DRAIN = false;
    bf16_t* proj; float* gates; bf16_t* zt; bf16_t* ztc;
    __device__ __forceinline__ void operator()(const f32x4 (&acc)[2][2][4][2], const pg8::Unit& u, int wr, int wc, int fr, int fq) const {
        const int row0 = u.pm * 256 + wr * 64 + fr;
        if (u.pn < 2) {
            const bool latu = u.pm < 64;
            unsigned char* zb = latu ? (unsigned char*)zt : (unsigned char*)ztc;
            const unsigned ldzb = latu ? 8192u : 1024u;
            const unsigned cofs = (unsigned)(wc * 32 + 8 * fq) * ldzb;
#pragma unroll
            for (int ai = 0; ai < 2; ++ai)
#pragma unroll
                for (int m = 0; m < 4; ++m) {
                    const int r = row0 + ai * 128 + m * 16;
                    unsigned off;
                    if (latu) { const int b = r >> 11, n = r & 2047; off = (unsigned)((b * 256) * 4096 + u.pn * 2048 + n) * 2u + cofs; }
                    else { const int rc = r - TL, b = rc >> 8, n = rc & 255; off = (unsigned)((b * 256) * 512 + u.pn * 256 + n) * 2u + cofs; }
#pragma unroll
                    for (int bj = 0; bj < 2; ++bj)
#pragma unroll
                        for (int n2 = 0; n2 < 2; ++n2) {
                            const f32x4 v = acc[ai][bj][m][n2];
#pragma unroll
                            for (int j = 0; j < 4; ++j) *(bf16_t*)(zb + (off + (unsigned)(bj * 128 + 4 * n2 + j) * ldzb)) = f2bf(v[j]);
                        }
                    asm volatile("" ::: "memory");
                }
        } else {
            const int colbase = (u.pn - 2) * 256 + wc * 32 + 8 * fq;
            const bool isg = (u.pn == 8) && (wc == 0) && (fq < 2);
#pragma unroll
            for (int ai = 0; ai < 2; ++ai)
#pragma unroll
                for (int m = 0; m < 4; ++m) {
                    const int r = row0 + ai * 128 + m * 16;
                    bf16_t* rowp = proj + (size_t)r * PW + colbase;
#pragma unroll
                    for (int bj = 0; bj < 2; ++bj) {
                        const f32x4 v0 = acc[ai][bj][m][0], v1 = acc[ai][bj][m][1];
                        u32x4 o; o.x = pk2(v0[0], v0[1]); o.y = pk2(v0[2], v0[3]); o.z = pk2(v1[0], v1[1]); o.w = pk2(v1[2], v1[3]);
                        *(u32x4*)(rowp + bj * 128) = o;
                    }
                    if (isg) { float* gp = gates + (size_t)r * 16 + 8 * fq; *(f32x4*)gp = acc[ai][0][m][0]; *(f32x4*)(gp + 4) = acc[ai][0][m][1]; }
                    asm volatile("" ::: "memory");
                }
        }
    }
};
struct EpiRes {
    static constexpr bool PERM = false, AFTER_DRAIN = false;
    const float* xol; const float* xoc; float* xnl; float* xnc; const float* ga;
    __device__ __forceinline__ void operator()(const f32x4 (&acc)[2][2][4][2], const pg8::Unit& u, int wr, int wc, int fr, int fq) const {
        const int row0 = u.pm * 256 + wr * 64 + fr, col0 = u.pn * 256 + wc * 32 + 4 * fq;
#pragma unroll
        for (int ai = 0; ai < 2; ++ai)
#pragma unroll
            for (int m = 0; m < 4; ++m) {
                const int r = row0 + ai * 128 + m * 16;
                const float* xo; float* xn; int b;
                if (r < TL) { xo = xol + (size_t)r * D; xn = xnl + (size_t)r * D; b = r >> 11; } else { xo = xoc + (size_t)(r - TL) * D; xn = xnc + (size_t)(r - TL) * D; b = 8; }
                const float* gp = ga + (size_t)b * 6144;
#pragma unroll
                for (int bj = 0; bj < 2; ++bj)
#pragma unroll
                    for (int n = 0; n < 2; ++n) {
                        const int c = col0 + bj * 128 + n * 16;
                        const f32x4 g = *(const f32x4*)(gp + c), xv = *(const f32x4*)(xo + c);
                        *(f32x4*)(xn + c) = xv + g * acc[ai][bj][m][n];
                    }
            }
    }
};
struct EpiResNorm {
    static constexpr bool PERM = false, AFTER_DRAIN = true;
    const float* xo; float* xn; const float* ga; float* rss; unsigned* cnt; int mode; const float* g; const float* sc; const float* sh; bf16_t* hb;
    __device__ __forceinline__ void fused(f32x4 (&acc)[2][2][4][2], const pg8::Unit& u, int wr, int wc, int fr, int fq, PG8_LAS unsigned char* lds, int wid, int lane) const {
        const int row0 = u.pm * 256 + wr * 64 + fr, col0 = u.pn * 256 + wc * 32 + 4 * fq, b = (u.pm * 256) >> 11;
        float ps[2][4];
        {   const float* gp = ga + (size_t)b * 6144 + col0;
            f32x4 gv[2][2];
#pragma unroll
            for (int bj = 0; bj < 2; ++bj)
#pragma unroll
                for (int n = 0; n < 2; ++n) gv[bj][n] = *(const f32x4*)(gp + bj * 128 + n * 16);
#pragma unroll
            for (int ai = 0; ai < 2; ++ai) {
                f32x4 xt[4][2][2];
#pragma unroll
                for (int m = 0; m < 4; ++m) { const float* xr = xo + (size_t)(row0 + ai * 128 + m * 16) * D + col0;
#pragma unroll
                    for (int bj = 0; bj < 2; ++bj)
#pragma unroll
                        for (int n = 0; n < 2; ++n) xt[m][bj][n] = *(const f32x4*)(xr + bj * 128 + n * 16); }
#pragma unroll
                for (int m = 0; m < 4; ++m) { float s = 0.f;
#pragma unroll
                    for (int bj = 0; bj < 2; ++bj)
#pragma unroll
                        for (int n = 0; n < 2; ++n) { const f32x4 v = xt[m][bj][n] + gv[bj][n] * acc[ai][bj][m][n]; acc[ai][bj][m][n] = v;
                            s += v[0] * v[0] + v[1] * v[1] + v[2] * v[2] + v[3] * v[3]; }
                    ps[ai][m] = sum_over_fq(s); }
                asm volatile("" ::: "memory");
            } }
        PG8_LAS float* red = (PG8_LAS float*)lds;
        if (fq == 0) {
#pragma unroll
            for (int ai = 0; ai < 2; ++ai)
#pragma unroll
                for (int m = 0; m < 4; ++m) red[wc * 256 + ai * 128 + wr * 64 + m * 16 + fr] = ps[ai][m]; }
        __syncthreads();
        const int tid = wid * 64 + lane;
        if (tid < 256) { const float tot = (red[tid] + red[256 + tid]) + (red[512 + tid] + red[768 + tid]);
            (void)__hip_atomic_fetch_add(rss + u.pm * 256 + tid, tot, __ATOMIC_RELAXED, __HIP_MEMORY_SCOPE_AGENT); }
        asm volatile("s_waitcnt vmcnt(0)" ::: "memory");
        __syncthreads();
        if (tid == 0) { unsigned* c = cnt + u.pm * 64;
            (void)__hip_atomic_fetch_add(c, 1u, __ATOMIC_RELAXED, __HIP_MEMORY_SCOPE_AGENT);
            unsigned spins = 0; while (__hip_atomic_load(c, __ATOMIC_RELAXED, __HIP_MEMORY_SCOPE_AGENT) < 4u && ++spins < (1u << 22)) __builtin_amdgcn_s_sleep(1); }
        __syncthreads();
        float rs[2][4];
#pragma unroll
        for (int ai = 0; ai < 2; ++ai)
#pragma unroll
            for (int m = 0; m < 4; ++m) rs[ai][m] = __hip_atomic_load(rss + row0 + ai * 128 + m * 16, __ATOMIC_RELAXED, __HIP_MEMORY_SCOPE_AGENT);
#pragma unroll
        for (int ai = 0; ai < 2; ++ai)
#pragma unroll
            for (int m = 0; m < 4; ++m) rs[ai][m] = rsqrtf(rs[ai][m] * (1.f / D) + EPS);
        const size_t bo = (size_t)b * 6144;
#pragma unroll
        for (int bj = 0; bj < 2; ++bj) {
            f32x4 gq[2], sv[2];
#pragma unroll
            for (int n = 0; n < 2; ++n) { const int c = col0 + bj * 128 + n * 16; const f32x4 gg = *(const f32x4*)(g + c);
                if (mode == 0) { gq[n] = gg * (*(const f32x4*)(sc + bo + c) + 1.f); sv[n] = *(const f32x4*)(sh + bo + c); }
                else { gq[n] = gg; sv[n] = (f32x4){0.f, 0.f, 0.f, 0.f}; } }
#pragma unroll
            for (int ai = 0; ai < 2; ++ai)
#pragma unroll
                for (int m = 0; m < 4; ++m) {
                    const int r = row0 + ai * 128 + m * 16; const float rstd = rs[ai][m];
#pragma unroll
                    for (int n = 0; n < 2; ++n) { const int c = col0 + bj * 128 + n * 16; const f32x4 v = acc[ai][bj][m][n];
                        const f32x4 hh = v * rstd * gq[n] + sv[n];
                        if (mode == 0) { *(f32x4*)(xn + (size_t)r * D + c) = v;
                            u32x2 o; o.x = pk2(hh[0], hh[1]); o.y = pk2(hh[2], hh[3]); *(u32x2*)(hb + (size_t)r * D + c) = o; }
                        else *(f32x4*)(xn + (size_t)r * D + c) = hh; }
                }
            asm volatile("" ::: "memory");
        }
    }
};
struct EpiUp {
    static constexpr bool PERM = true, AFTER_DRAIN = false;
    bf16_t* hid;
    __device__ __forceinline__ void operator()(const f32x4 (&acc)[2][2][4][2], const pg8::Unit& u, int wr, int wc, int fr, int fq) const {
        const int row0 = u.pm * 256 + wr * 64 + fr, col0 = u.pn * 256 + wc * 32 + 8 * fq;
#pragma unroll
        for (int ai = 0; ai < 2; ++ai)
#pragma unroll
            for (int m = 0; m < 4; ++m) {
                bf16_t* rowp = hid + (size_t)(row0 + ai * 128 + m * 16) * 4096 + col0;
#pragma unroll
                for (int bj = 0; bj < 2; ++bj) {
                    f32x4 v0 = acc[ai][bj][m][0], v1 = acc[ai][bj][m][1];
#pragma unroll
                    for (int j = 0; j < 4; ++j) { float a = fmaxf(v0[j], 0.f); v0[j] = a * a; float b = fmaxf(v1[j], 0.f); v1[j] = b * b; }
                    u32x4 o; o.x = pk2(v0[0], v0[1]); o.y = pk2(v0[2], v0[3]); o.z = pk2(v1[0], v1[1]); o.w = pk2(v1[2], v1[3]);
                    *(u32x4*)(rowp + bj * 128) = o;
                }
            }
    }
};
struct EpiFou {
    static constexpr bool PERM = true, AFTER_DRAIN = false;
    bf16_t* mix; int rows_per_b; int row_off; float scale;
    __device__ __forceinline__ void operator()(const f32x4 (&acc)[2][2][4][2], const pg8::Unit& u, int wr, int wc, int fr, int fq) const {
        const int row0 = u.pm * 256 + wr * 64 + fr, col0 = wc * 32 + 8 * fq;
        const size_t rb = (size_t)row_off + (size_t)u.pn * rows_per_b;
#pragma unroll
        for (int ai = 0; ai < 2; ++ai)
#pragma unroll
            for (int m = 0; m < 4; ++m) {
                bf16_t* rowp = mix + (rb + row0 + ai * 128 + m * 16) * D + col0;
#pragma unroll
                for (int bj = 0; bj < 2; ++bj) {
                    const f32x4 v0 = acc[ai][bj][m][0] * scale, v1 = acc[ai][bj][m][1] * scale;
                    u32x4 o; o.x = pk2(v0[0], v0[1]); o.y = pk2(v0[2], v0[3]); o.z = pk2(v1[0], v1[1]); o.w = pk2(v1[2], v1[3]);
                    *(u32x4*)(rowp + bj * 128) = o;
                }
            }
    }
};

template <class Epi>
__device__ __forceinline__ void run_gemm(unsigned char* shm, const bf16_t* A, const bf16_t* Bt, int M, int N, int K, int G, int c, const Epi& E) {
    pg8::Gemm g; g.A = A; g.Bt = Bt; g.M = M; g.N = N; g.K = K; g.ld = K;
    pg8::StaticOrder S; S.init(M, N, G, c);
    pg8::gemm_phase<Epi, pg8::StaticOrder, false>((PG8_LAS unsigned char*)shm, g, S, E, nullptr);
}

struct OneUnit {
    int pm, pn;
    __device__ bool next(int i, pg8::Unit& u) const { if (i) return false; u.pm = pm; u.pn = pn; return true; }
    __device__ __forceinline__ void a_ready(const pg8::Unit&) const {}
    __device__ __forceinline__ void done(const pg8::Unit&) const {}
};
struct EpiPart {
    static constexpr bool PERM = true, AFTER_DRAIN = false;
    bf16_t* part;
    __device__ __forceinline__ void operator()(const f32x4 (&acc)[2][2][4][2], const pg8::Unit& u, int wr, int wc, int fr, int fq) const {
        const int row0 = u.pm * 256 + wr * 64 + fr, col0 = u.pn * 256 + wc * 32 + 8 * fq;
#pragma unroll
        for (int ai = 0; ai < 2; ++ai)
#pragma unroll
            for (int m = 0; m < 4; ++m) {
                bf16_t* rowp = part + (size_t)(row0 + ai * 128 + m * 16) * D + col0;
#pragma unroll
                for (int bj = 0; bj < 2; ++bj) { const f32x4 v0 = acc[ai][bj][m][0], v1 = acc[ai][bj][m][1];
                    u32x4 o; o.x = pk2(v0[0], v0[1]); o.y = pk2(v0[2], v0[3]); o.z = pk2(v1[0], v1[1]); o.w = pk2(v1[2], v1[3]);
                    *(u32x4*)(rowp + bj * 128) = o; }
            }
    }
};
__device__ __forceinline__ void run_gemm_ctx_split(unsigned char* shm, const bf16_t* A, const bf16_t* Bt, int K, int ld, int pm, int pn, const EpiPart& E) {
    pg8::Gemm g; g.A = A; g.Bt = Bt; g.M = TC; g.N = 1024; g.K = K; g.ld = ld;
    OneUnit S; S.pm = pm; S.pn = pn;
    pg8::gemm_phase<EpiPart, OneUnit, false>((PG8_LAS unsigned char*)shm, g, S, E, nullptr);
}

__device__ __forceinline__ void build_costab(float* tab) {
    for (int i = ltid(); i < 2048; i += 512) tab[i] = cospif((float)i * (1.0f / 1024.0f));
    __syncthreads();
}
__device__ __forceinline__ void tr_load(const float* __restrict__ src, int ldn, int nmax, int k0, int nsrc0, float* tile) {
    const int tid = ltid(), r = tid >> 4, c4 = (tid & 15) * 4;
#pragma unroll
    for (int h = 0; h < 2; ++h) {
        const int rr = r + 32 * h, nc = nsrc0 + c4;
        f32x4 v = {0.f, 0.f, 0.f, 0.f};
        if (nc < nmax) v = *(const f32x4*)(src + (size_t)(k0 + rr) * ldn + nc);
        float* t = tile + rr * 65 + c4; t[0] = v[0]; t[1] = v[1]; t[2] = v[2]; t[3] = v[3];
    }
    __syncthreads();
}
__device__ __forceinline__ void tr_tile(const float* __restrict__ src, int ldn, int nmax, int k0, int nsrc0, bf16_t* __restrict__ dst, int ldk, int ndst0, float* tile) {
    tr_load(src, ldn, nmax, k0, nsrc0, tile);
    const int tid = ltid(), n = tid >> 3, kq = tid & 7;
    const float* s = tile + (kq * 8) * 65 + n;
    u32x4 o; o.x = pk2(s[0], s[65]); o.y = pk2(s[130], s[195]); o.z = pk2(s[260], s[325]); o.w = pk2(s[390], s[455]);
    *(u32x4*)(dst + (size_t)(ndst0 + n) * ldk + k0 + kq * 8) = o;
    __syncthreads();
}
__device__ __forceinline__ void fold_tile(const float* __restrict__ win, int k0, int g, bf16_t* __restrict__ dst, float* tile, const float* tab) {
    tr_load(win, 2224, 2224, k0, g * 64, tile);
    const int tid = ltid(), cp = tid >> 3, kq = tid & 7;
    float ac[8], as[8];
#pragma unroll
    for (int i = 0; i < 8; ++i) { ac[i] = 0.f; as[i] = 0.f; }
    for (int c = 0; c < 64; ++c) {
        const int idx = ((c * cp) & 63) * 32;
        const float cs = tab[idx], sn = tab[(idx - 512) & 2047];
#pragma unroll
        for (int i = 0; i < 8; ++i) { const float v = tile[(kq * 8 + i) * 65 + c]; ac[i] += v * cs; as[i] += v * sn; }
    }
    u32x4 o; o.x = pk2(ac[0], ac[1]); o.y = pk2(ac[2], ac[3]); o.z = pk2(ac[4], ac[5]); o.w = pk2(ac[6], ac[7]);
    *(u32x4*)(dst + (size_t)(g * 64 + cp) * 1024 + k0 + kq * 8) = o;
    u32x4 q; q.x = pk2(as[0], as[1]); q.y = pk2(as[2], as[3]); q.z = pk2(as[4], as[5]); q.w = pk2(as[6], as[7]);
    *(u32x4*)(dst + (size_t)(256 + g * 64 + cp) * 1024 + k0 + kq * 8) = q;
    __syncthreads();
}
__device__ __forceinline__ void tr_tile_wave(const float* __restrict__ src, int ldn, int nmax, int k0, int nsrc0, bf16_t* __restrict__ dst, int ldk, int ndst0, float* tile, int lane) {
    const int r = lane >> 4, c4 = (lane & 15) * 4;
    f32x4 tv[16];
#pragma unroll
    for (int h = 0; h < 16; ++h) { const int rr = r + 4 * h, nc = nsrc0 + c4; tv[h] = (f32x4){0.f, 0.f, 0.f, 0.f};
        if (nc < nmax) tv[h] = *(const f32x4*)(src + (size_t)(k0 + rr) * ldn + nc); }
#pragma unroll
    for (int h = 0; h < 16; ++h) { const int rr = r + 4 * h; float* t = tile + rr * 65 + c4; t[0] = tv[h][0]; t[1] = tv[h][1]; t[2] = tv[h][2]; t[3] = tv[h][3]; }
    asm volatile("s_waitcnt lgkmcnt(0)" ::: "memory");
    const int c = lane & 7, nl = lane >> 3;
#pragma unroll
    for (int j = 0; j < 8; ++j) { const int n = nl + 8 * j; const float* s = tile + (8 * c) * 65 + n;
        u32x4 o; o.x = pk2(s[0], s[65]); o.y = pk2(s[130], s[195]); o.z = pk2(s[260], s[325]); o.w = pk2(s[390], s[455]);
        *(u32x4*)(dst + (size_t)(ndst0 + n) * ldk + k0 + 8 * c) = o; }
    asm volatile("s_waitcnt lgkmcnt(0)" ::: "memory");
}
constexpr int NWV_ITEMS = 512 + 256 + 1024 + 1024 + 24 + 20;
__device__ __forceinline__ void prep_weight_item_wave(const KP& p, int l, int it, float* tile, int lane) {
    unsigned char* ws = p.ws;
    if (it < 512) { const int ct = it & 31, kt = it >> 5;
        tr_tile_wave(p.in[I_WIN] + (size_t)l * 1024 * 2224, 2224, 2224, kt * 64, 256 + ct * 64, (bf16_t*)(ws + WS_WIN), 1024, 512 + ct * 64, tile, lane); return; }
    it -= 512;
    if (it < 256) { tr_tile_wave(p.in[I_WOUT] + (size_t)l * 1024 * 1024, 1024, 1024, (it >> 4) * 64, (it & 15) * 64, (bf16_t*)(ws + WS_WOUT), 1024, (it & 15) * 64, tile, lane); return; }
    it -= 256;
    if (it < 1024) { tr_tile_wave(p.in[I_WUP] + (size_t)l * 1024 * 4096, 4096, 4096, (it >> 6) * 64, (it & 63) * 64, (bf16_t*)(ws + WS_WUP), 1024, (it & 63) * 64, tile, lane); return; }
    it -= 1024;
    if (it < 1024) { tr_tile_wave(p.in[I_WDOWN] + (size_t)l * 4096 * 1024, 1024, 1024, (it >> 4) * 64, (it & 15) * 64, (bf16_t*)(ws + WS_WDOWN), 4096, (it & 15) * 64, tile, lane); return; }
    it -= 1024;
    if (it < 24) { tr_tile_wave(p.in[I_WUQ] + (size_t)l * 256 * 384, 384, 384, (it / 6) * 64, (it % 6) * 64, (bf16_t*)(ws + WS_WUQ), 256, (it % 6) * 64, tile, lane); return; }
    it -= 24;
    tr_tile_wave(p.in[I_WUKV] + (size_t)l * 128 * 640, 640, 640, (it / 10) * 64, (it % 10) * 64, (bf16_t*)(ws + WS_WUKV), 128, (it % 10) * 64, tile, lane);
}
__device__ __forceinline__ void prep_weights(const KP& p, int l, unsigned char* shm, const float* tab, int part = 0, int b0 = 0, int nb = 0) {
    const int tid = ltid(), bid = lbid() - b0, G = nb ? nb : (int)gridDim.x;
    if (part != 2 && part != 4) for (int it = bid; it < 64; it += G) fold_tile(p.in[I_WIN] + (size_t)l * 1024 * 2224, (it >> 2) * 64, it & 3, (bf16_t*)(p.ws + WS_WIN), (float*)(shm + 8192), tab);
    __syncthreads();
    float* wt = (float*)(shm + 8192) + (tid >> 6) * (64 * 65);
    const int ilo = part == 4 ? 1024 : 0, ihi = part == 3 ? 1024 : NWV_ITEMS;
    for (int it = ilo + bid * 8 + (tid >> 6); it < ihi; it += G * 8) {
        const bool isdown = it >= 1792 && it < 2816;
        if ((part == 1 && isdown) || (part == 2 && !isdown)) continue;
        prep_weight_item_wave(p, l, it, wt, tid & 63); }
    __syncthreads();
}
constexpr int NW_ITEMS = 512 + 64 + 256 + 1024 + 1024 + 24 + 20;
__device__ __forceinline__ void prep_weight_item(const KP& p, int l, int it, float* tile, const float* tab) {
    unsigned char* ws = p.ws;
    if (it < 512) { const int ct = it & 31, kt = it >> 5;
        tr_tile(p.in[I_WIN] + (size_t)l * 1024 * 2224, 2224, 2224, kt * 64, 256 + ct * 64, (bf16_t*)(ws + WS_WIN), 1024, 512 + ct * 64, tile); return; }
    it -= 512;
    if (it < 64) { fold_tile(p.in[I_WIN] + (size_t)l * 1024 * 2224, (it >> 2) * 64, it & 3, (bf16_t*)(ws + WS_WIN), tile, tab); return; }
    it -= 64;
    if (it < 256) { tr_tile(p.in[I_WOUT] + (size_t)l * 1024 * 1024, 1024, 1024, (it >> 4) * 64, (it & 15) * 64, (bf16_t*)(ws + WS_WOUT), 1024, (it & 15) * 64, tile); return; }
    it -= 256;
    if (it < 1024) { tr_tile(p.in[I_WUP] + (size_t)l * 1024 * 4096, 4096, 4096, (it >> 6) * 64, (it & 63) * 64, (bf16_t*)(ws + WS_WUP), 1024, (it & 63) * 64, tile); return; }
    it -= 1024;
    if (it < 1024) { tr_tile(p.in[I_WDOWN] + (size_t)l * 4096 * 1024, 1024, 1024, (it >> 4) * 64, (it & 15) * 64, (bf16_t*)(ws + WS_WDOWN), 4096, (it & 15) * 64, tile); return; }
    it -= 1024;
    if (it < 24) { tr_tile(p.in[I_WUQ] + (size_t)l * 256 * 384, 384, 384, (it / 6) * 64, (it % 6) * 64, (bf16_t*)(ws + WS_WUQ), 256, (it % 6) * 64, tile); return; }
    it -= 24;
    tr_tile(p.in[I_WUKV] + (size_t)l * 128 * 640, 640, 640, (it / 10) * 64, (it % 10) * 64, (bf16_t*)(ws + WS_WUKV), 128, (it % 10) * 64, tile);
}
__device__ __forceinline__ void prep_mod_item(const KP& p, int it, float* sl) {
    const int tid = ltid(), l = it / 96, cgp = it % 96;
    {   float cv[18];
#pragma unroll
        for (int q = 0; q < 18; ++q) { const int i = tid + 512 * q, r = i >> 10, k = i & 1023; cv[q] = r < 8 ? p.in[I_C][r * 1024 + k] : p.in[I_CCTX][k]; }
#pragma unroll
        for (int q = 0; q < 18; ++q) sl[tid + 512 * q] = siluf(cv[q]); }
    __syncthreads();
    const int j4 = (tid & 15) * 4, ks = tid >> 4;
    f32x4 acc[9];
#pragma unroll
    for (int r = 0; r < 9; ++r) acc[r] = (f32x4){0.f, 0.f, 0.f, 0.f};
    const float* w = p.in[I_WMOD] + (size_t)l * 1024 * 6144 + cgp * 64 + j4;
#pragma unroll 8
    for (int k = ks * 32; k < ks * 32 + 32; ++k) {
        const f32x4 wv = *(const f32x4*)(w + (size_t)k * 6144);
#pragma unroll
        for (int r = 0; r < 9; ++r) acc[r] += wv * sl[r * 1024 + k];
    }
    float* red = sl + 9216;
#pragma unroll
    for (int r = 0; r < 9; ++r) *(f32x4*)(red + (ks * 9 + r) * 64 + j4) = acc[r];
    __syncthreads();
    for (int o = tid; o < 576; o += 512) { const int r = o >> 6, jl = o & 63; float s = 0.f;
#pragma unroll
        for (int q = 0; q < 32; ++q) s += red[(q * 9 + r) * 64 + jl];
        ((float*)(p.ws + WS_MOD))[(size_t)(l * 9 + r) * 6144 + cgp * 64 + jl] = s + p.in[I_BMOD][l * 6144 + cgp * 64 + jl]; }
    __syncthreads();
}
__device__ __forceinline__ void prep_dft_row(const KP& p, int rowid, const float* tab) {
    const int tid = ltid();
    if (rowid < 2048) {
        const int k = rowid; float v[4];
#pragma unroll
        for (int e = 0; e < 4; ++e) { const int j = tid * 4 + e;
            if (j <= 1024) v[e] = tab[(k * j) & 2047]; else { const int n = j - 1024; v[e] = -tab[(((k * n) & 2047) - 512) & 2047]; } }
        u32x2 ov; ov.x = pk2(v[0], v[1]); ov.y = pk2(v[2], v[3]);
        *(u32x2*)((bf16_t*)(p.ws + WS_FDFT) + (size_t)k * 2048 + tid * 4) = ov;
    } else if (tid < 64) {
        const int k = rowid - 2048; unsigned o[4];
#pragma unroll
        for (int i = 0; i < 4; ++i) { float v[2];
#pragma unroll
            for (int e = 0; e < 2; ++e) { const int np = tid * 8 + i * 2 + e, n = np & 255, j = ((k * n) & 255) * 8; v[e] = (np >> 8) ? -tab[(j - 512) & 2047] : tab[j]; }
            o[i] = pk2(v[0], v[1]); }
        u32x4 ov = {o[0], o[1], o[2], o[3]};
        *(u32x4*)((bf16_t*)(p.ws + WS_FDFTC) + (size_t)k * 512 + tid * 8) = ov;
    }
}
__device__ __forceinline__ void rope_cs(int tpos, int seg, int f, float& cs, float& sn);
__device__ __forceinline__ void step_prep0(const KP& p, unsigned char* shm) {
    float* tab = (float*)shm; float* work = (float*)(shm + 8192);
    build_costab(tab);
    {
        unsigned* z = (unsigned*)(p.ws + WS_RCNT);
        for (int i = lbid() * 512 + ltid(); i < (65536 + 262144) / 4; i += gridDim.x * 512) z[i] = 0u; }
    {
        float* rt = (float*)(p.ws + WS_ROPE);
        for (int i = lbid() * 512 + ltid(); i < 2048 * 16; i += gridDim.x * 512) { float cs, sn; rope_cs(i >> 4, (i >> 3) & 1, i & 7, cs, sn); rt[2 * i] = cs; rt[2 * i + 1] = sn; } }
    const int NT = 192 + 2304;
    const bool nomod = (int)gridDim.x == 256 && lbid() >= 192;
    if (nomod) prep_weights(p, 0, shm, tab, 3, 192, 64);
    for (int it = lbid(); it < NT; it += gridDim.x) {
        if (it < 192) prep_mod_item(p, it, work);
        else prep_dft_row(p, it - 192, tab);
    }
    __syncthreads();
    if ((int)gridDim.x == 256) prep_weights(p, 0, shm, tab, 4); else prep_weights(p, 0, shm, tab);
}

__device__ __forceinline__ void norm_rows(const float* xl, const float* xc, int nrows, const float* g, const float* modl, int shoff, int scoff, bf16_t* dst, const bf16_t* part = nullptr, const float* pga = nullptr, float* xcw = nullptr, int rlo = 0) {
    const int tid = ltid(), lane = tid & 63, gw = lbid() * 8 + (tid >> 6), NW = gridDim.x * 8;
    for (int r0 = rlo + gw; r0 < nrows; r0 += 3 * NW) {
        f32x4 v[3][4]; float ss[3];
#pragma unroll
        for (int q = 0; q < 3; ++q) { const int r = r0 + q * NW; ss[q] = 0.f;
            if (r < nrows) { const float* xr = r < TL ? xl + (size_t)r * D : xc + (size_t)(r - TL) * D;
#pragma unroll
                for (int j = 0; j < 4; ++j) v[q][j] = *(const f32x4*)(xr + lane * 4 + 256 * j);
                if (part != nullptr && r >= TL) {
#pragma unroll
                    for (int j = 0; j < 4; ++j) { const int c = lane * 4 + 256 * j; f32x4 a = {0.f, 0.f, 0.f, 0.f};
#pragma unroll
                        for (int sp = 0; sp < 4; ++sp) { const u32x2 pv = *(const u32x2*)(part + ((size_t)sp * TC + (r - TL)) * D + c); a[0] += lo_bf(pv.x); a[1] += hi_bf(pv.x); a[2] += lo_bf(pv.y); a[3] += hi_bf(pv.y); }
                        v[q][j] += *(const f32x4*)(pga + c) * a;
                        if (xcw != nullptr) *(f32x4*)(xcw + (size_t)(r - TL) * D + c) = v[q][j]; } } }
            else {
#pragma unroll
                for (int j = 0; j < 4; ++j) v[q][j] = (f32x4){0.f, 0.f, 0.f, 0.f}; } }
#pragma unroll
        for (int q = 0; q < 3; ++q) {
#pragma unroll
            for (int j = 0; j < 4; ++j) ss[q] += v[q][j][0] * v[q][j][0] + v[q][j][1] * v[q][j][1] + v[q][j][2] * v[q][j][2] + v[q][j][3] * v[q][j][3];
            ss[q] = wave_sum(ss[q]); }
#pragma unroll
        for (int q = 0; q < 3; ++q) { const int r = r0 + q * NW;
            if (r < nrows) { const int b = r < TL ? (r >> 11) : 8; const float rstd = rsqrtf(ss[q] * (1.f / D) + EPS); const float* mp = modl + (size_t)b * 6144;
#pragma unroll
                for (int j = 0; j < 4; ++j) { const int c = lane * 4 + 256 * j;
                    const f32x4 gg = *(const f32x4*)(g + c), sc = *(const f32x4*)(mp + scoff + c), sh = *(const f32x4*)(mp + shoff + c);
                    const f32x4 y = v[q][j] * rstd * gg, hh = y * (sc + 1.f) + sh;
                    u32x2 o; o.x = pk2(hh[0], hh[1]); o.y = pk2(hh[2], hh[3]);
                    *(u32x2*)(dst + (size_t)r * D + c) = o; } } }
    }
}
__device__ __forceinline__ void step_final(const KP& p) {
    const int tid = ltid(), lane = tid & 63, gw = lbid() * 8 + (tid >> 6), NW = gridDim.x * 8;
    const float* g = p.in[I_GFIN];
    for (int r0 = gw; r0 < TL; r0 += 2 * NW) {
        f32x4 v[2][4]; float ss[2];
#pragma unroll
        for (int q = 0; q < 2; ++q) { const float* xr = p.out + (size_t)(r0 + q * NW) * D; ss[q] = 0.f;
#pragma unroll
            for (int j = 0; j < 4; ++j) v[q][j] = *(const f32x4*)(xr + lane * 4 + 256 * j); }
#pragma unroll
        for (int q = 0; q < 2; ++q) {
#pragma unroll
            for (int j = 0; j < 4; ++j) ss[q] += v[q][j][0] * v[q][j][0] + v[q][j][1] * v[q][j][1] + v[q][j][2] * v[q][j][2] + v[q][j][3] * v[q][j][3];
            ss[q] = wave_sum(ss[q]); }
#pragma unroll
        for (int q = 0; q < 2; ++q) { float* xr = p.out + (size_t)(r0 + q * NW) * D; const float rstd = rsqrtf(ss[q] * (1.f / D) + EPS);
#pragma unroll
            for (int j = 0; j < 4; ++j) { const int c = lane * 4 + 256 * j; *(f32x4*)(xr + c) = v[q][j] * rstd * *(const f32x4*)(g + c); } }
    }
}

constexpr int ML_GA = 0;
constexpr int ML_CW = 3072;
constexpr int ML_Q = 7168;
constexpr int ML_K = 33792;
constexpr int ML_VT = 60416;
constexpr int ML_RAW = 90880;
__device__ __forceinline__ int ml_rowbase(int b, int jc) { return jc < 2 ? TL + b * CL + jc * LCH : b * SEQ + (jc - 2) * LCH; }

__device__ __forceinline__ void ml_stage(const KP& p, int l, int b, int h, int jc, unsigned char* shm) {
    const int tid = ltid();
    const bf16_t* proj = (const bf16_t*)(p.ws + WS_PROJ);
    const float* gates = (const float*)(p.ws + WS_GATES);
    float* GA = (float*)(shm + ML_GA); float* CW = (float*)(shm + ML_CW);
    bf16_t* vT = (bf16_t*)(shm + ML_VT); bf16_t* RAW = (bf16_t*)(shm + ML_RAW);
    const int rowbase = ml_rowbase(b, jc);
    const int t0 = jc < 2 ? jc * LCH : (jc - 2) * LCH, slen = jc < 2 ? CL : SEQ;
    float i_f = 0.f, i_b = 0.f, pf = 0.f, sf = 0.f;
    if (tid < 128) {
        const int lane = tid & 63;
        const float* gp = gates + (size_t)(rowbase + tid) * 16; const float* bg = p.in[I_BG] + l * 16;
        const f32x4 g0 = *(const f32x4*)gp, g1 = *(const f32x4*)(gp + 4), g2 = *(const f32x4*)(gp + 8), g3 = *(const f32x4*)(gp + 12);
        i_f = g0[h] + bg[h]; i_b = g2[h] + bg[8 + h];
        pf = logsig(g1[h] + bg[4 + h]); sf = logsig(g3[h] + bg[12 + h]);
#pragma unroll
        for (int o = 1; o < 64; o <<= 1) { const float t = __shfl_up(pf, o); if (lane >= o) pf += t; const float u = __shfl_down(sf, o); if (lane + o < 64) sf += u; }
        if (lane == 63) GA[4 * 128 + (tid >> 6)] = pf;
        if (lane == 0) GA[5 * 128 + (tid >> 6)] = sf;
    }
    float cwv[2]; u32x4 rv[7], vv[3];
#pragma unroll
    for (int q = 0; q < 2; ++q) { const int i = tid + 512 * q; cwv[q] = 0.f;
        if (i < 5 * 192) { const int k = i / 192, ch = i % 192; cwv[q] = p.in[I_CONV][(size_t)l * 5 * 768 + k * 768 + (ch < 96 ? h * 96 + ch : 384 + h * 96 + (ch - 96))]; } }
#pragma unroll
    for (int q = 0; q < 7; ++q) { const int i = tid + 512 * q; rv[q] = (u32x4){0u, 0u, 0u, 0u};
        if (i < 132 * 24) { const int rr = i / 24, ck = i % 24, t = t0 - 2 + rr;
            if (t >= 0 && t < slen) { const int col = ck < 12 ? C_MQ + h * 96 + ck * 8 : C_MK + h * 96 + (ck - 12) * 8; rv[q] = *(const u32x4*)(proj + (size_t)(rowbase - 2 + rr) * PW + col); } } }
#pragma unroll
    for (int q = 0; q < 3; ++q) { const int i = tid + 512 * q, s = i / 12, ck = i % 12; vv[q] = *(const u32x4*)(proj + (size_t)(rowbase + s) * PW + C_MV + h * 96 + ck * 8); }
#pragma unroll
    for (int q = 0; q < 2; ++q) { const int i = tid + 512 * q; if (i < 5 * 192) CW[i] = cwv[q]; }
#pragma unroll
    for (int q = 0; q < 7; ++q) { const int i = tid + 512 * q; if (i < 132 * 24) { const int rr = i / 24, ck = i % 24; *(u32x4*)(RAW + rr * 192 + ck * 8) = rv[q]; } }
#pragma unroll
    for (int q = 0; q < 3; ++q) { const int i = tid + 512 * q, s = i / 12, ck = i % 12; const u32x4 v = vv[q];
        bf16_t* d = vT + (ck * 8) * 136 + s;
        d[0] = (bf16_t)(v.x & 0xFFFF); d[136] = (bf16_t)(v.x >> 16); d[2 * 136] = (bf16_t)(v.y & 0xFFFF); d[3 * 136] = (bf16_t)(v.y >> 16);
        d[4 * 136] = (bf16_t)(v.z & 0xFFFF); d[5 * 136] = (bf16_t)(v.z >> 16); d[6 * 136] = (bf16_t)(v.w & 0xFFFF); d[7 * 136] = (bf16_t)(v.w >> 16); }
    for (int i = tid; i < 16 * 128; i += 512) { const int r = i >> 7, s = i & 127; vT[(96 + r) * 136 + s] = r == 0 ? (bf16_t)0x3F80 : (bf16_t)0; }
    __syncthreads();
    if (tid < 128) {
        const float bf = pf + (tid >= 64 ? GA[4 * 128 + 0] : 0.f), bb = sf + (tid < 64 ? GA[5 * 128 + 1] : 0.f);
        GA[0 * 128 + tid] = i_f; GA[1 * 128 + tid] = bf; GA[2 * 128 + tid] = i_b; GA[3 * 128 + tid] = bb;
    }
    __syncthreads();
}

__device__ __forceinline__ void conv8(const bf16_t* RAW, const float* CW, int s0, int ch, float (&o0)[8], float (&o1)[8]) {
    float w0[5], w1[5];
#pragma unroll
    for (int i = 0; i < 5; ++i) { w0[i] = CW[i * 192 + ch]; w1[i] = CW[i * 192 + ch + 1]; }
    unsigned rv[12];
#pragma unroll
    for (int i = 0; i < 12; ++i) rv[i] = *(const unsigned*)(RAW + (s0 + i) * 192 + ch);
#pragma unroll
    for (int o = 0; o < 8; ++o) { float a0 = 0.f, a1 = 0.f;
#pragma unroll
        for (int i = 0; i < 5; ++i) { a0 += lo_bf(rv[o + i]) * w0[i]; a1 += hi_bf(rv[o + i]) * w1[i]; }
        o0[o] = siluf(a0); o1[o] = siluf(a1); }
}
__device__ __forceinline__ void mlstm_a_item(const KP& p, int l, int item, unsigned char* shm) {
    const int tid = ltid(), w = tid >> 6, lane = tid & 63, fr = lane & 15, fq = lane >> 4;
    const int jc = item % NCH, bh = item / NCH, h = bh & 3, b = bh >> 2;
    ml_stage(p, l, b, h, jc, shm);
    float* GA = (float*)(shm + ML_GA); const float* CW = (const float*)(shm + ML_CW);
    bf16_t* kwf = (bf16_t*)(shm + ML_Q); bf16_t* kwb = (bf16_t*)(shm + ML_K);
    const bf16_t* vT = (const bf16_t*)(shm + ML_VT); const bf16_t* RAW = (const bf16_t*)(shm + ML_RAW);
    const float Bf = GA[1 * 128 + 127], Bb = GA[3 * 128 + 0];
    if (tid < 128) { GA[4 * 128 + tid] = __expf(Bf - GA[1 * 128 + tid] + GA[0 * 128 + tid]); GA[5 * 128 + tid] = __expf(Bb - GA[3 * 128 + tid] + GA[2 * 128 + tid]); }
    if (tid == 0) { float* dec = (float*)(p.ws + WS_DEC); dec[(bh * 2 + 0) * NCH + jc] = __expf(Bf); dec[(bh * 2 + 1) * NCH + jc] = __expf(Bb); }
    __syncthreads();
    for (int task = tid; task < 48 * 16; task += 512) { const int cp = task % 48, s0 = (task / 48) * 8, ch = 96 + 2 * cp, dk = 2 * cp;
        float o0[8], o1[8]; conv8(RAW, CW, s0, ch, o0, o1);
        const f32x4 wfa = *(const f32x4*)(GA + 4 * 128 + s0), wfb = *(const f32x4*)(GA + 4 * 128 + s0 + 4), wba = *(const f32x4*)(GA + 5 * 128 + s0), wbb = *(const f32x4*)(GA + 5 * 128 + s0 + 4);
        u32x4 t;
        t.x = pk2(o0[0] * wfa[0], o0[1] * wfa[1]); t.y = pk2(o0[2] * wfa[2], o0[3] * wfa[3]); t.z = pk2(o0[4] * wfb[0], o0[5] * wfb[1]); t.w = pk2(o0[6] * wfb[2], o0[7] * wfb[3]); *(u32x4*)(kwf + dk * 136 + s0) = t;
        t.x = pk2(o1[0] * wfa[0], o1[1] * wfa[1]); t.y = pk2(o1[2] * wfa[2], o1[3] * wfa[3]); t.z = pk2(o1[4] * wfb[0], o1[5] * wfb[1]); t.w = pk2(o1[6] * wfb[2], o1[7] * wfb[3]); *(u32x4*)(kwf + (dk + 1) * 136 + s0) = t;
        t.x = pk2(o0[0] * wba[0], o0[1] * wba[1]); t.y = pk2(o0[2] * wba[2], o0[3] * wba[3]); t.z = pk2(o0[4] * wbb[0], o0[5] * wbb[1]); t.w = pk2(o0[6] * wbb[2], o0[7] * wbb[3]); *(u32x4*)(kwb + dk * 136 + s0) = t;
        t.x = pk2(o1[0] * wba[0], o1[1] * wba[1]); t.y = pk2(o1[2] * wba[2], o1[3] * wba[3]); t.z = pk2(o1[4] * wbb[0], o1[5] * wbb[1]); t.w = pk2(o1[6] * wbb[2], o1[7] * wbb[3]); *(u32x4*)(kwb + (dk + 1) * 136 + s0) = t; }
    __syncthreads();
    bf16_t* dC = (bf16_t*)(p.ws + WS_DC);
    for (int tix = w; tix < 84; tix += 8) { const int dir = tix / 42, tt = tix % 42, vt = tt / 6, nt = tt % 6;
        const bf16_t* kw = dir ? kwb : kwf;
        f32x4 acc = {0.f, 0.f, 0.f, 0.f};
        bf16x8 af[4], bf4[4];
#pragma unroll
        for (int ks = 0; ks < 4; ++ks) { af[ks] = *(const bf16x8*)(vT + (16 * vt + fr) * 136 + 32 * ks + 8 * fq); bf4[ks] = *(const bf16x8*)(kw + (16 * nt + fr) * 136 + 32 * ks + 8 * fq); }
        __builtin_amdgcn_sched_barrier(0);
#pragma unroll
        for (int ks = 0; ks < 4; ++ks) acc = MFMA16(af[ks], bf4[ks], acc);
        bf16_t* o = dC + ((size_t)(bh * 2 + dir) * NCH + jc) * STSZ + (16 * vt + 4 * fq) * 96 + 16 * nt + fr;
        o[0] = f2bf(acc[0]); o[96] = f2bf(acc[1]); o[192] = f2bf(acc[2]); o[288] = f2bf(acc[3]); }
    __syncthreads();
}

__device__ __forceinline__ void mlstm_scan(const KP& p) {
    const bf16_t* dC = (const bf16_t*)(p.ws + WS_DC); bf16_t* Cst = (bf16_t*)(p.ws + WS_CST); const float* dec = (const float*)(p.ws + WS_DEC);
    const int nthr = gridDim.x * 512;
    for (int wi = lbid() * 512 + ltid(); wi < 64 * (STSZ / 8); wi += nthr) {
        const int chain = wi / (STSZ / 8), e = (wi % (STSZ / 8)) * 8, dir = chain & 1;
        u32x4 dv[NCH]; float dd[NCH];
#pragma unroll
        for (int pz = 0; pz < NCH; ++pz) { const int jc = dir == 0 ? pz : (pz < 2 ? 1 - pz : NCH + 1 - pz);
            dv[pz] = *(const u32x4*)(dC + ((size_t)chain * NCH + jc) * STSZ + e); dd[pz] = dec[chain * NCH + jc]; }
        float S[8];
#pragma unroll
        for (int i = 0; i < 8; ++i) S[i] = 0.f;
#pragma unroll
        for (int pz = 0; pz < NCH; ++pz) {
            const int jc = dir == 0 ? pz : (pz < 2 ? 1 - pz : NCH + 1 - pz);
            u32x4 o; o.x = pk2(S[0], S[1]); o.y = pk2(S[2], S[3]); o.z = pk2(S[4], S[5]); o.w = pk2(S[6], S[7]);
            *(u32x4*)(Cst + ((size_t)chain * NCH + jc) * STSZ + e) = o;
            const u32x4 d = dv[pz]; const float f = dd[pz];
            S[0] = S[0] * f + lo_bf(d.x); S[1] = S[1] * f + hi_bf(d.x); S[2] = S[2] * f + lo_bf(d.y); S[3] = S[3] * f + hi_bf(d.y);
            S[4] = S[4] * f + lo_bf(d.z); S[5] = S[5] * f + hi_bf(d.z); S[6] = S[6] * f + lo_bf(d.w); S[7] = S[7] * f + hi_bf(d.w);
        }
    }
}

__device__ __forceinline__ void mlstm_c_item(const KP& p, int l, int b, int h, int jc, unsigned char* shm) {
    const int tid = ltid(), w = tid >> 6, lane = tid & 63, fr = lane & 15, fq = lane >> 4;
    const int bh = b * 4 + h;
    ml_stage(p, l, b, h, jc, shm);
    const float* GA = (const float*)(shm + ML_GA); const float* CW = (const float*)(shm + ML_CW);
    bf16_t* qL = (bf16_t*)(shm + ML_Q); bf16_t* kL = (bf16_t*)(shm + ML_K);
    const bf16_t* vT = (const bf16_t*)(shm + ML_VT); const bf16_t* RAW = (const bf16_t*)(shm + ML_RAW);
    bf16_t* CsL = (bf16_t*)(shm + ML_RAW);
    const float qscale = 0.10206207261596577f;
    u32x4 cpre[6];
    {   const bf16_t* Cst = (const bf16_t*)(p.ws + WS_CST);
#pragma unroll
        for (int i = 0; i < 6; ++i) { const int c = tid + 512 * i; if (c < 2 * 112 * 12) { const int dir = c / 1344, r = (c % 1344) / 12, ck = c % 12;
            cpre[i] = *(const u32x4*)(Cst + ((size_t)(bh * 2 + dir) * NCH + jc) * STSZ + r * 96 + ck * 8); } else cpre[i] = (u32x4){0u, 0u, 0u, 0u}; } }
    for (int task = tid; task < 96 * 16; task += 512) { const int cp = task % 96, s0 = (task / 96) * 8, ch = 2 * cp;
        float o0[8], o1[8]; conv8(RAW, CW, s0, ch, o0, o1);
        if (ch < 96) {
#pragma unroll
            for (int i = 0; i < 8; ++i) *(unsigned*)(qL + (s0 + i) * 104 + ch) = pk2(o0[i] * qscale, o1[i] * qscale);
        } else {
#pragma unroll
            for (int i = 0; i < 8; ++i) *(unsigned*)(kL + (s0 + i) * 104 + (ch - 96)) = pk2(o0[i], o1[i]); } }
    __syncthreads();
    {
        for (int i = 0; i < 6; ++i) { const int c = tid + 512 * i; if (c < 2 * 112 * 12) { const int dir = c / 1344, r = (c % 1344) / 12, ck = c % 12; *(u32x4*)(CsL + dir * (112 * 104) + r * 104 + ck * 8) = cpre[i]; } }
    }
    __syncthreads();
    const int t = 16 * w + fr;
    const int row = ml_rowbase(b, jc) + t;
    const bf16_t* proj = (const bf16_t*)(p.ws + WS_PROJ);
    u32x2 mov[6];
#pragma unroll
    for (int vt = 0; vt < 6; ++vt) mov[vt] = *(const u32x2*)(proj + (size_t)row * PW + C_MO + h * 96 + 16 * vt + 4 * fq);
    bf16x8 qf[3];
#pragma unroll
    for (int ks = 0; ks < 3; ++ks) qf[ks] = *(const bf16x8*)(qL + t * 104 + 32 * ks + 8 * fq);
    const float bft = GA[128 + t], bbt = GA[3 * 128 + t];
    bf16x8 PF[4], PB[4];
#pragma unroll
    for (int half = 0; half < 2; ++half) {
        bf16x8 kf[4][3];
#pragma unroll
        for (int i = 0; i < 4; ++i)
#pragma unroll
            for (int ks = 0; ks < 3; ++ks) kf[i][ks] = *(const bf16x8*)(kL + (16 * (4 * half + i) + fr) * 104 + 32 * ks + 8 * fq);
        __builtin_amdgcn_sched_barrier(0);
        f32x4 sa[4];
#pragma unroll
        for (int i = 0; i < 4; ++i) { sa[i] = (f32x4){0.f, 0.f, 0.f, 0.f};
#pragma unroll
            for (int ks = 0; ks < 3; ++ks) sa[i] = MFMA16(kf[i][ks], qf[ks], sa[i]); }
        __builtin_amdgcn_sched_barrier(0);
#pragma unroll
        for (int k2 = 0; k2 < 2; ++k2) {
            unsigned pf[4], pb[4];
#pragma unroll
            for (int hh = 0; hh < 2; ++hh) { const int i = 2 * k2 + hh, st = 4 * half + i;
                const int s0 = 16 * st + 4 * fq;
                const f32x4 gif = *(const f32x4*)(GA + s0), gbf = *(const f32x4*)(GA + 128 + s0), gib = *(const f32x4*)(GA + 256 + s0), gbb = *(const f32x4*)(GA + 384 + s0);
                float vf[4], vb[4];
#pragma unroll
                for (int j = 0; j < 4; ++j) { const int s = s0 + j;
                    vf[j] = (s <= t) ? sa[i][j] * __expf(bft - gbf[j] + gif[j]) : 0.f;
                    vb[j] = (s >= t) ? sa[i][j] * __expf(bbt - gbb[j] + gib[j]) : 0.f; }
                pf[2 * hh] = pk2(vf[0], vf[1]); pf[2 * hh + 1] = pk2(vf[2], vf[3]); pb[2 * hh] = pk2(vb[0], vb[1]); pb[2 * hh + 1] = pk2(vb[2], vb[3]); }
            u32x4 tf = {pf[0], pf[1], pf[2], pf[3]}, tb = {pb[0], pb[1], pb[2], pb[3]};
            PF[2 * half + k2] = __builtin_bit_cast(bf16x8, tf); PB[2 * half + k2] = __builtin_bit_cast(bf16x8, tb);
        }
    }
    const float ebf = __expf(bft), ebb = __expf(bbt);
    f32x4 nf[7], nb[7];
#pragma unroll
    for (int vt = 0; vt < 7; ++vt) {
        bf16x8 cf[3], cb[3]; u32x2 vlo[4], vhi[4];
#pragma unroll
        for (int ks = 0; ks < 3; ++ks) { cf[ks] = *(const bf16x8*)(CsL + (16 * vt + fr) * 104 + 32 * ks + 8 * fq); cb[ks] = *(const bf16x8*)(CsL + 112 * 104 + (16 * vt + fr) * 104 + 32 * ks + 8 * fq); }
#pragma unroll
        for (int kk = 0; kk < 4; ++kk) { vlo[kk] = *(const u32x2*)(vT + (16 * vt + fr) * 136 + 32 * kk + 4 * fq); vhi[kk] = *(const u32x2*)(vT + (16 * vt + fr) * 136 + 32 * kk + 16 + 4 * fq); }
        __builtin_amdgcn_sched_barrier(0);
        f32x4 af = {0.f, 0.f, 0.f, 0.f}, ab = {0.f, 0.f, 0.f, 0.f};
#pragma unroll
        for (int ks = 0; ks < 3; ++ks) { af = MFMA16(cf[ks], qf[ks], af); ab = MFMA16(cb[ks], qf[ks], ab); }
        af *= ebf; ab *= ebb;
#pragma unroll
        for (int kk = 0; kk < 4; ++kk) { const bf16x8 a = mk8(vlo[kk], vhi[kk]); af = MFMA16(a, PF[kk], af); ab = MFMA16(a, PB[kk], ab); }
        nf[vt] = af; nb[vt] = ab;
    }
    const float denf = __shfl(nf[6][0], fr), denb = __shfl(nb[6][0], fr);
    const float rf = 1.f / fmaxf(fabsf(denf), 1.f), rb = 1.f / fmaxf(fabsf(denb), 1.f);
    float ss = 0.f;
#pragma unroll
    for (int vt = 0; vt < 6; ++vt) { nf[vt] = nf[vt] * rf + nb[vt] * rb; ss += nf[vt][0] * nf[vt][0] + nf[vt][1] * nf[vt][1] + nf[vt][2] * nf[vt][2] + nf[vt][3] * nf[vt][3]; }
    ss = sum_over_fq(ss);
    const float rn = rsqrtf(ss * (1.f / 96.f) + EPS);
    bf16_t* mix = (bf16_t*)(p.ws + WS_MIX);
    const float* gm = p.in[I_GM] + l * 384 + h * 96;
#pragma unroll
    for (int vt = 0; vt < 6; ++vt) { const int vc = 16 * vt + 4 * fq;
        const u32x2 mo = mov[vt]; const f32x4 g = *(const f32x4*)(gm + vc);
        const float m0 = lo_bf(mo.x), m1 = hi_bf(mo.x), m2 = lo_bf(mo.y), m3 = hi_bf(mo.y);
        const float y0 = nf[vt][0] * rn * g[0] / (1.f + __expf(-m0)), y1 = nf[vt][1] * rn * g[1] / (1.f + __expf(-m1));
        const float y2 = nf[vt][2] * rn * g[2] / (1.f + __expf(-m2)), y3 = nf[vt][3] * rn * g[3] / (1.f + __expf(-m3));
        u32x2 o; o.x = pk2(y0, y1); o.y = pk2(y2, y3);
        *(u32x2*)(mix + (size_t)row * D + 256 + h * 96 + vc) = o; }
    __syncthreads();
}

__device__ __forceinline__ void zt_fold_item(const KP& p, int item, unsigned char* shm) {
    const int tid = ltid(), w = tid >> 6, lane = tid & 63;
    const int col = item * 8 + w;
    const bf16_t* zr = (const bf16_t*)(p.ws + WS_ZT) + (size_t)col * 4096;
    bf16_t* la = (bf16_t*)(shm + w * 8192); bf16_t* lb = la + 2048;
#pragma unroll
    for (int q = 0; q < 4; ++q) { *(u32x4*)(la + (q * 64 + lane) * 8) = *(const u32x4*)(zr + (q * 64 + lane) * 8); *(u32x4*)(lb + (q * 64 + lane) * 8) = *(const u32x4*)(zr + 2048 + (q * 64 + lane) * 8); }
    asm volatile("s_waitcnt vmcnt(0) lgkmcnt(0)" ::: "memory");
    bf16_t* out = (bf16_t*)(p.ws + WS_ZTF) + (size_t)col * 2048;
#pragma unroll
    for (int q = 0; q < 4; ++q) { const int j0 = (q * 64 + lane) * 8; unsigned o[4];
#pragma unroll
        for (int e2 = 0; e2 < 4; ++e2) { float v[2];
#pragma unroll
            for (int e = 0; e < 2; ++e) { const int j = j0 + 2 * e2 + e;
                if (j == 0 || j == 1024) v[e] = bf2f(la[j]);
                else if (j < 1024) v[e] = bf2f(la[j]) + bf2f(la[2048 - j]);
                else { const int n = j - 1024; v[e] = bf2f(lb[n]) - bf2f(lb[2048 - n]); } }
            o[e2] = pk2(v[0], v[1]); }
        u32x4 ov = {o[0], o[1], o[2], o[3]};
        *(u32x4*)(out + j0) = ov; }
    asm volatile("s_waitcnt lgkmcnt(0)" ::: "memory");
}

__device__ __forceinline__ void rope_cs_tab(const float* rt, int tpos, int seg, int f, float& cs, float& sn) { const float2 v = *(const float2*)(rt + ((tpos * 2 + seg) * 8 + f) * 2); cs = v.x; sn = v.y; }
__device__ __forceinline__ void rope_cs(int tpos, int seg, int f, float& cs, float& sn) {
    const float pos = (float)(seg == 0 ? (tpos >> 6) : (tpos & 63));
    const float fr = exp2f(-(float)f * 1.6609640474436813f);
    sincosf(pos * fr, &sn, &cs);
}
__device__ __forceinline__ void qkv_item(const KP& p, int l, int item, unsigned char* shm) {
    const int tid = ltid(), w = tid >> 6, lane = tid & 63, fr = lane & 15, fq = lane >> 4;
    const int r0 = item * 64; const bool lat = r0 < TL;
    const int b = lat ? (r0 >> 11) : ((r0 - TL) >> 8), tl0 = lat ? (r0 & 2047) : ((r0 - TL) & 255), key0 = lat ? tl0 : SEQ + tl0;
    const bf16_t* proj = (const bf16_t*)(p.ws + WS_PROJ); const float* rt = (const float*)(p.ws + WS_ROPE);
    bf16_t* aq = (bf16_t*)shm; bf16_t* akv = (bf16_t*)(shm + 64 * 264 * 2);
    {
        const int tk = tid >> 3, sub = tid & 7; const bf16_t* pr = proj + (size_t)(r0 + tk) * PW;
        u32x4 cq[4], ck[2]; float sq = 0.f, sk = 0.f;
#pragma unroll
        for (int i = 0; i < 4; ++i) { cq[i] = *(const u32x4*)(pr + C_CQ + sub * 32 + i * 8);
#pragma unroll
            for (int e = 0; e < 4; ++e) { const float a = lo_bf(cq[i][e]), c = hi_bf(cq[i][e]); sq += a * a + c * c; } }
#pragma unroll
        for (int i = 0; i < 2; ++i) { ck[i] = *(const u32x4*)(pr + C_CKV + sub * 16 + i * 8);
#pragma unroll
            for (int e = 0; e < 4; ++e) { const float a = lo_bf(ck[i][e]), c = hi_bf(ck[i][e]); sk += a * a + c * c; } }
        sq += __shfl_xor(sq, 1); sq += __shfl_xor(sq, 2); sq += __shfl_xor(sq, 4);
        sk += __shfl_xor(sk, 1); sk += __shfl_xor(sk, 2); sk += __shfl_xor(sk, 4);
        const float rq = rsqrtf(sq * (1.f / 256.f) + EPS), rk = rsqrtf(sk * (1.f / 128.f) + EPS);
        const float* gq = p.in[I_GQN] + l * 256 + sub * 32; const float* gk = p.in[I_GKVN] + l * 128 + sub * 16;
#pragma unroll
        for (int i = 0; i < 4; ++i) { u32x4 o;
#pragma unroll
            for (int e = 0; e < 4; ++e) o[e] = pk2(lo_bf(cq[i][e]) * rq * gq[i * 8 + 2 * e], hi_bf(cq[i][e]) * rq * gq[i * 8 + 2 * e + 1]);
            *(u32x4*)(aq + tk * 264 + sub * 32 + i * 8) = o; }
#pragma unroll
        for (int i = 0; i < 2; ++i) { u32x4 o;
#pragma unroll
            for (int e = 0; e < 4; ++e) o[e] = pk2(lo_bf(ck[i][e]) * rk * gk[i * 8 + 2 * e], hi_bf(ck[i][e]) * rk * gk[i * 8 + 2 * e + 1]);
            *(u32x4*)(akv + tk * 136 + sub * 16 + i * 8) = o; }
    }
    bf16_t* Qb = (bf16_t*)(p.ws + WS_QB); bf16_t* Kb = (bf16_t*)(p.ws + WS_KB); bf16_t* Vt = (bf16_t*)(p.ws + WS_VT);
    {
        const int tk = tid >> 3, i0 = (tid & 7) * 4, seg = i0 >> 4, half = (i0 >> 3) & 1, f0 = i0 & 7;
        const bf16_t* pr = proj + (size_t)(r0 + tk) * PW + C_KR;
        const u32x2 me = *(const u32x2*)(pr + i0), pa = *(const u32x2*)(pr + (i0 ^ 8));
        float mv[4] = {lo_bf(me.x), hi_bf(me.x), lo_bf(me.y), hi_bf(me.y)}, pv[4] = {lo_bf(pa.x), hi_bf(pa.x), lo_bf(pa.y), hi_bf(pa.y)}, ov[4];
#pragma unroll
        for (int j = 0; j < 4; ++j) {
            if (lat) { float cs, sn; rope_cs_tab(rt, tl0 + tk, seg, f0 + j, cs, sn); ov[j] = half ? (pv[j] * sn + mv[j] * cs) : (mv[j] * cs - pv[j] * sn); }
            else ov[j] = mv[j]; }
        u32x2 o; o.x = pk2(ov[0], ov[1]); o.y = pk2(ov[2], ov[3]);
#pragma unroll
        for (int hh = 0; hh < 4; ++hh) *(u32x2*)(Kb + ((size_t)(b * 4 + hh) * KEYS + key0 + tk) * 96 + 64 + i0) = o;
    }
    __syncthreads();
    const bf16_t* WuqT = (const bf16_t*)(p.ws + WS_WUQ); const bf16_t* WukvT = (const bf16_t*)(p.ws + WS_WUKV);
    const float qs = 0.10206207261596577f * 1.4426950408889634f;
    for (int ct = w; ct < 24; ct += 8) {
        f32x4 acc[4];
#pragma unroll
        for (int tt = 0; tt < 4; ++tt) acc[tt] = (f32x4){0.f, 0.f, 0.f, 0.f};
        bf16x8 wa[8];
#pragma unroll
        for (int ks = 0; ks < 8; ++ks) wa[ks] = *(const bf16x8*)(WuqT + (size_t)(16 * ct + fr) * 256 + 32 * ks + 8 * fq);
#pragma unroll
        for (int kh = 0; kh < 4; ++kh) { bf16x8 bb[2][4];
#pragma unroll
            for (int k2 = 0; k2 < 2; ++k2)
#pragma unroll
                for (int tt = 0; tt < 4; ++tt) bb[k2][tt] = *(const bf16x8*)(aq + (16 * tt + fr) * 264 + 32 * (2 * kh + k2) + 8 * fq);
            __builtin_amdgcn_sched_barrier(0);
#pragma unroll
            for (int k2 = 0; k2 < 2; ++k2)
#pragma unroll
                for (int tt = 0; tt < 4; ++tt) acc[tt] = MFMA16(wa[2 * kh + k2], bb[k2][tt], acc[tt]); }
        const int hq = ct / 6, dt = ct % 6;
#pragma unroll
        for (int tt = 0; tt < 4; ++tt) { const int tk = 16 * tt + fr; f32x4 v = acc[tt];
            if (dt >= 4 && lat) { const int seg = dt - 4, half = fq >> 1;
#pragma unroll
                for (int j = 0; j < 4; ++j) { const float pa = __shfl_xor(v[j], 32); float cs, sn; rope_cs_tab(rt, tl0 + tk, seg, 4 * (fq & 1) + j, cs, sn);
                    v[j] = half ? (pa * sn + v[j] * cs) : (v[j] * cs - pa * sn); } }
            u32x2 o; o.x = pk2(v[0] * qs, v[1] * qs); o.y = pk2(v[2] * qs, v[3] * qs);
            *(u32x2*)(Qb + ((size_t)(b * 4 + hq) * KEYS + key0 + tk) * 96 + 16 * dt + 4 * fq) = o; }
    }
    for (int ct = w; ct < 40; ct += 8) {
        const int hk = ct / 10, dt = ct % 10;
        f32x4 acc[4];
#pragma unroll
        for (int tt = 0; tt < 4; ++tt) acc[tt] = (f32x4){0.f, 0.f, 0.f, 0.f};
        bf16x8 wa[4];
#pragma unroll
        for (int ks = 0; ks < 4; ++ks) wa[ks] = *(const bf16x8*)(WukvT + (size_t)(16 * ct + fr) * 128 + 32 * ks + 8 * fq);
#pragma unroll
        for (int kh = 0; kh < 2; ++kh) { bf16x8 bb[2][4];
#pragma unroll
            for (int k2 = 0; k2 < 2; ++k2)
#pragma unroll
                for (int tt = 0; tt < 4; ++tt) bb[k2][tt] = *(const bf16x8*)(akv + (16 * tt + fr) * 136 + 32 * (2 * kh + k2) + 8 * fq);
            __builtin_amdgcn_sched_barrier(0);
#pragma unroll
            for (int k2 = 0; k2 < 2; ++k2)
#pragma unroll
                for (int tt = 0; tt < 4; ++tt) acc[tt] = dt < 4 ? MFMA16(wa[2 * kh + k2], bb[k2][tt], acc[tt]) : MFMA16(bb[k2][tt], wa[2 * kh + k2], acc[tt]); }
#pragma unroll
        for (int tt = 0; tt < 4; ++tt) { const f32x4 v = acc[tt]; u32x2 o; o.x = pk2(v[0], v[1]); o.y = pk2(v[2], v[3]);
            if (dt < 4) *(u32x2*)(Kb + ((size_t)(b * 4 + hk) * KEYS + key0 + 16 * tt + fr) * 96 + 16 * dt + 4 * fq) = o;
            else *(u32x2*)(Vt + ((size_t)(b * 4 + hk) * 96 + 16 * (dt - 4) + fr) * KEYS + key0 + 32 * (tt >> 1) + 8 * fq + 4 * (tt & 1)) = o; }
    }
    __syncthreads();
}

template <int VAR>
__device__ __forceinline__ void attn_item(const KP& p, int item, unsigned char* shm) {
    const int tid = ltid(), w = tid >> 6, lane = tid & 63, fr = lane & 15, fq = lane >> 4;
    const int qb = item < 256 ? (item & 7) : 8, bh = item < 256 ? (item >> 3) : item - 256, b = bh >> 2, h = bh & 3;
    const int kbeg = qb < 8 ? 0 : SEQ, ntile = qb < 8 ? KEYS / 64 : CL / 64;
    const bf16_t* Qb = (const bf16_t*)(p.ws + WS_QB) + (size_t)bh * KEYS * 96;
    const bf16_t* Kb = (const bf16_t*)(p.ws + WS_KB) + (size_t)bh * KEYS * 96;
    const bf16_t* Vt = (const bf16_t*)(p.ws + WS_VT) + (size_t)bh * 96 * KEYS;
    const int q0 = qb * 256 + 32 * w;
    bf16x8 qf[2][3];
#pragma unroll
    for (int qt = 0; qt < 2; ++qt)
#pragma unroll
        for (int ks = 0; ks < 3; ++ks) qf[qt][ks] = *(const bf16x8*)(Qb + (size_t)(q0 + 16 * qt + fr) * 96 + 32 * ks + 8 * fq);
    f32x4 O[6][2];
#pragma unroll
    for (int dt = 0; dt < 6; ++dt) { O[dt][0] = (f32x4){0.f, 0.f, 0.f, 0.f}; O[dt][1] = (f32x4){0.f, 0.f, 0.f, 0.f}; }
    float mrow[2] = {-1e30f, -1e30f}, lrow[2] = {0.f, 0.f};
    u32x4 pre[6];
    constexpr int ABUF = (64 * 104 + 96 * 72) * 2;
    auto gload = [&](int kp) {
#pragma unroll
        for (int sub = 0; sub < 2; ++sub) { const int key0 = kbeg + (2 * kp + sub) * 64;
#pragma unroll
            for (int i = 0; i < 3; ++i) { const int c = tid + 512 * i;
                if (c < 768) pre[3 * sub + i] = *(const u32x4*)(Kb + (size_t)key0 * 96 + c * 8);
                else { const int cc = c - 768, dv = cc >> 3, part = cc & 7; pre[3 * sub + i] = *(const u32x4*)(Vt + (size_t)dv * KEYS + key0 + part * 8); } } }
    };
    auto lstore = [&](int buf) {
#pragma unroll
        for (int sub = 0; sub < 2; ++sub) { bf16_t* Kw = (bf16_t*)(shm + (2 * buf + sub) * ABUF); bf16_t* Vw = Kw + 64 * 104;
#pragma unroll
            for (int i = 0; i < 3; ++i) { const int c = tid + 512 * i;
                if (c < 768) { const int key = c / 12, part = c % 12; *(u32x4*)(Kw + key * 104 + part * 8) = pre[3 * sub + i]; }
                else { const int cc = c - 768, dv = cc >> 3, part = cc & 7; *(u32x4*)(Vw + dv * 72 + part * 8) = pre[3 * sub + i]; } } }
    };
    const int npair = ntile >> 1;
    gload(0);
    lstore(0);
    __syncthreads();
    if (npair > 1) gload(1);
    for (int kp = 0; kp < npair; ++kp) {
#pragma unroll
      for (int sub = 0; sub < 2; ++sub) {
        const bf16_t* Kc = (const bf16_t*)(shm + (2 * (kp & 1) + sub) * ABUF); const bf16_t* Vc = Kc + 64 * 104;
        bf16x8 kf[4][3];
#pragma unroll
        for (int kk = 0; kk < 4; ++kk)
#pragma unroll
            for (int ks = 0; ks < 3; ++ks) kf[kk][ks] = *(const bf16x8*)(Kc + (16 * kk + fr) * 104 + 32 * ks + 8 * fq);
        __builtin_amdgcn_sched_barrier(0);
        f32x4 S[4][2];
#pragma unroll
        for (int kk = 0; kk < 4; ++kk) { S[kk][0] = (f32x4){0.f, 0.f, 0.f, 0.f}; S[kk][1] = (f32x4){0.f, 0.f, 0.f, 0.f}; }
        bf16x8 P[2][2];
        auto softmax_qt = [&](const int qt) {
            float mx = S[0][qt][0];
#pragma unroll
            for (int kk = 0; kk < 4; ++kk)
#pragma unroll
                for (int j = 0; j < 4; ++j) mx = fmaxf(mx, S[kk][qt][j]);
            mx = max_over_fq(mx);
            if (__any(mx > mrow[qt] + 8.f)) {
                const float mnew = fmaxf(mrow[qt], mx), alpha = __builtin_amdgcn_exp2f(mrow[qt] - mnew); mrow[qt] = mnew;
                lrow[qt] *= alpha;
#pragma unroll
                for (int dt = 0; dt < 6; ++dt) O[dt][qt] *= alpha;
            }
            const float mn = mrow[qt];
            float ps = 0.f; unsigned pk[8];
#pragma unroll
            for (int kk = 0; kk < 4; ++kk) { const float e0 = __builtin_amdgcn_exp2f(S[kk][qt][0] - mn), e1 = __builtin_amdgcn_exp2f(S[kk][qt][1] - mn), e2 = __builtin_amdgcn_exp2f(S[kk][qt][2] - mn), e3 = __builtin_amdgcn_exp2f(S[kk][qt][3] - mn);
                ps += (e0 + e1) + (e2 + e3); pk[2 * kk] = pk2(e0, e1); pk[2 * kk + 1] = pk2(e2, e3); }
            lrow[qt] += ps;
            u32x4 t0 = {pk[0], pk[1], pk[2], pk[3]}, t1 = {pk[4], pk[5], pk[6], pk[7]};
            P[qt][0] = __builtin_bit_cast(bf16x8, t0); P[qt][1] = __builtin_bit_cast(bf16x8, t1);
        };
#pragma unroll
        for (int ks = 0; ks < 3; ++ks)
#pragma unroll
            for (int kk = 0; kk < 4; ++kk) S[kk][0] = MFMA16(kf[kk][ks], qf[0][ks], S[kk][0]);
        __builtin_amdgcn_sched_barrier(0);
#pragma unroll
        for (int ks = 0; ks < 3; ++ks)
#pragma unroll
            for (int kk = 0; kk < 4; ++kk) S[kk][1] = MFMA16(kf[kk][ks], qf[1][ks], S[kk][1]);
        softmax_qt(0);
        __builtin_amdgcn_sched_barrier(0);
        bf16x8 vf[6][2];
#pragma unroll
        for (int dt = 0; dt < 6; ++dt)
#pragma unroll
            for (int k2 = 0; k2 < 2; ++k2) vf[dt][k2] = *(const bf16x8*)(Vc + (16 * dt + fr) * 72 + 32 * k2 + 8 * fq);
        __builtin_amdgcn_sched_barrier(0);
#pragma unroll
        for (int dt = 0; dt < 6; ++dt)
#pragma unroll
            for (int k2 = 0; k2 < 2; ++k2) O[dt][0] = MFMA16(vf[dt][k2], P[0][k2], O[dt][0]);
        softmax_qt(1);
        __builtin_amdgcn_sched_barrier(0);
#pragma unroll
        for (int dt = 0; dt < 6; ++dt)
#pragma unroll
            for (int k2 = 0; k2 < 2; ++k2) O[dt][1] = MFMA16(vf[dt][k2], P[1][k2], O[dt][1]);
      }
        if (kp + 1 < npair) lstore((kp + 1) & 1);
        __syncthreads();
        if (kp + 2 < npair) gload(kp + 2);
    }
    bf16_t* mix = (bf16_t*)(p.ws + WS_MIX);
#pragma unroll
    for (int qt = 0; qt < 2; ++qt) { float lt = lrow[qt]; lt += __shfl_xor(lt, 16); lt += __shfl_xor(lt, 32); const float inv = 1.f / lt;
        const int q = q0 + 16 * qt + fr; const size_t row = q < SEQ ? (size_t)b * SEQ + q : (size_t)TL + b * CL + (q - SEQ);
#pragma unroll
        for (int dt = 0; dt < 6; ++dt) { const f32x4 v = O[dt][qt] * inv; u32x2 o; o.x = pk2(v[0], v[1]); o.y = pk2(v[2], v[3]);
            *(u32x2*)(mix + row * D + 640 + h * 96 + 16 * dt + 4 * fq) = o; } }
    __syncthreads();
}


#ifdef DIAG
__device__ __forceinline__ float block_max(float v, float* red) {
    const int tid = ltid();
#pragma unroll
    for (int o = 1; o < 64; o <<= 1) v = fmaxf(v, __shfl_xor(v, o));
    __syncthreads(); if ((tid & 63) == 0) red[tid >> 6] = v; __syncthreads();
    float r = red[0];
#pragma unroll
    for (int i = 1; i < 8; ++i) r = fmaxf(r, red[i]);
    __syncthreads(); return r;
}
__device__ __forceinline__ float block_sum(float v, float* red) {
    const int tid = ltid();
    v = wave_sum(v);
    __syncthreads(); if ((tid & 63) == 0) red[tid >> 6] = v; __syncthreads();
    float r = 0.f;
#pragma unroll
    for (int i = 0; i < 8; ++i) r += red[i];
    __syncthreads(); return r;
}
__device__ __forceinline__ float dg_conv(const KP& p, int l, int rbase, int slen, int t, int chg) {
    const bf16_t* proj = (const bf16_t*)(p.ws + WS_PROJ); float a = 0.f;
    for (int i = 0; i < 5; ++i) { const int tt = t - 2 + i; if (tt < 0 || tt >= slen) continue;
        a += bf2f(proj[(size_t)(rbase + tt) * PW + chg]) * p.in[I_CONV][(size_t)l * 5 * 768 + i * 768 + chg]; }
    return siluf(a);
}
__device__ __forceinline__ float diag_mlstm(const KP& p, int l, int b, int h, int tsel, unsigned char* shm) {
    const int tid = ltid();
    float* Ff = (float*)shm; float* Gb = Ff + 2304; float* If = Gb + 2304; float* Ib = If + 2304; float* Wf = Ib + 2304; float* Wb = Wf + 2304; float* qt = Wb + 2304; float* red = qt + 96; float* yr = red + 16;
    const float* gates = (const float*)(p.ws + WS_GATES); const float* bg = p.in[I_BG] + l * 16;
    const bf16_t* proj = (const bf16_t*)(p.ws + WS_PROJ);
    for (int pos = tid; pos < 2304; pos += 512) { const int row = pos < 256 ? TL + b * CL + pos : b * SEQ + (pos - 256); const float* gp = gates + (size_t)row * 16;
        const int pb = pos < 256 ? 2048 + pos : pos - 256;
        If[pos] = gp[h] + bg[h]; Ff[pos] = logsig(gp[4 + h] + bg[4 + h]); Ib[pb] = gp[8 + h] + bg[8 + h]; Gb[pb] = logsig(gp[12 + h] + bg[12 + h]); }
    __syncthreads();
    if (tid == 0) { float a = 0.f; for (int i = 0; i < 2304; ++i) { a += Ff[i]; Ff[i] = a; } a = 0.f; for (int i = 2303; i >= 0; --i) { a += Gb[i]; Gb[i] = a; } }
    if (tid < 96) qt[tid] = dg_conv(p, l, b * SEQ, SEQ, tsel, h * 96 + tid) * 0.10206207261596577f;
    __syncthreads();
    const int tf = 256 + tsel, tb = tsel;
    for (int pos = tid; pos < 2304; pos += 512) { const bool isc = pos < 256; const int rbase = isc ? TL + b * CL : b * SEQ, slen = isc ? CL : SEQ, t = isc ? pos : pos - 256;
        float dot = 0.f; for (int d = 0; d < 96; ++d) dot += qt[d] * dg_conv(p, l, rbase, slen, t, 384 + h * 96 + d);
        const int pb = isc ? 2048 + pos : pos - 256;
        Wf[pos] = pos <= tf ? dot * __expf(Ff[tf] - Ff[pos] + If[pos]) : 0.f;
        Wb[pos] = pb >= tb ? dot * __expf(Gb[tb] - Gb[pb] + Ib[pb]) : 0.f; }
    __syncthreads();
    float hv = 0.f;
    if (tid < 96) { float nf = 0.f, nb = 0.f, df = 0.f, db = 0.f;
        for (int pos = 0; pos < 2304; ++pos) { const int row = pos < 256 ? TL + b * CL + pos : b * SEQ + (pos - 256); const float v = bf2f(proj[(size_t)row * PW + C_MV + h * 96 + tid]);
            nf += Wf[pos] * v; nb += Wb[pos] * v; df += Wf[pos]; db += Wb[pos]; }
        hv = nf / fmaxf(fabsf(df), 1.f) + nb / fmaxf(fabsf(db), 1.f); }
    const float ss = block_sum(tid < 96 ? hv * hv : 0.f, red);
    float diff = 0.f;
    if (tid < 96) { const int row = b * SEQ + tsel; const float mo = bf2f(proj[(size_t)row * PW + C_MO + h * 96 + tid]);
        const float y = hv * rsqrtf(ss * (1.f / 96.f) + EPS) * p.in[I_GM][l * 384 + h * 96 + tid] / (1.f + __expf(-mo));
        const float yf = bf2f(((const bf16_t*)(p.ws + WS_MIX))[(size_t)row * D + 256 + h * 96 + tid]);
        diff = fabsf(y - yf); }
    return block_max(diff, red);
}
__device__ __forceinline__ float diag_attn(const KP& p, int l, int b, int h, int qsel, unsigned char* shm) {
    const int tid = ltid();
    float* sc = (float*)shm; float* qv = sc + 2304; float* red = qv + 96; float* nq = red + 16;
    float* Vs = (float*)(p.ws + WS_HID + 100000000);
    const bf16_t* proj = (const bf16_t*)(p.ws + WS_PROJ);
    const float* wuq = p.in[I_WUQ] + (size_t)l * 256 * 384; const float* wukv = p.in[I_WUKV] + (size_t)l * 128 * 640;
    const int qrow = b * SEQ + qsel;
    { float v = tid < 256 ? bf2f(proj[(size_t)qrow * PW + C_CQ + tid]) : 0.f; const float ss = block_sum(v * v, red);
      if (tid < 256) nq[tid] = v * rsqrtf(ss * (1.f / 256.f) + EPS) * p.in[I_GQN][l * 256 + tid]; }
    __syncthreads();
    if (tid < 96) { float a = 0.f; for (int k = 0; k < 256; ++k) a += nq[k] * wuq[(size_t)k * 384 + h * 96 + tid]; qv[tid] = a; }
    __syncthreads();
    if (tid < 16) {
        const int seg = tid >> 3, f = tid & 7; float cs, sn; rope_cs(qsel, seg, f, cs, sn);
        const float x1 = qv[64 + seg * 16 + f], x2 = qv[64 + seg * 16 + 8 + f]; qv[64 + seg * 16 + f] = x1 * cs - x2 * sn; qv[64 + seg * 16 + 8 + f] = x1 * sn + x2 * cs; }
    __syncthreads();
    for (int key = tid; key < 2304; key += 512) { const bool lat = key < SEQ; const int row = lat ? b * SEQ + key : TL + b * CL + (key - SEQ);
        const bf16_t* pr = proj + (size_t)row * PW;
        float ss = 0.f; for (int k = 0; k < 128; ++k) { const float v = bf2f(pr[C_CKV + k]); ss += v * v; }
        const float rk = rsqrtf(ss * (1.f / 128.f) + EPS);
        float s = 0.f;
        for (int c = 0; c < 160; ++c) { float a = 0.f; for (int k = 0; k < 128; ++k) a += bf2f(pr[C_CKV + k]) * rk * p.in[I_GKVN][l * 128 + k] * wukv[(size_t)k * 640 + h * 160 + c];
            if (c < 64) s += qv[c] * a; else Vs[(size_t)key * 96 + (c - 64)] = a; }
        for (int seg = 0; seg < 2; ++seg) for (int f = 0; f < 8; ++f) { float x1 = bf2f(pr[C_KR + seg * 16 + f]), x2 = bf2f(pr[C_KR + seg * 16 + 8 + f]);
            if (lat) { float cs, sn; rope_cs(key, seg, f, cs, sn); const float o1 = x1 * cs - x2 * sn, o2 = x1 * sn + x2 * cs; x1 = o1; x2 = o2; }
            s += qv[64 + seg * 16 + f] * x1 + qv[64 + seg * 16 + 8 + f] * x2; }
        sc[key] = s * 0.10206207261596577f; }
    __syncthreads();
    float mx = -1e30f; for (int key = tid; key < 2304; key += 512) mx = fmaxf(mx, sc[key]); mx = block_max(mx, red);
    float sm = 0.f; for (int key = tid; key < 2304; key += 512) { const float e = __expf(sc[key] - mx); sc[key] = e; sm += e; } sm = block_sum(sm, red);
    __threadfence(); __syncthreads();
    float diff = 0.f;
    if (tid < 96) { float a = 0.f; for (int key = 0; key < 2304; ++key) a += sc[key] * Vs[(size_t)key * 96 + tid]; a /= sm;
        const float yf = bf2f(((const bf16_t*)(p.ws + WS_MIX))[(size_t)qrow * D + 640 + h * 96 + tid]); diff = fabsf(a - yf); }
    return block_max(diff, red);
}

__device__ __forceinline__ float diag_fourier(const KP& p, int b, int g, unsigned char* shm) {
    const int tid = ltid();
    float* hrow = (float*)shm; float* red = hrow + 1024;
    float* pf = (float*)(p.ws + WS_HID + 100000000);
    const float* mod = (const float*)(p.ws + WS_MOD) + (size_t)b * 6144;
    for (int n = 0; n < 2048; ++n) {
        const float* xr = p.in[I_X] + ((size_t)b * SEQ + n) * D;
        const float x0 = xr[tid], x1 = xr[tid + 512];
        const float ss = block_sum(x0 * x0 + x1 * x1, red); const float rstd = rsqrtf(ss * (1.f / D) + EPS);
        hrow[tid] = x0 * rstd * p.in[I_G1][tid] * (1.f + mod[1024 + tid]) + mod[tid];
        hrow[tid + 512] = x1 * rstd * p.in[I_G1][tid + 512] * (1.f + mod[1024 + tid + 512]) + mod[tid + 512];
        __syncthreads();
        { const int c = tid & 63, ks = tid >> 6; float a = 0.f;
          for (int k = ks * 128; k < ks * 128 + 128; ++k) a += hrow[k] * p.in[I_WIN][(size_t)k * 2224 + g * 64 + c];
          red[16 + ks * 64 + c] = a; }
        __syncthreads();
        if (tid < 64) { float a = 0.f; for (int q = 0; q < 8; ++q) a += red[16 + q * 64 + tid]; pf[n * 64 + tid] = a; }
        __syncthreads();
    }
    __threadfence(); __syncthreads();
    float worst = 0.f;
#pragma unroll 1
    for (int i = 0; i < 6; ++i) { const int k = i == 0 ? 0 : i == 1 ? 1 : i == 2 ? 5 : i == 3 ? 1000 : i == 4 ? 1024 : 2047;
        const int cp = tid & 63, ns = tid >> 6; float a = 0.f;
        for (int n = ns * 256; n < ns * 256 + 256; ++n) for (int c = 0; c < 64; ++c) { const int idx = (k * n + 32 * c * cp) & 2047; a += pf[n * 64 + c] * cospif((float)idx * (1.f / 1024.f)); }
        __syncthreads(); red[16 + ns * 64 + cp] = a; __syncthreads();
        float diff = 0.f;
        if (tid < 64) { float y = 0.f; for (int q = 0; q < 8; ++q) y += red[16 + q * 64 + tid]; y *= 0.00276213586400995f;
            const float yf = bf2f(((const bf16_t*)(p.ws + WS_MIX))[((size_t)b * SEQ + k) * D + g * 64 + tid]); diff = fabsf(y - yf); }
        worst = fmaxf(worst, block_max(diff, red));
    }
    return worst;
}

__device__ __forceinline__ int dg_row(int i) { return i == 0 ? 0 : i == 1 ? 1 : i == 2 ? 255 : i == 3 ? 256 : i == 4 ? 5000 : i == 5 ? 16383 : i == 6 ? 16384 : 18431; }
__device__ __forceinline__ float diag_g2(const KP& p, int i, unsigned char* shm) {
    const int tid = ltid(); float* red = (float*)shm;
    const int r = dg_row(i), b = r < TL ? r >> 11 : 8;
    const bf16_t* mr = (const bf16_t*)(p.ws + WS_MIX) + (size_t)r * D;
    const float* xo = r < TL ? p.in[I_X] + (size_t)r * D : p.in[I_CTX] + (size_t)(r - TL) * D;
    const float* xn = r < TL ? p.out + (size_t)r * D : (const float*)(p.ws + WS_XCTX) + (size_t)(r - TL) * D;
    const float* mod = (const float*)(p.ws + WS_MOD);
    float diff = 0.f;
    for (int c = tid; c < 1024; c += 512) { float a = 0.f; for (int j = 0; j < 1024; ++j) a += bf2f(mr[j]) * p.in[I_WOUT][(size_t)j * 1024 + c];
        diff = fmaxf(diff, fabsf(xo[c] + mod[(size_t)b * 6144 + 2048 + c] * a - xn[c])); }
#ifdef DIAG_MODONLY
    diff = 0.f;
#endif
#ifndef DIAG_G2ONLY
    { const int l = i & 1, j = (37 * tid + 11 * i) % 6144; float a = 0.f;
      for (int k = 0; k < 1024; ++k) { const float cv = b < 8 ? p.in[I_C][b * 1024 + k] : p.in[I_CCTX][k]; a += siluf(cv) * p.in[I_WMOD][(size_t)l * 1024 * 6144 + (size_t)k * 6144 + j]; }
      a += p.in[I_BMOD][l * 6144 + j]; diff = fmaxf(diff, fabsf(a - mod[(size_t)(l * 9 + b) * 6144 + j])); }
#endif
    return block_max(diff, red);
}
__device__ __forceinline__ float diag_g3(const KP& p, int i, unsigned char* shm) {
    const int tid = ltid(); float* red = (float*)shm; float* hr = red + 16;
    const int r = dg_row(i), b = r < TL ? r >> 11 : 8;
    const float* xr = r < TL ? p.out + (size_t)r * D : (const float*)(p.ws + WS_XCTX) + (size_t)(r - TL) * D;
    const float* mod = (const float*)(p.ws + WS_MOD) + (size_t)b * 6144;
    const bf16_t* hb = (const bf16_t*)(p.ws + WS_HBUF) + (size_t)r * D;
    const float x0 = xr[tid], x1 = xr[tid + 512];
    const float ss = block_sum(x0 * x0 + x1 * x1, red); const float rstd = rsqrtf(ss * (1.f / D) + EPS);
    float diff = 0.f;
    { const float h0 = x0 * rstd * p.in[I_G2][tid] * (1.f + mod[4096 + tid]) + mod[3072 + tid], h1 = x1 * rstd * p.in[I_G2][tid + 512] * (1.f + mod[4096 + tid + 512]) + mod[3072 + tid + 512];
      diff = fmaxf(fabsf(h0 - bf2f(hb[tid])), fabsf(h1 - bf2f(hb[tid + 512]))); hr[tid] = bf2f(hb[tid]); hr[tid + 512] = bf2f(hb[tid + 512]); }
    __syncthreads();
    const bf16_t* hid = (const bf16_t*)(p.ws + WS_HID) + (size_t)r * 4096;
    for (int j = tid; j < 4096; j += 512) { float a = 0.f; for (int k = 0; k < 1024; ++k) a += hr[k] * p.in[I_WUP][(size_t)k * 4096 + j];
        a = fmaxf(a, 0.f); a = a * a; diff = fmaxf(diff, fabsf(a - bf2f(hid[j])) / (1.f + fabsf(a))); }
    return block_max(diff, red);
}
#endif


#define XB_TMO      128
#define XB_XCNT(j)  (256  + 64 * (j))
#define XB_XSUB(j)  (1280 + 64 * (j))
#define XB_XGEN(j)  (2304 + 64 * (j))
#define XB_TOP      3328
#define XB_TOPGEN   3392
#define XCD_BAR_WORDS 3456
#define XB_SPIN_CAP (1u << 18)
#define LAS __attribute__((address_space(3)))
__device__ __forceinline__ unsigned xb_ld(unsigned* p)              { return __hip_atomic_load(p, __ATOMIC_RELAXED, __HIP_MEMORY_SCOPE_AGENT); }
__device__ __forceinline__ unsigned xb_add(unsigned* p, unsigned v) { return __hip_atomic_fetch_add(p, v, __ATOMIC_RELAXED, __HIP_MEMORY_SCOPE_AGENT); }
__device__ __forceinline__ unsigned xb_xcc_id() { return (unsigned)__builtin_amdgcn_s_getreg((3 << 11) | 20) & 0xFu; }
#define XB_SPIN(cond, bar) do { unsigned _sp = 0; while (cond) { __builtin_amdgcn_s_sleep(1); \
    if ((++_sp & 255u) == 0u) { if (xb_ld(&(bar)[XB_TMO])) break; if (_sp > XB_SPIN_CAP) { atomicAdd(&(bar)[XB_TMO], 1u); break; } } } } while (0)
struct XcdBarrier { unsigned* bar; unsigned x; volatile LAS unsigned* st; };
__device__ __forceinline__ XcdBarrier xcd_barrier_post(unsigned* bar, volatile LAS unsigned* st) {
    XcdBarrier b; b.bar = bar; b.x = xb_xcc_id(); b.st = st;
    if (threadIdx.x == 0) (void)xb_add(&bar[XB_XCNT(b.x)], 1u);
    return b;
}
__device__ __forceinline__ void xcd_barrier_complete(unsigned* bar, unsigned x, unsigned& nloc, unsigned& nx) {
    const unsigned G = gridDim.x * gridDim.y * gridDim.z;
    unsigned sum, cnt, mine, sp = 0u;
    for (;;) {
        sum = 0u; cnt = 0u; mine = 0u;
#pragma unroll
        for (unsigned j = 0; j < 16; ++j) { const unsigned c = xb_ld(&bar[XB_XCNT(j)]); sum += c; cnt += (c > 0u) ? 1u : 0u; mine = (j == x) ? c : mine; }
        if (sum == G) break;
        __builtin_amdgcn_s_sleep(1);
        if ((++sp & 255u) == 0u) { if (xb_ld(&bar[XB_TMO])) break; if (sp > XB_SPIN_CAP) { atomicAdd(&bar[XB_TMO], 1u); break; } }
    }
    nloc = mine > 0u ? mine : 1u; nx = cnt > 0u ? cnt : 1u;
}
__device__ __forceinline__ void xcd_barrier(const XcdBarrier& b) {
    asm volatile("s_waitcnt vmcnt(0)" ::: "memory");
    __syncthreads();
    if (threadIdx.x == 0) {
        unsigned* bar = b.bar;
        __builtin_amdgcn_s_waitcnt(0);
        unsigned nloc = b.st[0], nx = b.st[1];
        if (nloc == 0u) { xcd_barrier_complete(bar, b.x, nloc, nx); b.st[0] = nloc; b.st[1] = nx; }
        const unsigned old = xb_add(&bar[XB_XSUB(b.x)], 1u);
        const unsigned gen = old / nloc;
        if (old + 1u == (gen + 1u) * nloc) {
            __builtin_amdgcn_fence(__ATOMIC_RELEASE, "agent");
            asm volatile("s_waitcnt vmcnt(0)" ::: "memory");
            const unsigned og = xb_add(&bar[XB_TOP], 1u);
            const unsigned tg = og / nx;
            if (og + 1u == (tg + 1u) * nx) xb_add(&bar[XB_TOPGEN], 1u);
            else XB_SPIN(xb_ld(&bar[XB_TOPGEN]) == tg, bar);
            __builtin_amdgcn_fence(__ATOMIC_ACQUIRE, "agent");
            xb_add(&bar[XB_XGEN(b.x)], 1u);
            asm volatile("s_waitcnt vmcnt(0)" ::: "memory");
        } else {
            XB_SPIN(xb_ld(&bar[XB_XGEN(b.x)]) == gen, bar);
            __builtin_amdgcn_fence(__ATOMIC_ACQUIRE, "agent");
            asm volatile("s_waitcnt vmcnt(0)" ::: "memory");
        }
    }
    __syncthreads();
}

__device__ __attribute__((noinline)) void grid_sync_fn() { cg::this_grid().sync(); }
__global__ __launch_bounds__(512, 2) void mega(KP p) {
    extern __shared__ __attribute__((aligned(16))) unsigned char shm[];
    volatile LAS unsigned* xst = (volatile LAS unsigned*)(LAS unsigned char*)(shm + LDS_BYTES - 16);
    if (threadIdx.x == 0) { xst[0] = 0u; xst[1] = 0u; }
    __syncthreads();
    if (p.ph_lo < 0) grid_sync_fn();
    const XcdBarrier xbar = xcd_barrier_post((unsigned*)(p.ws + WS_BAR), xst);
    for (int s = p.ph_lo; s < p.ph_hi; ++s) {
      if (s == 16) continue;
      const int nrep = (s >= 1 && s < 19 && ((REPMASK >> ((s - 1) % 9)) & 1)) ? 2 : 1;
      for (int rep = 0; rep < nrep; ++rep) {
        const int G = gridDim.x, bid = lbid();
        unsigned char* ws = p.ws; asm volatile("" : "+s"(ws));
        float* outp = p.out; asm volatile("" : "+s"(outp));
        if (s == 0) { if (PHMASK & 512) step_prep0(p, shm);
#ifdef REP_PREP
            xcd_barrier(xbar); step_prep0(p, shm);
#endif
        }
        else if (s == 19) { if (PHMASK & 1024) step_final(p); }
        else {
            const int l = (s - 1) / 9, ph = (s - 1) % 9; const bool last = l == 1;
            const float* modl = (const float*)(ws + WS_MOD) + (size_t)l * 9 * 6144;
            const float* xl = l == 0 ? p.in[I_X] : outp; const float* xc = l == 0 ? p.in[I_CTX] : (const float*)(ws + WS_XCTX);
            const int Mrows = last ? TL : TT;
            if (ph == 0) {
                if (PHMASK & 1) {
                if (l == 1) { float* tab = (float*)shm; prep_weights(p, 1, shm, tab, 2); }
                norm_rows(xl, xc, TT, p.in[I_G1] + l * D, modl, 0, 1024, (bf16_t*)(ws + WS_HBUF), l == 1 ? (const bf16_t*)(ws + WS_PART) : nullptr, (const float*)(ws + WS_MOD) + 8 * 6144 + 5120, nullptr, l == 1 ? TL : 0); }
            } else if (ph == 1) {
                if (PHMASK & 2) {
                EpiIn E; E.proj = (bf16_t*)(ws + WS_PROJ); E.gates = (float*)(ws + WS_GATES); E.zt = (bf16_t*)(ws + WS_ZT); E.ztc = (bf16_t*)(ws + WS_ZTC);
                run_gemm(shm, (const bf16_t*)(ws + WS_HBUF), (const bf16_t*)(ws + WS_WIN), TT, NIN, 1024, G, bid, E); }
            } else if (ph == 2) {
                if (PHMASK & 4) {
                    for (int it = bid; it < 32 * NCH + TT / 64; it += G) { if (it < 32 * NCH) mlstm_a_item(p, l, it, shm); else qkv_item(p, l, it - 32 * NCH, shm); }
                    {
                        const int nlong = (32 * NCH + TT / 64) % G, f0 = bid >= nlong ? bid - nlong : -1, fs = G - nlong;
                        if (f0 >= 0) for (int f = f0; f < 256; f += fs) zt_fold_item(p, f, shm);
                        __syncthreads(); }
                }
            } else if (ph == 3 || ph == 4) {
                if (PHMASK & 8) {
                const int nF = 64;
                if (ph == 3) mlstm_scan(p);
                {
                    int a0, a1, ast;
                    if (ph == 3) { a0 = bid; a1 = 256; ast = G; } else { a0 = (!last && bid >= nF + 8) ? 256 + (bid - nF - 8) : (1 << 30); a1 = 288; ast = G - nF - 8; }
                    for (int it = a0; it < a1; it += ast) {
                        const int item = it < 256 ? (((it & 7) * 4 + (it >> 6)) << 3) + ((it >> 3) & 7) : it;
                        attn_item<0>(p, item, shm); } }
                if (ph == 4) {
                if (bid < nF) {
                    for (int pass = 0; pass < (last ? 1 : 2); ++pass) {
                        const bool fl = pass == 0;
                        if (!fl && bid >= 8) break;
                        EpiFou E; E.mix = (bf16_t*)(ws + WS_MIX); E.rows_per_b = fl ? SEQ : CL; E.row_off = fl ? 0 : TL; E.scale = fl ? 0.00276213586400995f : 0.0078125f;
                        run_gemm(shm, (const bf16_t*)(ws + (fl ? WS_FDFT : WS_FDFTC)), (const bf16_t*)(ws + (fl ? WS_ZTF : WS_ZTC)), fl ? 2048 : 256, 2048, fl ? 2048 : 512, G, bid, E);
                    }
                } else {
                    const int vb = bid - nF, nb = G - nF, per = last ? 16 : NCH, nit = 32 * per;
                    for (int it = vb; it < nit; it += nb) { const int bh = it / per, jc = (last ? 2 : 0) + it % per; mlstm_c_item(p, l, bh >> 2, bh & 3, jc, shm); }
                } } }
            } else if (ph == 6) {
                if (PHMASK & 64) norm_rows(outp, l == 0 ? p.in[I_CTX] : (const float*)(ws + WS_XCTX), Mrows, p.in[I_G2] + l * D, modl, 3072, 4096, (bf16_t*)(ws + WS_HBUF),
                                           l == 0 ? (const bf16_t*)(ws + WS_PART) : nullptr, modl + 8 * 6144 + 2048, (float*)(ws + WS_XCTX), TL);
            } else if (ph == 7) {
                if (PHMASK & 128) {
                EpiUp E; E.hid = (bf16_t*)(ws + WS_HID);
                run_gemm(shm, (const bf16_t*)(ws + WS_HBUF), (const bf16_t*)(ws + WS_WUP), Mrows, 4096, 1024, G, bid, E); }
            } else {
                if (PHMASK & 32) {
                const bool g2 = ph == 5;
                {
                    const float* mod1 = (const float*)(ws + WS_MOD) + (size_t)9 * 6144;
                    EpiResNorm E; E.xo = g2 ? xl : outp; E.xn = outp; E.ga = modl + (g2 ? 2048 : 5120);
                    E.rss = (float*)(ws + WS_RSS) + (size_t)(2 * l + (g2 ? 0 : 1)) * TL; E.cnt = (unsigned*)(ws + WS_RCNT) + (2 * l + (g2 ? 0 : 1)) * 64 * 64;
                    E.mode = (!g2 && last) ? 1 : 0;
                    E.g = g2 ? p.in[I_G2] + l * D : (last ? p.in[I_GFIN] : p.in[I_G1] + D);
                    E.sc = g2 ? modl + 4096 : mod1 + 1024; E.sh = g2 ? modl + 3072 : mod1; E.hb = (bf16_t*)(ws + WS_HBUF);
                    pg8::Gemm gm; gm.A = (const bf16_t*)(ws + (g2 ? WS_MIX : WS_HID)); gm.Bt = (const bf16_t*)(ws + (g2 ? WS_WOUT : WS_WDOWN)); gm.M = TL; gm.N = 1024; gm.K = g2 ? 1024 : 4096; gm.ld = gm.K;
                    pg8::StaticOrder S; S.init(TL, 1024, G, bid);
                    pg8::gemm_phase<EpiResNorm, pg8::StaticOrder, false>((PG8_LAS unsigned char*)shm, gm, S, E, nullptr); }
                if (!last && !g2 && bid >= 128) { float* tab = (float*)shm; build_costab(tab); prep_weights(p, 1, shm, tab, 1, 128, G - 128); }
                if (!last) for (int su = bid; su < 128; su += G) {
                    const int ks = su >> 5, ui = su & 31, ld = g2 ? 1024 : 4096, Ks = ld >> 2;
                    EpiPart E; E.part = (bf16_t*)(ws + WS_PART) + (size_t)ks * TC * D;
                    run_gemm_ctx_split(shm, (const bf16_t*)(ws + (g2 ? WS_MIX : WS_HID)) + (size_t)TL * ld + ks * Ks, (const bf16_t*)(ws + (g2 ? WS_WOUT : WS_WDOWN)) + ks * Ks, Ks, ld, ui >> 2, ui & 3, E); }
                }
            }
        }
        if (s + 1 < p.ph_hi || rep + 1 < nrep) xcd_barrier(xbar);
      }
    }
#ifdef EXTRA_SYNCS
    for (int i = 0; i < EXTRA_SYNCS; ++i) xcd_barrier(xbar);
#endif
#ifdef DIAG
    grid_sync_fn();
    if (blockIdx.x == 0) {
        float worst = 0.f;
#pragma unroll 1
        for (int i = 0; i < 8; ++i) {
            const int tk = i == 0 ? 0 : i == 1 ? 1 : i == 2 ? 127 : i == 3 ? 128 : i == 4 ? 129 : i == 5 ? 1000 : i == 6 ? 2046 : 2047;
#if DIAG == 1
            const float d = diag_mlstm(p, 0, 3, 2, tk, shm);
#elif DIAG == 2
            const float d = diag_attn(p, 0, 3, 2, tk, shm);
#elif DIAG == 3
            const float d = i == 0 ? diag_fourier(p, 3, 2, shm) : 0.f;
#elif DIAG == 4
            const float d = fmaxf(diag_mlstm(p, 1, 5, 1, tk, shm), diag_attn(p, 1, 5, 1, tk, shm));
#elif DIAG == 5
            const float d = diag_g2(p, i, shm);
#else
            const float d = diag_g3(p, i, shm);
#endif
#ifdef DIAG_TOK
            if (i == DIAG_TOK) worst = d;
#else
            worst = fmaxf(worst, d);
#endif
        }
        if (threadIdx.x == 0) p.out[0] = 1e4f * worst;
    }
#endif
}

extern "C" void kernel_launch(void* const* d_in, const int* in_sizes, int n_in, void* d_out, int out_size, void* d_ws, size_t ws_size, hipStream_t stream) {
    static int grid_blocks = 0;
    if (grid_blocks == 0) {
        if (n_in != 20 || ws_size < WS_NEED) { fprintf(stderr, "kernel_launch: unexpected inputs (n_in %d, ws %zu, need %zu)\n", n_in, ws_size, (size_t)WS_NEED); grid_blocks = -1; return; }
        int dev = 0, cus = 0, per_cu = 0;
        hipGetDevice(&dev);
        hipDeviceGetAttribute(&cus, hipDeviceAttributeMultiprocessorCount, dev);
        hipFuncSetAttribute((const void*)mega, hipFuncAttributeMaxDynamicSharedMemorySize, LDS_BYTES);
        hipOccupancyMaxActiveBlocksPerMultiprocessor(&per_cu, (const void*)mega, 512, LDS_BYTES);
        if (per_cu < 1) per_cu = 1;
        grid_blocks = cus * per_cu;
        if (grid_blocks != 256) { fprintf(stderr, "kernel_launch: this build needs exactly 256 resident workgroups (got %d)\n", grid_blocks); grid_blocks = -1; (void)hipGetLastError(); return; }
        (void)hipGetLastError();
    }
    if (grid_blocks < 0) return;
    KP p{};
    for (int i = 0; i < 20; ++i) p.in[i] = (const float*)d_in[i];
    p.out = (float*)d_out; p.ws = (unsigned char*)d_ws; p.ph_lo = 0; p.ph_hi = 19;
#ifdef DIAG
    p.ph_hi = DIAG == 4 ? 15 : DIAG == 5 ? 7 : DIAG == 6 ? 9 : 6;
#endif
    (void)hipMemsetAsync((unsigned char*)d_ws + WS_BAR, 0, 16384, stream);
    void* args[] = {&p};
    hipError_t e = hipLaunchCooperativeKernel((const void*)mega, dim3(grid_blocks), dim3(512), args, LDS_BYTES, stream);
    if (e != hipSuccess) fprintf(stderr, "cooperative launch failed: %s (grid %d)\n", hipGetErrorString(e), grid_blocks);
}
```

```cpp
#include <hip/hip_runtime.h>
#include <hip/hip_cooperative_groups.h>
#include <cstdio>
namespace cg = cooperative_groups;
namespace pg8 {
#define PG8_LAS __attribute__((address_space(3)))
typedef unsigned short bf16_t;
typedef short bf16x8 __attribute__((ext_vector_type(8)));
typedef float f32x4 __attribute__((ext_vector_type(4)));
typedef unsigned u32x4 __attribute__((ext_vector_type(4)));
constexpr int BM = 256, BK = 64, HALF = 128, HTB = HALF * BK * 2  , STAGE_BYTES = 8 * HTB, NXCD = 8, WGM = 8;

__host__ __device__ __forceinline__ int lds_byte(int r, int c) { const int st = (r >> 4) * 2 + (c >> 5), rr = r & 15, cc = c & 31, ob = rr * 64 + cc * 2; return st * 1024 + (ob ^ (((ob >> 9) & 1) << 5)); }
__host__ __device__ __forceinline__ void stage_rc(int b, int& R, int& C) { const int st = b / 1024, sb = b % 1024, swz = sb ^ (((sb >> 9) & 1) << 5); R = (st >> 1) * 16 + swz / 64; C = (st & 1) * 32 + (swz % 64) / 2; }
__host__ __device__ __forceinline__ int perm32(int rho) { const int n = rho >> 4, i = rho & 15; return 8 * (i >> 2) + 4 * n + (i & 3); }

struct Unit { int pm, pn; };
struct Gemm { const bf16_t* A; const bf16_t* Bt; int M, N, K, ld; };

struct StaticOrder {
    int nM, nN, nwg, G, c;
    __host__ __device__ void init(int M, int N, int G_, int c_) { nM = M / BM; nN = N / BM; nwg = nM * nN; G = G_; c = c_; }
    __host__ __device__ bool next(int i, Unit& u) const {
        const long L = (long)i * G + c; if (L >= nwg) return false;
        int wgid = (int)L; { const int q = nwg / NXCD, r = nwg % NXCD, xcd = wgid % NXCD, off = wgid / NXCD; wgid = (xcd < r ? xcd * (q + 1) : r * (q + 1) + (xcd - r) * q) + off; }
        const int nig = WGM * nN, gid = wgid / nig, fm = gid * WGM, gsz = (nM - fm) < WGM ? (nM - fm) : WGM;
        u.pm = fm + ((wgid % nig) % gsz); u.pn = (wgid % nig) / gsz; return true;
    }
    __device__ __forceinline__ void a_ready(const Unit&) const {}
    __device__ __forceinline__ void done(const Unit&) const {}
};
__device__ __forceinline__ unsigned cvt_pk_bf16(float lo, float hi) { unsigned r; asm volatile("v_cvt_pk_bf16_f32 %0, %1, %2" : "=v"(r) : "v"(lo), "v"(hi)); return r; }
template <class Epi, class Sched, bool STAMP = false>
__device__ __forceinline__ void gemm_phase(PG8_LAS unsigned char* lds, const Gemm g, const Sched& S, const Epi& E, unsigned long long* stamps) {
    int tid_l = threadIdx.x; asm volatile("" : "+v"(tid_l)); const int tid = tid_l, wid = __builtin_amdgcn_readfirstlane(tid >> 6), lane = tid & 63, wr = wid >> 2, wc = wid & 3, fr = lane & 15, fq = lane >> 4;
    const int K = g.K, nt = K / BK, LD = g.ld;
    int ts_lo = 0, ts_hi = 0, nts = 0; const unsigned long long rt_entry = STAMP ? (unsigned long long)wall_clock64() : 0ull;
#define PG8_STAMP() do { if (STAMP && wid == 0 && nts < 64) { const unsigned long long _c = (unsigned long long)clock64(); \
        ts_lo = (lane == nts) ? (int)(unsigned)_c : ts_lo; ts_hi = (lane == nts) ? (int)(unsigned)(_c >> 32) : ts_hi; ++nts; } } while (0)
    PG8_STAMP();
    unsigned voffA[2], voffB[2];
#pragma unroll
    for (int i = 0; i < 2; ++i) { int R, C; stage_rc(tid * 16 + i * 8192, R, C); const int Rb = Epi::PERM ? ((R & ~31) + perm32(R & 31)) : R;
        voffA[i] = (unsigned)(R * LD + C) * 2u; voffB[i] = (unsigned)(Rb * LD + C) * 2u; }
    const size_t kstep = (size_t)(BK * 2);
    const size_t hstep = (size_t)HALF * LD * 2;
    const size_t tstep = 2 * hstep;
    const unsigned ldsw = (unsigned)wid * 1024u;
    const int aoff = lds_byte(wr * 64 + fr, fq * 8), boff = lds_byte(wc * 32 + fr, fq * 8);
#define PG8_SA(b, h) (((b) * 2 + (h)) * HTB)
#define PG8_SB(b, h) ((4 + (b) * 2 + (h)) * HTB)
#define PG8_STAGE(bufoff, gbase, voff) do { _Pragma("unroll") for (int _i = 0; _i < 2; ++_i) \
        __builtin_amdgcn_global_load_lds((const unsigned*)((const char*)(gbase) + (voff)[_i]), (PG8_LAS unsigned*)(lds + (bufoff) + ldsw + _i * 8192), 16, 0, 0); } while (0)
#define PG8_LDA(dst, b, h) do { _Pragma("unroll") for (int m = 0; m < 4; ++m) _Pragma("unroll") for (int k = 0; k < 2; ++k) dst[m][k] = *(const PG8_LAS bf16x8*)(lds + PG8_SA(b, h) + aoff + m * 2048 + k * 1024); } while (0)
#define PG8_LDB(dst, b, h) do { _Pragma("unroll") for (int n = 0; n < 2; ++n) _Pragma("unroll") for (int k = 0; k < 2; ++k) dst[n][k] = *(const PG8_LAS bf16x8*)(lds + PG8_SB(b, h) + boff + n * 2048 + k * 1024); } while (0)
#define PG8_MMA(ai, bj, At, Bt) do { __builtin_amdgcn_s_setprio(1); _Pragma("unroll") for (int m = 0; m < 4; ++m) _Pragma("unroll") for (int n = 0; n < 2; ++n) _Pragma("unroll") for (int k = 0; k < 2; ++k) \
        acc[ai][bj][m][n] = __builtin_amdgcn_mfma_f32_16x16x32_bf16(Bt[n][k], At[m][k], acc[ai][bj][m][n], 0, 0, 0); __builtin_amdgcn_s_setprio(0); } while (0)
#define PG8_WAIT_V(n) asm volatile("s_waitcnt vmcnt(" #n ")" ::: "memory")
#define PG8_WAIT_L(n) asm volatile("s_waitcnt lgkmcnt(" #n ")" ::: "memory")
#define PG8_BAR __builtin_amdgcn_s_barrier()
#define PG8_SCHED __builtin_amdgcn_sched_barrier(0)
    Unit cur, nxt; int ui = 0;
    if (!S.next(0, cur)) return;
    f32x4 acc[2][2][4][2];
#pragma unroll
    for (int a = 0; a < 2; ++a)
#pragma unroll
        for (int b = 0; b < 2; ++b)
#pragma unroll
            for (int m = 0; m < 4; ++m)
#pragma unroll
                for (int n = 0; n < 2; ++n) acc[a][b][m][n] = (f32x4){0.f, 0.f, 0.f, 0.f};
    bf16x8 At[4][2], B0[2][2], B1[2][2];
    const char* cA = (const char*)g.A + (size_t)cur.pm * tstep; const char* cB = (const char*)g.Bt + (size_t)cur.pn * tstep;
    S.a_ready(cur);
    PG8_STAGE(PG8_SB(0, 0), cB, voffB); PG8_STAGE(PG8_SA(0, 0), cA, voffA); PG8_STAGE(PG8_SB(0, 1), cB + hstep, voffB); PG8_STAGE(PG8_SA(0, 1), cA + hstep, voffA);
    if (wr == 1) PG8_BAR;
    PG8_WAIT_V(4); PG8_BAR;
    PG8_STAGE(PG8_SB(1, 0), cB + kstep, voffB); PG8_STAGE(PG8_SA(1, 0), cA + kstep, voffA); PG8_STAGE(PG8_SB(1, 1), cB + hstep + kstep, voffB);
    PG8_WAIT_V(6); PG8_BAR;
    PG8_STAMP();
    for (;;) {
        const bool has_next = S.next(ui + 1, nxt);
        const char* nA = has_next ? (const char*)g.A + (size_t)nxt.pm * tstep : cA; const char* nB = has_next ? (const char*)g.Bt + (size_t)nxt.pn * tstep : cB;
        for (int t = 0; t < nt; t += 2) {
            const bool last = (t == nt - 2);
            const char* a1 = cA + (size_t)(t + 1) * kstep;
            const char* a2 = last ? nA : cA + (size_t)(t + 2) * kstep; const char* b2 = last ? nB : cB + (size_t)(t + 2) * kstep;
            const char* a3 = a2 + kstep; const char* b3 = b2 + kstep;
            if (last && has_next) S.a_ready(nxt);
            PG8_LDB(B0, 0, 0); PG8_SCHED; PG8_LDA(At, 0, 0); PG8_STAGE(PG8_SA(1, 1), a1 + hstep, voffA);
            PG8_WAIT_L(8); PG8_BAR; PG8_WAIT_L(0); PG8_MMA(0, 0, At, B0); PG8_BAR; PG8_SCHED;
            PG8_LDB(B1, 0, 1); PG8_STAGE(PG8_SB(0, 0), b2, voffB);
            PG8_BAR; PG8_WAIT_L(0); PG8_MMA(0, 1, At, B1); PG8_BAR;
            PG8_LDA(At, 0, 1); PG8_STAGE(PG8_SA(0, 0), a2, voffA);
            PG8_BAR; PG8_WAIT_L(0); PG8_MMA(1, 0, At, B0); PG8_BAR; PG8_SCHED;
            PG8_STAGE(PG8_SB(0, 1), b2 + hstep, voffB);
            PG8_WAIT_V(6); PG8_BAR; PG8_MMA(1, 1, At, B1); PG8_BAR;
            PG8_LDB(B0, 1, 0); PG8_SCHED; PG8_LDA(At, 1, 0); PG8_STAGE(PG8_SA(0, 1), a2 + hstep, voffA);
            PG8_WAIT_L(8); PG8_BAR; PG8_WAIT_L(0); PG8_MMA(0, 0, At, B0); PG8_BAR; PG8_SCHED;
            PG8_LDB(B1, 1, 1); PG8_STAGE(PG8_SB(1, 0), b3, voffB);
            PG8_BAR; PG8_WAIT_L(0); PG8_MMA(0, 1, At, B1); PG8_BAR;
            PG8_LDA(At, 1, 1); PG8_STAGE(PG8_SA(1, 0), a3, voffA);
            PG8_BAR; PG8_WAIT_L(0); PG8_MMA(1, 0, At, B0); PG8_BAR; PG8_SCHED;
            PG8_STAGE(PG8_SB(1, 1), b3 + hstep, voffB);
            PG8_WAIT_V(6); PG8_BAR; PG8_MMA(1, 1, At, B1); PG8_BAR;
        }
        PG8_STAMP();
        if constexpr (!Epi::AFTER_DRAIN) { E(acc, cur, wr, wc, fr, fq); S.done(cur); }
        PG8_STAMP();
        if (!has_next) break;
#pragma unroll
        for (int a = 0; a < 2; ++a)
#pragma unroll
            for (int b = 0; b < 2; ++b)
#pragma unroll
                for (int m = 0; m < 4; ++m)
#pragma unroll
                    for (int n = 0; n < 2; ++n) acc[a][b][m][n] = (f32x4){0.f, 0.f, 0.f, 0.f};
        cur = nxt; cA = nA; cB = nB; ++ui;
    }
    PG8_WAIT_V(0);
    if (wr == 0) PG8_BAR;
    PG8_BAR;
    if constexpr (Epi::AFTER_DRAIN) { E.fused(acc, cur, wr, wc, fr, fq, lds, wid, lane); S.done(cur); }
    PG8_STAMP();
    if (STAMP && wid == 0) { stamps[lane] = lane < nts ? (((unsigned long long)(unsigned)ts_hi << 32) | (unsigned)ts_lo) : 0ull;
        if (lane == 62) stamps[62] = rt_entry; if (lane == 63) stamps[63] = (unsigned long long)wall_clock64(); }
#undef PG8_STAMP
#undef PG8_SA
#undef PG8_SB
#undef PG8_STAGE
#undef PG8_LDA
#undef PG8_LDB
#undef PG8_MMA
#undef PG8_WAIT_V
#undef PG8_WAIT_L
#undef PG8_BAR
#undef PG8_SCHED
}
}

using pg8::bf16_t; using pg8::bf16x8; using pg8::f32x4; using pg8::u32x4;
typedef unsigned u32x2 __attribute__((ext_vector_type(2)));
#define MFMA16(a, b, c) __builtin_amdgcn_mfma_f32_16x16x32_bf16((a), (b), (c), 0, 0, 0)

constexpr int D = 1024, NB = 8, SEQ = 2048, CL = 256, TL = NB * SEQ, TC = NB * CL, TT = TL + TC;
constexpr int NIN = 2560;
constexpr int PW = 2048;
constexpr int C_MQ = 0, C_MK = 384, C_MV = 768, C_MO = 1152, C_CQ = 1552, C_CKV = 1808, C_KR = 1936;
constexpr int KEYS = SEQ + CL;
constexpr int LCH = 128, NCH = 18;
constexpr int VC = 112, STSZ = VC * 96;
constexpr int LDS_BYTES = 147456;
constexpr float EPS = 1e-6f;
#ifndef ATT_REP
#define ATT_REP 1
#endif
#ifndef REPMASK
#define REPMASK 0
#endif
#ifndef PHMASK
#define PHMASK 0xFFFF
#endif

constexpr size_t WS_MOD = 0;
constexpr size_t WS_WIN = WS_MOD + 442368;
constexpr size_t WS_WOUT = WS_WIN + 5242880;
constexpr size_t WS_WUP = WS_WOUT + 2097152;
constexpr size_t WS_WDOWN = WS_WUP + 8388608;
constexpr size_t WS_WUQ = WS_WDOWN + 8388608;
constexpr size_t WS_WUKV = WS_WUQ + 196608;
constexpr size_t WS_FDFT = WS_WUKV + 163840;
constexpr size_t WS_FDFTC = WS_FDFT + 16777216;
constexpr size_t WS_XCTX = WS_FDFTC + 262144;
constexpr size_t WS_S0 = WS_XCTX + 8388608;
constexpr size_t WS_HBUF = WS_S0;
constexpr size_t WS_HID = WS_S0 + 37748736;
constexpr size_t WS_MIX = WS_S0;
constexpr size_t WS_PROJ = WS_S0 + 37748736;
constexpr size_t WS_GATES = WS_PROJ + 75497472;
constexpr size_t WS_QB = WS_GATES + 1179648;
constexpr size_t WS_KB = WS_QB + 14155776;
constexpr size_t WS_VT = WS_KB + 14155776;
constexpr size_t WS_DC = WS_VT + 14155776;
constexpr size_t WS_DEC = WS_DC + 24772608;
constexpr size_t WS_ZT = WS_DEC + 8192;
constexpr size_t WS_ZTC = WS_ZT + 16777216;
constexpr size_t WS_ZTF = WS_ZTC + 2097152;
constexpr size_t WS_CST = WS_DC;
constexpr size_t WS_END_MIX = WS_ZTF + 8388608;
constexpr size_t WS_END_MLP = WS_HID + 150994944;
constexpr size_t WS_PART = WS_HID + 150994944;
constexpr size_t WS_RSS = 268435456 - 16384 - 262144 - 262144;
constexpr size_t WS_RCNT = WS_RSS - 65536;
constexpr size_t WS_ROPE = 268435456 - 16384 - 262144;
constexpr size_t WS_BAR = 268435456 - 16384;
constexpr size_t WS_NEED = 268435456;
static_assert(WS_END_MIX <= WS_RCNT && WS_PART + 4 * 4194304 <= WS_RCNT, "workspace map");

struct KP { const float* in[20]; float* out; unsigned char* ws; int ph_lo, ph_hi; };
enum { I_X, I_C, I_CTX, I_CCTX, I_WMOD, I_BMOD, I_G1, I_G2, I_WIN, I_BG, I_CONV, I_GM, I_GQN, I_GKVN, I_WUQ, I_WUKV, I_WOUT, I_WUP, I_WDOWN, I_GFIN };

__device__ __forceinline__ int ltid() { int t = threadIdx.x; asm volatile("" : "+v"(t)); return t; }
__device__ __forceinline__ int lbid() { int t = blockIdx.x; asm volatile("" : "+s"(t)); return t; }
__device__ __forceinline__ float bf2f(bf16_t v) { return __uint_as_float(((unsigned)v) << 16); }
__device__ __forceinline__ bf16_t f2bf(float f) { unsigned u = __float_as_uint(f); u += 0x7FFFu + ((u >> 16) & 1u); return (bf16_t)(u >> 16); }
__device__ __forceinline__ unsigned pk2(float lo, float hi) { unsigned r; asm("v_cvt_pk_bf16_f32 %0, %1, %2" : "=v"(r) : "v"(lo), "v"(hi)); return r; }
__device__ __forceinline__ float lo_bf(unsigned u) { return __uint_as_float(u << 16); }
__device__ __forceinline__ float hi_bf(unsigned u) { return __uint_as_float(u & 0xFFFF0000u); }
__device__ __forceinline__ float wave_sum(float v) {
#pragma unroll
    for (int o = 1; o < 64; o <<= 1) v += __shfl_xor(v, o);
    return v;
}
__device__ __forceinline__ float max_over_fq(float x) {
    const unsigned u = __float_as_uint(x);
    const auto r = __builtin_amdgcn_permlane32_swap(u, u, false, false);
    const float m = fmaxf(__uint_as_float(r[0]), __uint_as_float(r[1]));
    const unsigned v = __float_as_uint(m);
    const auto s = __builtin_amdgcn_permlane16_swap(v, v, false, false);
    return fmaxf(__uint_as_float(s[0]), __uint_as_float(s[1]));
}
__device__ __forceinline__ float sum_over_fq(float x) {
    const unsigned u = __float_as_uint(x);
    const auto r = __builtin_amdgcn_permlane32_swap(u, u, false, false);
    const float m = __uint_as_float(r[0]) + __uint_as_float(r[1]);
    const unsigned v = __float_as_uint(m);
    const auto s = __builtin_amdgcn_permlane16_swap(v, v, false, false);
    return __uint_as_float(s[0]) + __uint_as_float(s[1]);
}
__device__ __forceinline__ float logsig(float f) { const float e = __expf(-fabsf(f)); return fminf(f, 0.f) - __logf(1.f + e); }
__device__ __forceinline__ float siluf(float v) { return v / (1.f + __expf(-v)); }
__device__ __forceinline__ bf16x8 mk8(u32x2 lo, u32x2 hi) { u32x4 t = {lo.x, lo.y, hi.x, hi.y}; return __builtin_bit_cast(bf16x8, t); }

struct EpiIn {
    static constexpr bool PERM = true, AFTER_DRAIN = false;
    bf16_t* proj; float* gates; bf16_t* zt; bf16_t* ztc;
    __device__ __forceinline__ void operator()(const f32x4 (&acc)[2][2][4][2], const pg8::Unit& u, int wr, int wc, int fr, int fq) const {
        const int row0 = u.pm * 256 + wr * 64 + fr;
        if (u.pn < 2) {
            const bool latu = u.pm < 64;
            unsigned char* zb = latu ? (unsigned char*)zt : (unsigned char*)ztc;
            const unsigned ldzb = latu ? 8192u : 1024u;
            const unsigned cofs = (unsigned)(wc * 32 + 8 * fq) * ldzb;
#pragma unroll
            for (int ai = 0; ai < 2; ++ai)
#pragma unroll
                for (int m = 0; m < 4; ++m) {
                    const int r = row0 + ai * 128 + m * 16;
                    unsigned off;
                    if (latu) { const int b = r >> 11, n = r & 2047; off = (unsigned)((b * 256) * 4096 + u.pn * 2048 + n) * 2u + cofs; }
                    else { const int rc = r - TL, b = rc >> 8, n = rc & 255; off = (unsigned)((b * 256) * 512 + u.pn * 256 + n) * 2u + cofs; }
#pragma unroll
                    for (int bj = 0; bj < 2; ++bj)
#pragma unroll
                        for (int n2 = 0; n2 < 2; ++n2) {
                            const f32x4 v = acc[ai][bj][m][n2];
#pragma unroll
                            for (int j = 0; j < 4; ++j) *(bf16_t*)(zb + (off + (unsigned)(bj * 128 + 4 * n2 + j) * ldzb)) = f2bf(v[j]);
                        }
                    asm volatile("" ::: "memory");
                }
        } else {
            const int colbase = (u.pn - 2) * 256 + wc * 32 + 8 * fq;
            const bool isg = (u.pn == 8) && (wc == 0) && (fq < 2);
#pragma unroll
            for (int ai = 0; ai < 2; ++ai)
#pragma unroll
                for (int m = 0; m < 4; ++m) {
                    const int r = row0 + ai * 128 + m * 16;
                    bf16_t* rowp = proj + (size_t)r * PW + colbase;
#pragma unroll
                    for (int bj = 0; bj < 2; ++bj) {
                        const f32x4 v0 = acc[ai][bj][m][0], v1 = acc[ai][bj][m][1];
                        u32x4 o; o.x = pk2(v0[0], v0[1]); o.y = pk2(v0[2], v0[3]); o.z = pk2(v1[0], v1[1]); o.w = pk2(v1[2], v1[3]);
                        *(u32x4*)(rowp + bj * 128) = o;
                    }
                    if (isg) { float* gp = gates + (size_t)r * 16 + 8 * fq; *(f32x4*)gp = acc[ai][0][m][0]; *(f32x4*)(gp + 4) = acc[ai][0][m][1]; }
                    asm volatile("" ::: "memory");
                }
        }
    }
};
struct EpiRes {
    static constexpr bool PERM = false, AFTER_DRAIN = false;
    const float* xol; const float* xoc; float* xnl; float* xnc; const float* ga;
    __device__ __forceinline__ void operator()(const f32x4 (&acc)[2][2][4][2], const pg8::Unit& u, int wr, int wc, int fr, int fq) const {
        const int row0 = u.pm * 256 + wr * 64 + fr, col0 = u.pn * 256 + wc * 32 + 4 * fq;
#pragma unroll
        for (int ai = 0; ai < 2; ++ai)
#pragma unroll
            for (int m = 0; m < 4; ++m) {
                const int r = row0 + ai * 128 + m * 16;
                const float* xo; float* xn; int b;
                if (r < TL) { xo = xol + (size_t)r * D; xn = xnl + (size_t)r * D; b = r >> 11; } else { xo = xoc + (size_t)(r - TL) * D; xn = xnc + (size_t)(r - TL) * D; b = 8; }
                const float* gp = ga + (size_t)b * 6144;
#pragma unroll
                for (int bj = 0; bj < 2; ++bj)
#pragma unroll
                    for (int n = 0; n < 2; ++n) {
                        const int c = col0 + bj * 128 + n * 16;
                        const f32x4 g = *(const f32x4*)(gp + c), xv = *(const f32x4*)(xo + c);
                        *(f32x4*)(xn + c) = xv + g * acc[ai][bj][m][n];
                    }
            }
    }
};
struct EpiResNorm {
    static constexpr bool PERM = false, AFTER_DRAIN = true;
    const float* xo; float* xn; const float* ga; float* rss; unsigned* cnt; int mode; const float* g; const float* sc; const float* sh; bf16_t* hb;
    __device__ __forceinline__ void fused(f32x4 (&acc)[2][2][4][2], const pg8::Unit& u, int wr, int wc, int fr, int fq, PG8_LAS unsigned char* lds, int wid, int lane) const {
        const int row0 = u.pm * 256 + wr * 64 + fr, col0 = u.pn * 256 + wc * 32 + 4 * fq, b = (u.pm * 256) >> 11;
        float ps[2][4];
        {   const float* gp = ga + (size_t)b * 6144 + col0;
            f32x4 gv[2][2];
#pragma unroll
            for (int bj = 0; bj < 2; ++bj)
#pragma unroll
                for (int n = 0; n < 2; ++n) gv[bj][n] = *(const f32x4*)(gp + bj * 128 + n * 16);
#pragma unroll
            for (int ai = 0; ai < 2; ++ai) {
                f32x4 xt[4][2][2];
#pragma unroll
                for (int m = 0; m < 4; ++m) { const float* xr = xo + (size_t)(row0 + ai * 128 + m * 16) * D + col0;
#pragma unroll
                    for (int bj = 0; bj < 2; ++bj)
#pragma unroll
                        for (int n = 0; n < 2; ++n) xt[m][bj][n] = *(const f32x4*)(xr + bj * 128 + n * 16); }
#pragma unroll
                for (int m = 0; m < 4; ++m) { float s = 0.f;
#pragma unroll
                    for (int bj = 0; bj < 2; ++bj)
#pragma unroll
                        for (int n = 0; n < 2; ++n) { const f32x4 v = xt[m][bj][n] + gv[bj][n] * acc[ai][bj][m][n]; acc[ai][bj][m][n] = v;
                            s += v[0] * v[0] + v[1] * v[1] + v[2] * v[2] + v[3] * v[3]; }
                    ps[ai][m] = sum_over_fq(s); }
                asm volatile("" ::: "memory");
            } }
        PG8_LAS float* red = (PG8_LAS float*)lds;
        if (fq == 0) {
#pragma unroll
            for (int ai = 0; ai < 2; ++ai)
#pragma unroll
                for (int m = 0; m < 4; ++m) red[wc * 256 + ai * 128 + wr * 64 + m * 16 + fr] = ps[ai][m]; }
        __syncthreads();
        const int tid = wid * 64 + lane;
        if (tid < 256) { const float tot = (red[tid] + red[256 + tid]) + (red[512 + tid] + red[768 + tid]);
            (void)__hip_atomic_fetch_add(rss + u.pm * 256 + tid, tot, __ATOMIC_RELAXED, __HIP_MEMORY_SCOPE_AGENT); }
        asm volatile("s_waitcnt vmcnt(0)" ::: "memory");
        __syncthreads();
        if (tid == 0) { unsigned* c = cnt + u.pm * 64;
            (void)__hip_atomic_fetch_add(c, 1u, __ATOMIC_RELAXED, __HIP_MEMORY_SCOPE_AGENT);
            unsigned spins = 0; while (__hip_atomic_load(c, __ATOMIC_RELAXED, __HIP_MEMORY_SCOPE_AGENT) < 4u && ++spins < (1u << 22)) __builtin_amdgcn_s_sleep(1); }
        __syncthreads();
        float rs[2][4];
#pragma unroll
        for (int ai = 0; ai < 2; ++ai)
#pragma unroll
            for (int m = 0; m < 4; ++m) rs[ai][m] = __hip_atomic_load(rss + row0 + ai * 128 + m * 16, __ATOMIC_RELAXED, __HIP_MEMORY_SCOPE_AGENT);
#pragma unroll
        for (int ai = 0; ai < 2; ++ai)
#pragma unroll
            for (int m = 0; m < 4; ++m) rs[ai][m] = rsqrtf(rs[ai][m] * (1.f / D) + EPS);
        const size_t bo = (size_t)b * 6144;
#pragma unroll
        for (int bj = 0; bj < 2; ++bj) {
            f32x4 gq[2], sv[2];
#pragma unroll
            for (int n = 0; n < 2; ++n) { const int c = col0 + bj * 128 + n * 16; const f32x4 gg = *(const f32x4*)(g + c);
                if (mode == 0) { gq[n] = gg * (*(const f32x4*)(sc + bo + c) + 1.f); sv[n] = *(const f32x4*)(sh + bo + c); }
                else { gq[n] = gg; sv[n] = (f32x4){0.f, 0.f, 0.f, 0.f}; } }
#pragma unroll
            for (int ai = 0; ai < 2; ++ai)
#pragma unroll
                for (int m = 0; m < 4; ++m) {
                    const int r = row0 + ai * 128 + m * 16; const float rstd = rs[ai][m];
#pragma unroll
                    for (int n = 0; n < 2; ++n) { const int c = col0 + bj * 128 + n * 16; const f32x4 v = acc[ai][bj][m][n];
                        const f32x4 hh = v * rstd * gq[n] + sv[n];
                        if (mode == 0) { *(f32x4*)(xn + (size_t)r * D + c) = v;
                            u32x2 o; o.x = pk2(hh[0], hh[1]); o.y = pk2(hh[2], hh[3]); *(u32x2*)(hb + (size_t)r * D + c) = o; }
                        else *(f32x4*)(xn + (size_t)r * D + c) = hh; }
                }
            asm volatile("" ::: "memory");
        }
    }
};
struct EpiUp {
    static constexpr bool PERM = true, AFTER_DRAIN = false;
    bf16_t* hid;
    __device__ __forceinline__ void operator()(const f32x4 (&acc)[2][2][4][2], const pg8::Unit& u, int wr, int wc, int fr, int fq) const {
        const int row0 = u.pm * 256 + wr * 64 + fr, col0 = u.pn * 256 + wc * 32 + 8 * fq;
#pragma unroll
        for (int ai = 0; ai < 2; ++ai)
#pragma unroll
            for (int m = 0; m < 4; ++m) {
                bf16_t* rowp = hid + (size_t)(row0 + ai * 128 + m * 16) * 4096 + col0;
#pragma unroll
                for (int bj = 0; bj < 2; ++bj) {
                    f32x4 v0 = acc[ai][bj][m][0], v1 = acc[ai][bj][m][1];
#pragma unroll
                    for (int j = 0; j < 4; ++j) { float a = fmaxf(v0[j], 0.f); v0[j] = a * a; float b = fmaxf(v1[j], 0.f); v1[j] = b * b; }
                    u32x4 o; o.x = pk2(v0[0], v0[1]); o.y = pk2(v0[2], v0[3]); o.z = pk2(v1[0], v1[1]); o.w = pk2(v1[2], v1[3]);
                    *(u32x4*)(rowp + bj * 128) = o;
                }
            }
    }
};
struct EpiFou {
    static constexpr bool PERM = true, AFTER_DRAIN = false;
    bf16_t* mix; int rows_per_b; int row_off; float scale;
    __device__ __forceinline__ void operator()(const f32x4 (&acc)[2][2][4][2], const pg8::Unit& u, int wr, int wc, int fr, int fq) const {
        const int row0 = u.pm * 256 + wr * 64 + fr, col0 = wc * 32 + 8 * fq;
        const size_t rb = (size_t)row_off + (size_t)u.pn * rows_per_b;
#pragma unroll
        for (int ai = 0; ai < 2; ++ai)
#pragma unroll
            for (int m = 0; m < 4; ++m) {
                bf16_t* rowp = mix + (rb + row0 + ai * 128 + m * 16) * D + col0;
#pragma unroll
                for (int bj = 0; bj < 2; ++bj) {
                    const f32x4 v0 = acc[ai][bj][m][0] * scale, v1 = acc[ai][bj][m][1] * scale;
                    u32x4 o; o.x = pk2(v0[0], v0[1]); o.y = pk2(v0[2], v0[3]); o.z = pk2(v1[0], v1[1]); o.w = pk2(v1[2], v1[3]);
                    *(u32x4*)(rowp + bj * 128) = o;
                }
            }
    }
};

template <class Epi>
__device__ __forceinline__ void run_gemm(unsigned char* shm, const bf16_t* A, const bf16_t* Bt, int M, int N, int K, int G, int c, const Epi& E) {
    pg8::Gemm g; g.A = A; g.Bt = Bt; g.M = M; g.N = N; g.K = K; g.ld = K;
    pg8::StaticOrder S; S.init(M, N, G, c);
    pg8::gemm_phase<Epi, pg8::StaticOrder, false>((PG8_LAS unsigned char*)shm, g, S, E, nullptr);
}

struct OneUnit {
    int pm, pn;
    __device__ bool next(int i, pg8::Unit& u) const { if (i) return false; u.pm = pm; u.pn = pn; return true; }
    __device__ __forceinline__ void a_ready(const pg8::Unit&) const {}
    __device__ __forceinline__ void done(const pg8::Unit&) const {}
};
struct EpiPart {
    static constexpr bool PERM = true, AFTER_DRAIN = false;
    bf16_t* part;
    __device__ __forceinline__ void operator()(const f32x4 (&acc)[2][2][4][2], const pg8::Unit& u, int wr, int wc, int fr, int fq) const {
        const int row0 = u.pm * 256 + wr * 64 + fr, col0 = u.pn * 256 + wc * 32 + 8 * fq;
#pragma unroll
        for (int ai = 0; ai < 2; ++ai)
#pragma unroll
            for (int m = 0; m < 4; ++m) {
                bf16_t* rowp = part + (size_t)(row0 + ai * 128 + m * 16) * D + col0;
#pragma unroll
                for (int bj = 0; bj < 2; ++bj) { const f32x4 v0 = acc[ai][bj][m][0], v1 = acc[ai][bj][m][1];
                    u32x4 o; o.x = pk2(v0[0], v0[1]); o.y = pk2(v0[2], v0[3]); o.z = pk2(v1[0], v1[1]); o.w = pk2(v1[2], v1[3]);
                    *(u32x4*)(rowp + bj * 128) = o; }
            }
    }
};
__device__ __forceinline__ void run_gemm_ctx_split(unsigned char* shm, const bf16_t* A, const bf16_t* Bt, int K, int ld, int pm, int pn, const EpiPart& E) {
    pg8::Gemm g; g.A = A; g.Bt = Bt; g.M = TC; g.N = 1024; g.K = K; g.ld = ld;
    OneUnit S; S.pm = pm; S.pn = pn;
    pg8::gemm_phase<EpiPart, OneUnit, false>((PG8_LAS unsigned char*)shm, g, S, E, nullptr);
}

__device__ __forceinline__ void build_costab(float* tab) {
    for (int i = ltid(); i < 2048; i += 512) tab[i] = cospif((float)i * (1.0f / 1024.0f));
    __syncthreads();
}
__device__ __forceinline__ void tr_load(const float* __restrict__ src, int ldn, int nmax, int k0, int nsrc0, float* tile) {
    const int tid = ltid(), r = tid >> 4, c4 = (tid & 15) * 4;
#pragma unroll
    for (int h = 0; h < 2; ++h) {
        const int rr = r + 32 * h, nc = nsrc0 + c4;
        f32x4 v = {0.f, 0.f, 0.f, 0.f};
        if (nc < nmax) v = *(const f32x4*)(src + (size_t)(k0 + rr) * ldn + nc);
        float* t = tile + rr * 65 + c4; t[0] = v[0]; t[1] = v[1]; t[2] = v[2]; t[3] = v[3];
    }
    __syncthreads();
}
__device__ __forceinline__ void tr_tile(const float* __restrict__ src, int ldn, int nmax, int k0, int nsrc0, bf16_t* __restrict__ dst, int ldk, int ndst0, float* tile) {
    tr_load(src, ldn, nmax, k0, nsrc0, tile);
    const int tid = ltid(), n = tid >> 3, kq = tid & 7;
    const float* s = tile + (kq * 8) * 65 + n;
    u32x4 o; o.x = pk2(s[0], s[65]); o.y = pk2(s[130], s[195]); o.z = pk2(s[260], s[325]); o.w = pk2(s[390], s[455]);
    *(u32x4*)(dst + (size_t)(ndst0 + n) * ldk + k0 + kq * 8) = o;
    __syncthreads();
}
__device__ __forceinline__ void fold_tile(const float* __restrict__ win, int k0, int g, bf16_t* __restrict__ dst, float* tile, const float* tab) {
    tr_load(win, 2224, 2224, k0, g * 64, tile);
    const int tid = ltid(), cp = tid >> 3, kq = tid & 7;
    float ac[8], as[8];
#pragma unroll
    for (int i = 0; i < 8; ++i) { ac[i] = 0.f; as[i] = 0.f; }
    for (int c = 0; c < 64; ++c) {
        const int idx = ((c * cp) & 63) * 32;
        const float cs = tab[idx], sn = tab[(idx - 512) & 2047];
#pragma unroll
        for (int i = 0; i < 8; ++i) { const float v = tile[(kq * 8 + i) * 65 + c]; ac[i] += v * cs; as[i] += v * sn; }
    }
    u32x4 o; o.x = pk2(ac[0], ac[1]); o.y = pk2(ac[2], ac[3]); o.z = pk2(ac[4], ac[5]); o.w = pk2(ac[6], ac[7]);
    *(u32x4*)(dst + (size_t)(g * 64 + cp) * 1024 + k0 + kq * 8) = o;
    u32x4 q; q.x = pk2(as[0], as[1]); q.y = pk2(as[2], as[3]); q.z = pk2(as[4], as[5]); q.w = pk2(as[6], as[7]);
    *(u32x4*)(dst + (size_t)(256 + g * 64 + cp) * 1024 + k0 + kq * 8) = q;
    __syncthreads();
}
__device__ __forceinline__ void tr_tile_wave(const float* __restrict__ src, int ldn, int nmax, int k0, int nsrc0, bf16_t* __restrict__ dst, int ldk, int ndst0, float* tile, int lane) {
    const int r = lane >> 4, c4 = (lane & 15) * 4;
    f32x4 tv[16];
#pragma unroll
    for (int h = 0; h < 16; ++h) { const int rr = r + 4 * h, nc = nsrc0 + c4; tv[h] = (f32x4){0.f, 0.f, 0.f, 0.f};
        if (nc < nmax) tv[h] = *(const f32x4*)(src + (size_t)(k0 + rr) * ldn + nc); }
#pragma unroll
    for (int h = 0; h < 16; ++h) { const int rr = r + 4 * h; float* t = tile + rr * 65 + c4; t[0] = tv[h][0]; t[1] = tv[h][1]; t[2] = tv[h][2]; t[3] = tv[h][3]; }
    asm volatile("s_waitcnt lgkmcnt(0)" ::: "memory");
    const int c = lane & 7, nl = lane >> 3;
#pragma unroll
    for (int j = 0; j < 8; ++j) { const int n = nl + 8 * j; const float* s = tile + (8 * c) * 65 + n;
        u32x4 o; o.x = pk2(s[0], s[65]); o.y = pk2(s[130], s[195]); o.z = pk2(s[260], s[325]); o.w = pk2(s[390], s[455]);
        *(u32x4*)(dst + (size_t)(ndst0 + n) * ldk + k0 + 8 * c) = o; }
    asm volatile("s_waitcnt lgkmcnt(0)" ::: "memory");
}
constexpr int NWV_ITEMS = 512 + 256 + 1024 + 1024 + 24 + 20;
__device__ __forceinline__ void prep_weight_item_wave(const KP& p, int l, int it, float* tile, int lane) {
    unsigned char* ws = p.ws;
    if (it < 512) { const int ct = it & 31, kt = it >> 5;
        tr_tile_wave(p.in[I_WIN] + (size_t)l * 1024 * 2224, 2224, 2224, kt * 64, 256 + ct * 64, (bf16_t*)(ws + WS_WIN), 1024, 512 + ct * 64, tile, lane); return; }
    it -= 512;
    if (it < 256) { tr_tile_wave(p.in[I_WOUT] + (size_t)l * 1024 * 1024, 1024, 1024, (it >> 4) * 64, (it & 15) * 64, (bf16_t*)(ws + WS_WOUT), 1024, (it & 15) * 64, tile, lane); return; }
    it -= 256;
    if (it < 1024) { tr_tile_wave(p.in[I_WUP] + (size_t)l * 1024 * 4096, 4096, 4096, (it >> 6) * 64, (it & 63) * 64, (bf16_t*)(ws + WS_WUP), 1024, (it & 63) * 64, tile, lane); return; }
    it -= 1024;
    if (it < 1024) { tr_tile_wave(p.in[I_WDOWN] + (size_t)l * 4096 * 1024, 1024, 1024, (it >> 4) * 64, (it & 15) * 64, (bf16_t*)(ws + WS_WDOWN), 4096, (it & 15) * 64, tile, lane); return; }
    it -= 1024;
    if (it < 24) { tr_tile_wave(p.in[I_WUQ] + (size_t)l * 256 * 384, 384, 384, (it / 6) * 64, (it % 6) * 64, (bf16_t*)(ws + WS_WUQ), 256, (it % 6) * 64, tile, lane); return; }
    it -= 24;
    tr_tile_wave(p.in[I_WUKV] + (size_t)l * 128 * 640, 640, 640, (it / 10) * 64, (it % 10) * 64, (bf16_t*)(ws + WS_WUKV), 128, (it % 10) * 64, tile, lane);
}
__device__ __forceinline__ void prep_weights(const KP& p, int l, unsigned char* shm, const float* tab, int part = 0, int b0 = 0, int nb = 0) {
    const int tid = ltid(), bid = lbid() - b0, G = nb ? nb : (int)gridDim.x;
    if (part != 2 && part != 4) for (int it = bid; it < 64; it += G) fold_tile(p.in[I_WIN] + (size_t)l * 1024 * 2224, (it >> 2) * 64, it & 3, (bf16_t*)(p.ws + WS_WIN), (float*)(shm + 8192), tab);
    __syncthreads();
    float* wt = (float*)(shm + 8192) + (tid >> 6) * (64 * 65);
    const int ilo = part == 4 ? 2304 : 0, ihi = part == 3 ? 2304 : NWV_ITEMS;
    for (int it = ilo + bid * 8 + (tid >> 6); it < ihi; it += G * 8) {
        const bool isdown = it >= 1792 && it < 2816;
        if ((part == 1 && isdown) || (part == 2 && !isdown)) continue;
        prep_weight_item_wave(p, l, it, wt, tid & 63); }
    __syncthreads();
}
constexpr int NW_ITEMS = 512 + 64 + 256 + 1024 + 1024 + 24 + 20;
__device__ __forceinline__ void prep_weight_item(const KP& p, int l, int it, float* tile, const float* tab) {
    unsigned char* ws = p.ws;
    if (it < 512) { const int ct = it & 31, kt = it >> 5;
        tr_tile(p.in[I_WIN] + (size_t)l * 1024 * 2224, 2224, 2224, kt * 64, 256 + ct * 64, (bf16_t*)(ws + WS_WIN), 1024, 512 + ct * 64, tile); return; }
    it -= 512;
    if (it < 64) { fold_tile(p.in[I_WIN] + (size_t)l * 1024 * 2224, (it >> 2) * 64, it & 3, (bf16_t*)(ws + WS_WIN), tile, tab); return; }
    it -= 64;
    if (it < 256) { tr_tile(p.in[I_WOUT] + (size_t)l * 1024 * 1024, 1024, 1024, (it >> 4) * 64, (it & 15) * 64, (bf16_t*)(ws + WS_WOUT), 1024, (it & 15) * 64, tile); return; }
    it -= 256;
    if (it < 1024) { tr_tile(p.in[I_WUP] + (size_t)l * 1024 * 4096, 4096, 4096, (it >> 6) * 64, (it & 63) * 64, (bf16_t*)(ws + WS_WUP), 1024, (it & 63) * 64, tile); return; }
    it -= 1024;
    if (it < 1024) { tr_tile(p.in[I_WDOWN] + (size_t)l * 4096 * 1024, 1024, 1024, (it >> 4) * 64, (it & 15) * 64, (bf16_t*)(ws + WS_WDOWN), 4096, (it & 15) * 64, tile); return; }
    it -= 1024;
    if (it < 24) { tr_tile(p.in[I_WUQ] + (size_t)l * 256 * 384, 384, 384, (it / 6) * 64, (it % 6) * 64, (bf16_t*)(ws + WS_WUQ), 256, (it % 6) * 64, tile); return; }
    it -= 24;
    tr_tile(p.in[I_WUKV] + (size_t)l * 128 * 640, 640, 640, (it / 10) * 64, (it % 10) * 64, (bf16_t*)(ws + WS_WUKV), 128, (it % 10) * 64, tile);
}
__device__ __forceinline__ void prep_mod_item(const KP& p, int it, float* sl) {
    const int tid = ltid(), l = it / 96, cgp = it % 96;
    {   float cv[18];
#pragma unroll
        for (int q = 0; q < 18; ++q) { const int i = tid + 512 * q, r = i >> 10, k = i & 1023; cv[q] = r < 8 ? p.in[I_C][r * 1024 + k] : p.in[I_CCTX][k]; }
#pragma unroll
        for (int q = 0; q < 18; ++q) sl[tid + 512 * q] = siluf(cv[q]); }
    __syncthreads();
    const int j4 = (tid & 15) * 4, ks = tid >> 4;
    f32x4 acc[9];
#pragma unroll
    for (int r = 0; r < 9; ++r) acc[r] = (f32x4){0.f, 0.f, 0.f, 0.f};
    const float* w = p.in[I_WMOD] + (size_t)l * 1024 * 6144 + cgp * 64 + j4;
#pragma unroll 8
    for (int k = ks * 32; k < ks * 32 + 32; ++k) {
        const f32x4 wv = *(const f32x4*)(w + (size_t)k * 6144);
#pragma unroll
        for (int r = 0; r < 9; ++r) acc[r] += wv * sl[r * 1024 + k];
    }
    float* red = sl + 9216;
#pragma unroll
    for (int r = 0; r < 9; ++r) *(f32x4*)(red + (ks * 9 + r) * 64 + j4) = acc[r];
    __syncthreads();
    for (int o = tid; o < 576; o += 512) { const int r = o >> 6, jl = o & 63; float s = 0.f;
#pragma unroll
        for (int q = 0; q < 32; ++q) s += red[(q * 9 + r) * 64 + jl];
        ((float*)(p.ws + WS_MOD))[(size_t)(l * 9 + r) * 6144 + cgp * 64 + jl] = s + p.in[I_BMOD][l * 6144 + cgp * 64 + jl]; }
    __syncthreads();
}
__device__ __forceinline__ void prep_dft_row(const KP& p, int rowid, const float* tab) {
    const int tid = ltid();
    if (rowid < 2048) {
        const int k = rowid; float v[4];
#pragma unroll
        for (int e = 0; e < 4; ++e) { const int j = tid * 4 + e;
            if (j <= 1024) v[e] = tab[(k * j) & 2047]; else { const int n = j - 1024; v[e] = -tab[(((k * n) & 2047) - 512) & 2047]; } }
        u32x2 ov; ov.x = pk2(v[0], v[1]); ov.y = pk2(v[2], v[3]);
        *(u32x2*)((bf16_t*)(p.ws + WS_FDFT) + (size_t)k * 2048 + tid * 4) = ov;
    } else if (tid < 64) {
        const int k = rowid - 2048; unsigned o[4];
#pragma unroll
        for (int i = 0; i < 4; ++i) { float v[2];
#pragma unroll
            for (int e = 0; e < 2; ++e) { const int np = tid * 8 + i * 2 + e, n = np & 255, j = ((k * n) & 255) * 8; v[e] = (np >> 8) ? -tab[(j - 512) & 2047] : tab[j]; }
            o[i] = pk2(v[0], v[1]); }
        u32x4 ov = {o[0], o[1], o[2], o[3]};
        *(u32x4*)((bf16_t*)(p.ws + WS_FDFTC) + (size_t)k * 512 + tid * 8) = ov;
    }
}
__device__ __forceinline__ void rope_cs(int tpos, int seg, int f, float& cs, float& sn);
__device__ __forceinline__ void step_prep0(const KP& p, unsigned char* shm) {
    float* tab = (float*)shm; float* work = (float*)(shm + 8192);
    build_costab(tab);
    {
        unsigned* z = (unsigned*)(p.ws + WS_RCNT);
        for (int i = lbid() * 512 + ltid(); i < (65536 + 262144) / 4; i += gridDim.x * 512) z[i] = 0u; }
    {
        float* rt = (float*)(p.ws + WS_ROPE);
        for (int i = lbid() * 512 + ltid(); i < 2048 * 16; i += gridDim.x * 512) { float cs, sn; rope_cs(i >> 4, (i >> 3) & 1, i & 7, cs, sn); rt[2 * i] = cs; rt[2 * i + 1] = sn; } }
    const int NT = 192 + 2304;
    const bool nomod = (int)gridDim.x == 256 && lbid() >= 192;
    if (nomod) prep_weights(p, 0, shm, tab, 3, 192, 64);
    for (int it = lbid(); it < NT; it += gridDim.x) {
        if (it < 192) prep_mod_item(p, it, work);
        else prep_dft_row(p, it - 192, tab);
    }
    __syncthreads();
    if ((int)gridDim.x == 256) prep_weights(p, 0, shm, tab, 4); else prep_weights(p, 0, shm, tab);
}

__device__ __forceinline__ void norm_rows(const float* xl, const float* xc, int nrows, const float* g, const float* modl, int shoff, int scoff, bf16_t* dst, const bf16_t* part = nullptr, const float* pga = nullptr, float* xcw = nullptr, int rlo = 0) {
    const int tid = ltid(), lane = tid & 63, gw = lbid() * 8 + (tid >> 6), NW = gridDim.x * 8;
    for (int r0 = rlo + gw; r0 < nrows; r0 += 3 * NW) {
        f32x4 v[3][4]; float ss[3];
#pragma unroll
        for (int q = 0; q < 3; ++q) { const int r = r0 + q * NW; ss[q] = 0.f;
            if (r < nrows) { const float* xr = r < TL ? xl + (size_t)r * D : xc + (size_t)(r - TL) * D;
#pragma unroll
                for (int j = 0; j < 4; ++j) v[q][j] = *(const f32x4*)(xr + lane * 4 + 256 * j);
                if (part != nullptr && r >= TL) {
#pragma unroll
                    for (int j = 0; j < 4; ++j) { const int c = lane * 4 + 256 * j; f32x4 a = {0.f, 0.f, 0.f, 0.f};
#pragma unroll
                        for (int sp = 0; sp < 4; ++sp) { const u32x2 pv = *(const u32x2*)(part + ((size_t)sp * TC + (r - TL)) * D + c); a[0] += lo_bf(pv.x); a[1] += hi_bf(pv.x); a[2] += lo_bf(pv.y); a[3] += hi_bf(pv.y); }
                        v[q][j] += *(const f32x4*)(pga + c) * a;
                        if (xcw != nullptr) *(f32x4*)(xcw + (size_t)(r - TL) * D + c) = v[q][j]; } } }
            else {
#pragma unroll
                for (int j = 0; j < 4; ++j) v[q][j] = (f32x4){0.f, 0.f, 0.f, 0.f}; } }
#pragma unroll
        for (int q = 0; q < 3; ++q) {
#pragma unroll
            for (int j = 0; j < 4; ++j) ss[q] += v[q][j][0] * v[q][j][0] + v[q][j][1] * v[q][j][1] + v[q][j][2] * v[q][j][2] + v[q][j][3] * v[q][j][3];
            ss[q] = wave_sum(ss[q]); }
#pragma unroll
        for (int q = 0; q < 3; ++q) { const int r = r0 + q * NW;
            if (r < nrows) { const int b = r < TL ? (r >> 11) : 8; const float rstd = rsqrtf(ss[q] * (1.f / D) + EPS); const float* mp = modl + (size_t)b * 6144;
#pragma unroll
                for (int j = 0; j < 4; ++j) { const int c = lane * 4 + 256 * j;
                    const f32x4 gg = *(const f32x4*)(g + c), sc = *(const f32x4*)(mp + scoff + c), sh = *(const f32x4*)(mp + shoff + c);
                    const f32x4 y = v[q][j] * rstd * gg, hh = y * (sc + 1.f) + sh;
                    u32x2 o; o.x = pk2(hh[0], hh[1]); o.y = pk2(hh[2], hh[3]);
                    *(u32x2*)(dst + (size_t)r * D + c) = o; } } }
    }
}
__device__ __forceinline__ void step_final(const KP& p) {
    const int tid = ltid(), lane = tid & 63, gw = lbid() * 8 + (tid >> 6), NW = gridDim.x * 8;
    const float* g = p.in[I_GFIN];
    for (int r0 = gw; r0 < TL; r0 += 2 * NW) {
        f32x4 v[2][4]; float ss[2];
#pragma unroll
        for (int q = 0; q < 2; ++q) { const float* xr = p.out + (size_t)(r0 + q * NW) * D; ss[q] = 0.f;
#pragma unroll
            for (int j = 0; j < 4; ++j) v[q][j] = *(const f32x4*)(xr + lane * 4 + 256 * j); }
#pragma unroll
        for (int q = 0; q < 2; ++q) {
#pragma unroll
            for (int j = 0; j < 4; ++j) ss[q] += v[q][j][0] * v[q][j][0] + v[q][j][1] * v[q][j][1] + v[q][j][2] * v[q][j][2] + v[q][j][3] * v[q][j][3];
            ss[q] = wave_sum(ss[q]); }
#pragma unroll
        for (int q = 0; q < 2; ++q) { float* xr = p.out + (size_t)(r0 + q * NW) * D; const float rstd = rsqrtf(ss[q] * (1.f / D) + EPS);
#pragma unroll
            for (int j = 0; j < 4; ++j) { const int c = lane * 4 + 256 * j; *(f32x4*)(xr + c) = v[q][j] * rstd * *(const f32x4*)(g + c); } }
    }
}

constexpr int ML_GA = 0;
constexpr int ML_CW = 3072;
constexpr int ML_Q = 7168;
constexpr int ML_K = 33792;
constexpr int ML_VT = 60416;
constexpr int ML_RAW = 90880;
__device__ __forceinline__ int ml_rowbase(int b, int jc) { return jc < 2 ? TL + b * CL + jc * LCH : b * SEQ + (jc - 2) * LCH; }

__device__ __forceinline__ void ml_stage(const KP& p, int l, int b, int h, int jc, unsigned char* shm) {
    const int tid = ltid();
    const bf16_t* proj = (const bf16_t*)(p.ws + WS_PROJ);
    const float* gates = (const float*)(p.ws + WS_GATES);
    float* GA = (float*)(shm + ML_GA); float* CW = (float*)(shm + ML_CW);
    bf16_t* vT = (bf16_t*)(shm + ML_VT); bf16_t* RAW = (bf16_t*)(shm + ML_RAW);
    const int rowbase = ml_rowbase(b, jc);
    const int t0 = jc < 2 ? jc * LCH : (jc - 2) * LCH, slen = jc < 2 ? CL : SEQ;
    float i_f = 0.f, i_b = 0.f, pf = 0.f, sf = 0.f;
    if (tid < 128) {
        const int lane = tid & 63;
        const float* gp = gates + (size_t)(rowbase + tid) * 16; const float* bg = p.in[I_BG] + l * 16;
        const f32x4 g0 = *(const f32x4*)gp, g1 = *(const f32x4*)(gp + 4), g2 = *(const f32x4*)(gp + 8), g3 = *(const f32x4*)(gp + 12);
        i_f = g0[h] + bg[h]; i_b = g2[h] + bg[8 + h];
        pf = logsig(g1[h] + bg[4 + h]); sf = logsig(g3[h] + bg[12 + h]);
#pragma unroll
        for (int o = 1; o < 64; o <<= 1) { const float t = __shfl_up(pf, o); if (lane >= o) pf += t; const float u = __shfl_down(sf, o); if (lane + o < 64) sf += u; }
        if (lane == 63) GA[4 * 128 + (tid >> 6)] = pf;
        if (lane == 0) GA[5 * 128 + (tid >> 6)] = sf;
    }
    float cwv[2]; u32x4 rv[7], vv[3];
#pragma unroll
    for (int q = 0; q < 2; ++q) { const int i = tid + 512 * q; cwv[q] = 0.f;
        if (i < 5 * 192) { const int k = i / 192, ch = i % 192; cwv[q] = p.in[I_CONV][(size_t)l * 5 * 768 + k * 768 + (ch < 96 ? h * 96 + ch : 384 + h * 96 + (ch - 96))]; } }
#pragma unroll
    for (int q = 0; q < 7; ++q) { const int i = tid + 512 * q; rv[q] = (u32x4){0u, 0u, 0u, 0u};
        if (i < 132 * 24) { const int rr = i / 24, ck = i % 24, t = t0 - 2 + rr;
            if (t >= 0 && t < slen) { const int col = ck < 12 ? C_MQ + h * 96 + ck * 8 : C_MK + h * 96 + (ck - 12) * 8; rv[q] = *(const u32x4*)(proj + (size_t)(rowbase - 2 + rr) * PW + col); } } }
#pragma unroll
    for (int q = 0; q < 3; ++q) { const int i = tid + 512 * q, s = i / 12, ck = i % 12; vv[q] = *(const u32x4*)(proj + (size_t)(rowbase + s) * PW + C_MV + h * 96 + ck * 8); }
#pragma unroll
    for (int q = 0; q < 2; ++q) { const int i = tid + 512 * q; if (i < 5 * 192) CW[i] = cwv[q]; }
#pragma unroll
    for (int q = 0; q < 7; ++q) { const int i = tid + 512 * q; if (i < 132 * 24) { const int rr = i / 24, ck = i % 24; *(u32x4*)(RAW + rr * 192 + ck * 8) = rv[q]; } }
#pragma unroll
    for (int q = 0; q < 3; ++q) { const int i = tid + 512 * q, s = i / 12, ck = i % 12; const u32x4 v = vv[q];
        bf16_t* d = vT + (ck * 8) * 136 + s;
        d[0] = (bf16_t)(v.x & 0xFFFF); d[136] = (bf16_t)(v.x >> 16); d[2 * 136] = (bf16_t)(v.y & 0xFFFF); d[3 * 136] = (bf16_t)(v.y >> 16);
        d[4 * 136] = (bf16_t)(v.z & 0xFFFF); d[5 * 136] = (bf16_t)(v.z >> 16); d[6 * 136] = (bf16_t)(v.w & 0xFFFF); d[7 * 136] = (bf16_t)(v.w >> 16); }
    for (int i = tid; i < 16 * 128; i += 512) { const int r = i >> 7, s = i & 127; vT[(96 + r) * 136 + s] = r == 0 ? (bf16_t)0x3F80 : (bf16_t)0; }
    __syncthreads();
    if (tid < 128) {
        const float bf = pf + (tid >= 64 ? GA[4 * 128 + 0] : 0.f), bb = sf + (tid < 64 ? GA[5 * 128 + 1] : 0.f);
        GA[0 * 128 + tid] = i_f; GA[1 * 128 + tid] = bf; GA[2 * 128 + tid] = i_b; GA[3 * 128 + tid] = bb;
    }
    __syncthreads();
}

__device__ __forceinline__ void conv8(const bf16_t* RAW, const float* CW, int s0, int ch, float (&o0)[8], float (&o1)[8]) {
    float w0[5], w1[5];
#pragma unroll
    for (int i = 0; i < 5; ++i) { w0[i] = CW[i * 192 + ch]; w1[i] = CW[i * 192 + ch + 1]; }
    unsigned rv[12];
#pragma unroll
    for (int i = 0; i < 12; ++i) rv[i] = *(const unsigned*)(RAW + (s0 + i) * 192 + ch);
#pragma unroll
    for (int o = 0; o < 8; ++o) { float a0 = 0.f, a1 = 0.f;
#pragma unroll
        for (int i = 0; i < 5; ++i) { a0 += lo_bf(rv[o + i]) * w0[i]; a1 += hi_bf(rv[o + i]) * w1[i]; }
        o0[o] = siluf(a0); o1[o] = siluf(a1); }
}
__device__ __forceinline__ void mlstm_a_item(const KP& p, int l, int item, unsigned char* shm) {
    const int tid = ltid(), w = tid >> 6, lane = tid & 63, fr = lane & 15, fq = lane >> 4;
    const int jc = item % NCH, bh = item / NCH, h = bh & 3, b = bh >> 2;
    ml_stage(p, l, b, h, jc, shm);
    float* GA = (float*)(shm + ML_GA); const float* CW = (const float*)(shm + ML_CW);
    bf16_t* kwf = (bf16_t*)(shm + ML_Q); bf16_t* kwb = (bf16_t*)(shm + ML_K);
    const bf16_t* vT = (const bf16_t*)(shm + ML_VT); const bf16_t* RAW = (const bf16_t*)(shm + ML_RAW);
    const float Bf = GA[1 * 128 + 127], Bb = GA[3 * 128 + 0];
    if (tid < 128) { GA[4 * 128 + tid] = __expf(Bf - GA[1 * 128 + tid] + GA[0 * 128 + tid]); GA[5 * 128 + tid] = __expf(Bb - GA[3 * 128 + tid] + GA[2 * 128 + tid]); }
    if (tid == 0) { float* dec = (float*)(p.ws + WS_DEC); dec[(bh * 2 + 0) * NCH + jc] = __expf(Bf); dec[(bh * 2 + 1) * NCH + jc] = __expf(Bb); }
    __syncthreads();
    for (int task = tid; task < 48 * 16; task += 512) { const int cp = task % 48, s0 = (task / 48) * 8, ch = 96 + 2 * cp, dk = 2 * cp;
        float o0[8], o1[8]; conv8(RAW, CW, s0, ch, o0, o1);
        const f32x4 wfa = *(const f32x4*)(GA + 4 * 128 + s0), wfb = *(const f32x4*)(GA + 4 * 128 + s0 + 4), wba = *(const f32x4*)(GA + 5 * 128 + s0), wbb = *(const f32x4*)(GA + 5 * 128 + s0 + 4);
        u32x4 t;
        t.x = pk2(o0[0] * wfa[0], o0[1] * wfa[1]); t.y = pk2(o0[2] * wfa[2], o0[3] * wfa[3]); t.z = pk2(o0[4] * wfb[0], o0[5] * wfb[1]); t.w = pk2(o0[6] * wfb[2], o0[7] * wfb[3]); *(u32x4*)(kwf + dk * 136 + s0) = t;
        t.x = pk2(o1[0] * wfa[0], o1[1] * wfa[1]); t.y = pk2(o1[2] * wfa[2], o1[3] * wfa[3]); t.z = pk2(o1[4] * wfb[0], o1[5] * wfb[1]); t.w = pk2(o1[6] * wfb[2], o1[7] * wfb[3]); *(u32x4*)(kwf + (dk + 1) * 136 + s0) = t;
        t.x = pk2(o0[0] * wba[0], o0[1] * wba[1]); t.y = pk2(o0[2] * wba[2], o0[3] * wba[3]); t.z = pk2(o0[4] * wbb[0], o0[5] * wbb[1]); t.w = pk2(o0[6] * wbb[2], o0[7] * wbb[3]); *(u32x4*)(kwb + dk * 136 + s0) = t;
        t.x = pk2(o1[0] * wba[0], o1[1] * wba[1]); t.y = pk2(o1[2] * wba[2], o1[3] * wba[3]); t.z = pk2(o1[4] * wbb[0], o1[5] * wbb[1]); t.w = pk2(o1[6] * wbb[2], o1[7] * wbb[3]); *(u32x4*)(kwb + (dk + 1) * 136 + s0) = t; }
    __syncthreads();
    bf16_t* dC = (bf16_t*)(p.ws + WS_DC);
    for (int tix = w; tix < 84; tix += 8) { const int dir = tix / 42, tt = tix % 42, vt = tt / 6, nt = tt % 6;
        const bf16_t* kw = dir ? kwb : kwf;
        f32x4 acc = {0.f, 0.f, 0.f, 0.f};
        bf16x8 af[4], bf4[4];
#pragma unroll
        for (int ks = 0; ks < 4; ++ks) { af[ks] = *(const bf16x8*)(vT + (16 * vt + fr) * 136 + 32 * ks + 8 * fq); bf4[ks] = *(const bf16x8*)(kw + (16 * nt + fr) * 136 + 32 * ks + 8 * fq); }
        __builtin_amdgcn_sched_barrier(0);
#pragma unroll
        for (int ks = 0; ks < 4; ++ks) acc = MFMA16(af[ks], bf4[ks], acc);
        bf16_t* o = dC + ((size_t)(bh * 2 + dir) * NCH + jc) * STSZ + (16 * vt + 4 * fq) * 96 + 16 * nt + fr;
        o[0] = f2bf(acc[0]); o[96] = f2bf(acc[1]); o[192] = f2bf(acc[2]); o[288] = f2bf(acc[3]); }
    __syncthreads();
}

__device__ __forceinline__ void mlstm_scan(const KP& p) {
    const bf16_t* dC = (const bf16_t*)(p.ws + WS_DC); bf16_t* Cst = (bf16_t*)(p.ws + WS_CST); const float* dec = (const float*)(p.ws + WS_DEC);
    const int nthr = gridDim.x * 512;
    for (int wi = lbid() * 512 + ltid(); wi < 64 * (STSZ / 8); wi += nthr) {
        const int chain = wi / (STSZ / 8), e = (wi % (STSZ / 8)) * 8, dir = chain & 1;
        u32x4 dv[NCH]; float dd[NCH];
#pragma unroll
        for (int pz = 0; pz < NCH; ++pz) { const int jc = dir == 0 ? pz : (pz < 2 ? 1 - pz : NCH + 1 - pz);
            dv[pz] = *(const u32x4*)(dC + ((size_t)chain * NCH + jc) * STSZ + e); dd[pz] = dec[chain * NCH + jc]; }
        float S[8];
#pragma unroll
        for (int i = 0; i < 8; ++i) S[i] = 0.f;
#pragma unroll
        for (int pz = 0; pz < NCH; ++pz) {
            const int jc = dir == 0 ? pz : (pz < 2 ? 1 - pz : NCH + 1 - pz);
            u32x4 o; o.x = pk2(S[0], S[1]); o.y = pk2(S[2], S[3]); o.z = pk2(S[4], S[5]); o.w = pk2(S[6], S[7]);
            *(u32x4*)(Cst + ((size_t)chain * NCH + jc) * STSZ + e) = o;
            const u32x4 d = dv[pz]; const float f = dd[pz];
            S[0] = S[0] * f + lo_bf(d.x); S[1] = S[1] * f + hi_bf(d.x); S[2] = S[2] * f + lo_bf(d.y); S[3] = S[3] * f + hi_bf(d.y);
            S[4] = S[4] * f + lo_bf(d.z); S[5] = S[5] * f + hi_bf(d.z); S[6] = S[6] * f + lo_bf(d.w); S[7] = S[7] * f + hi_bf(d.w);
        }
    }
}

__device__ __forceinline__ void mlstm_c_item(const KP& p, int l, int b, int h, int jc, unsigned char* shm) {
    const int tid = ltid(), w = tid >> 6, lane = tid & 63, fr = lane & 15, fq = lane >> 4;
    const int bh = b * 4 + h;
    ml_stage(p, l, b, h, jc, shm);
    const float* GA = (const float*)(shm + ML_GA); const float* CW = (const float*)(shm + ML_CW);
    bf16_t* qL = (bf16_t*)(shm + ML_Q); bf16_t* kL = (bf16_t*)(shm + ML_K);
    const bf16_t* vT = (const bf16_t*)(shm + ML_VT); const bf16_t* RAW = (const bf16_t*)(shm + ML_RAW);
    bf16_t* CsL = (bf16_t*)(shm + ML_RAW);
    const float qscale = 0.10206207261596577f;
    u32x4 cpre[6];
    {   const bf16_t* Cst = (const bf16_t*)(p.ws + WS_CST);
#pragma unroll
        for (int i = 0; i < 6; ++i) { const int c = tid + 512 * i; if (c < 2 * 112 * 12) { const int dir = c / 1344, r = (c % 1344) / 12, ck = c % 12;
            cpre[i] = *(const u32x4*)(Cst + ((size_t)(bh * 2 + dir) * NCH + jc) * STSZ + r * 96 + ck * 8); } else cpre[i] = (u32x4){0u, 0u, 0u, 0u}; } }
    for (int task = tid; task < 96 * 16; task += 512) { const int cp = task % 96, s0 = (task / 96) * 8, ch = 2 * cp;
        float o0[8], o1[8]; conv8(RAW, CW, s0, ch, o0, o1);
        if (ch < 96) {
#pragma unroll
            for (int i = 0; i < 8; ++i) *(unsigned*)(qL + (s0 + i) * 104 + ch) = pk2(o0[i] * qscale, o1[i] * qscale);
        } else {
#pragma unroll
            for (int i = 0; i < 8; ++i) *(unsigned*)(kL + (s0 + i) * 104 + (ch - 96)) = pk2(o0[i], o1[i]); } }
    __syncthreads();
    {
        for (int i = 0; i < 6; ++i) { const int c = tid + 512 * i; if (c < 2 * 112 * 12) { const int dir = c / 1344, r = (c % 1344) / 12, ck = c % 12; *(u32x4*)(CsL + dir * (112 * 104) + r * 104 + ck * 8) = cpre[i]; } }
    }
    __syncthreads();
    const int t = 16 * w + fr;
    const int row = ml_rowbase(b, jc) + t;
    const bf16_t* proj = (const bf16_t*)(p.ws + WS_PROJ);
    u32x2 mov[6];
#pragma unroll
    for (int vt = 0; vt < 6; ++vt) mov[vt] = *(const u32x2*)(proj + (size_t)row * PW + C_MO + h * 96 + 16 * vt + 4 * fq);
    bf16x8 qf[3];
#pragma unroll
    for (int ks = 0; ks < 3; ++ks) qf[ks] = *(const bf16x8*)(qL + t * 104 + 32 * ks + 8 * fq);
    const float bft = GA[128 + t], bbt = GA[3 * 128 + t];
    bf16x8 PF[4], PB[4];
#pragma unroll
    for (int half = 0; half < 2; ++half) {
        bf16x8 kf[4][3];
#pragma unroll
        for (int i = 0; i < 4; ++i)
#pragma unroll
            for (int ks = 0; ks < 3; ++ks) kf[i][ks] = *(const bf16x8*)(kL + (16 * (4 * half + i) + fr) * 104 + 32 * ks + 8 * fq);
        __builtin_amdgcn_sched_barrier(0);
        f32x4 sa[4];
#pragma unroll
        for (int i = 0; i < 4; ++i) { sa[i] = (f32x4){0.f, 0.f, 0.f, 0.f};
#pragma unroll
            for (int ks = 0; ks < 3; ++ks) sa[i] = MFMA16(kf[i][ks], qf[ks], sa[i]); }
        __builtin_amdgcn_sched_barrier(0);
#pragma unroll
        for (int k2 = 0; k2 < 2; ++k2) {
            unsigned pf[4], pb[4];
#pragma unroll
            for (int hh = 0; hh < 2; ++hh) { const int i = 2 * k2 + hh, st = 4 * half + i;
                const int s0 = 16 * st + 4 * fq;
                const f32x4 gif = *(const f32x4*)(GA + s0), gbf = *(const f32x4*)(GA + 128 + s0), gib = *(const f32x4*)(GA + 256 + s0), gbb = *(const f32x4*)(GA + 384 + s0);
                float vf[4], vb[4];
#pragma unroll
                for (int j = 0; j < 4; ++j) { const int s = s0 + j;
                    vf[j] = (s <= t) ? sa[i][j] * __expf(bft - gbf[j] + gif[j]) : 0.f;
                    vb[j] = (s >= t) ? sa[i][j] * __expf(bbt - gbb[j] + gib[j]) : 0.f; }
                pf[2 * hh] = pk2(vf[0], vf[1]); pf[2 * hh + 1] = pk2(vf[2], vf[3]); pb[2 * hh] = pk2(vb[0], vb[1]); pb[2 * hh + 1] = pk2(vb[2], vb[3]); }
            u32x4 tf = {pf[0], pf[1], pf[2], pf[3]}, tb = {pb[0], pb[1], pb[2], pb[3]};
            PF[2 * half + k2] = __builtin_bit_cast(bf16x8, tf); PB[2 * half + k2] = __builtin_bit_cast(bf16x8, tb);
        }
    }
    const float ebf = __expf(bft), ebb = __expf(bbt);
    f32x4 nf[7], nb[7];
#pragma unroll
    for (int vt = 0; vt < 7; ++vt) {
        bf16x8 cf[3], cb[3]; u32x2 vlo[4], vhi[4];
#pragma unroll
        for (int ks = 0; ks < 3; ++ks) { cf[ks] = *(const bf16x8*)(CsL + (16 * vt + fr) * 104 + 32 * ks + 8 * fq); cb[ks] = *(const bf16x8*)(CsL + 112 * 104 + (16 * vt + fr) * 104 + 32 * ks + 8 * fq); }
#pragma unroll
        for (int kk = 0; kk < 4; ++kk) { vlo[kk] = *(const u32x2*)(vT + (16 * vt + fr) * 136 + 32 * kk + 4 * fq); vhi[kk] = *(const u32x2*)(vT + (16 * vt + fr) * 136 + 32 * kk + 16 + 4 * fq); }
        __builtin_amdgcn_sched_barrier(0);
        f32x4 af = {0.f, 0.f, 0.f, 0.f}, ab = {0.f, 0.f, 0.f, 0.f};
#pragma unroll
        for (int ks = 0; ks < 3; ++ks) { af = MFMA16(cf[ks], qf[ks], af); ab = MFMA16(cb[ks], qf[ks], ab); }
        af *= ebf; ab *= ebb;
#pragma unroll
        for (int kk = 0; kk < 4; ++kk) { const bf16x8 a = mk8(vlo[kk], vhi[kk]); af = MFMA16(a, PF[kk], af); ab = MFMA16(a, PB[kk], ab); }
        nf[vt] = af; nb[vt] = ab;
    }
    const float denf = __shfl(nf[6][0], fr), denb = __shfl(nb[6][0], fr);
    const float rf = 1.f / fmaxf(fabsf(denf), 1.f), rb = 1.f / fmaxf(fabsf(denb), 1.f);
    float ss = 0.f;
#pragma unroll
    for (int vt = 0; vt < 6; ++vt) { nf[vt] = nf[vt] * rf + nb[vt] * rb; ss += nf[vt][0] * nf[vt][0] + nf[vt][1] * nf[vt][1] + nf[vt][2] * nf[vt][2] + nf[vt][3] * nf[vt][3]; }
    ss = sum_over_fq(ss);
    const float rn = rsqrtf(ss * (1.f / 96.f) + EPS);
    bf16_t* mix = (bf16_t*)(p.ws + WS_MIX);
    const float* gm = p.in[I_GM] + l * 384 + h * 96;
#pragma unroll
    for (int vt = 0; vt < 6; ++vt) { const int vc = 16 * vt + 4 * fq;
        const u32x2 mo = mov[vt]; const f32x4 g = *(const f32x4*)(gm + vc);
        const float m0 = lo_bf(mo.x), m1 = hi_bf(mo.x), m2 = lo_bf(mo.y), m3 = hi_bf(mo.y);
        const float y0 = nf[vt][0] * rn * g[0] / (1.f + __expf(-m0)), y1 = nf[vt][1] * rn * g[1] / (1.f + __expf(-m1));
        const float y2 = nf[vt][2] * rn * g[2] / (1.f + __expf(-m2)), y3 = nf[vt][3] * rn * g[3] / (1.f + __expf(-m3));
        u32x2 o; o.x = pk2(y0, y1); o.y = pk2(y2, y3);
        *(u32x2*)(mix + (size_t)row * D + 256 + h * 96 + vc) = o; }
    __syncthreads();
}

__device__ __forceinline__ void zt_fold_item(const KP& p, int item, unsigned char* shm) {
    const int tid = ltid(), w = tid >> 6, lane = tid & 63;
    const int col = item * 8 + w;
    const bf16_t* zr = (const bf16_t*)(p.ws + WS_ZT) + (size_t)col * 4096;
    bf16_t* la = (bf16_t*)(shm + w * 8192); bf16_t* lb = la + 2048;
#pragma unroll
    for (int q = 0; q < 4; ++q) { *(u32x4*)(la + (q * 64 + lane) * 8) = *(const u32x4*)(zr + (q * 64 + lane) * 8); *(u32x4*)(lb + (q * 64 + lane) * 8) = *(const u32x4*)(zr + 2048 + (q * 64 + lane) * 8); }
    asm volatile("s_waitcnt vmcnt(0) lgkmcnt(0)" ::: "memory");
    bf16_t* out = (bf16_t*)(p.ws + WS_ZTF) + (size_t)col * 2048;
#pragma unroll
    for (int q = 0; q < 4; ++q) { const int j0 = (q * 64 + lane) * 8; unsigned o[4];
#pragma unroll
        for (int e2 = 0; e2 < 4; ++e2) { float v[2];
#pragma unroll
            for (int e = 0; e < 2; ++e) { const int j = j0 + 2 * e2 + e;
                if (j == 0 || j == 1024) v[e] = bf2f(la[j]);
                else if (j < 1024) v[e] = bf2f(la[j]) + bf2f(la[2048 - j]);
                else { const int n = j - 1024; v[e] = bf2f(lb[n]) - bf2f(lb[2048 - n]); } }
            o[e2] = pk2(v[0], v[1]); }
        u32x4 ov = {o[0], o[1], o[2], o[3]};
        *(u32x4*)(out + j0) = ov; }
    asm volatile("s_waitcnt lgkmcnt(0)" ::: "memory");
}

__device__ __forceinline__ void rope_cs_tab(const float* rt, int tpos, int seg, int f, float& cs, float& sn) { const float2 v = *(const float2*)(rt + ((tpos * 2 + seg) * 8 + f) * 2); cs = v.x; sn = v.y; }
__device__ __forceinline__ void rope_cs(int tpos, int seg, int f, float& cs, float& sn) {
    const float pos = (float)(seg == 0 ? (tpos >> 6) : (tpos & 63));
    const float fr = exp2f(-(float)f * 1.6609640474436813f);
    sincosf(pos * fr, &sn, &cs);
}
__device__ __forceinline__ void qkv_item(const KP& p, int l, int item, unsigned char* shm) {
    const int tid = ltid(), w = tid >> 6, lane = tid & 63, fr = lane & 15, fq = lane >> 4;
    const int r0 = item * 64; const bool lat = r0 < TL;
    const int b = lat ? (r0 >> 11) : ((r0 - TL) >> 8), tl0 = lat ? (r0 & 2047) : ((r0 - TL) & 255), key0 = lat ? tl0 : SEQ + tl0;
    const bf16_t* proj = (const bf16_t*)(p.ws + WS_PROJ); const float* rt = (const float*)(p.ws + WS_ROPE);
    bf16_t* aq = (bf16_t*)shm; bf16_t* akv = (bf16_t*)(shm + 64 * 264 * 2);
    {
        const int tk = tid >> 3, sub = tid & 7; const bf16_t* pr = proj + (size_t)(r0 + tk) * PW;
        u32x4 cq[4], ck[2]; float sq = 0.f, sk = 0.f;
#pragma unroll
        for (int i = 0; i < 4; ++i) { cq[i] = *(const u32x4*)(pr + C_CQ + sub * 32 + i * 8);
#pragma unroll
            for (int e = 0; e < 4; ++e) { const float a = lo_bf(cq[i][e]), c = hi_bf(cq[i][e]); sq += a * a + c * c; } }
#pragma unroll
        for (int i = 0; i < 2; ++i) { ck[i] = *(const u32x4*)(pr + C_CKV + sub * 16 + i * 8);
#pragma unroll
            for (int e = 0; e < 4; ++e) { const float a = lo_bf(ck[i][e]), c = hi_bf(ck[i][e]); sk += a * a + c * c; } }
        sq += __shfl_xor(sq, 1); sq += __shfl_xor(sq, 2); sq += __shfl_xor(sq, 4);
        sk += __shfl_xor(sk, 1); sk += __shfl_xor(sk, 2); sk += __shfl_xor(sk, 4);
        const float rq = rsqrtf(sq * (1.f / 256.f) + EPS), rk = rsqrtf(sk * (1.f / 128.f) + EPS);
        const float* gq = p.in[I_GQN] + l * 256 + sub * 32; const float* gk = p.in[I_GKVN] + l * 128 + sub * 16;
#pragma unroll
        for (int i = 0; i < 4; ++i) { u32x4 o;
#pragma unroll
            for (int e = 0; e < 4; ++e) o[e] = pk2(lo_bf(cq[i][e]) * rq * gq[i * 8 + 2 * e], hi_bf(cq[i][e]) * rq * gq[i * 8 + 2 * e + 1]);
            *(u32x4*)(aq + tk * 264 + sub * 32 + i * 8) = o; }
#pragma unroll
        for (int i = 0; i < 2; ++i) { u32x4 o;
#pragma unroll
            for (int e = 0; e < 4; ++e) o[e] = pk2(lo_bf(ck[i][e]) * rk * gk[i * 8 + 2 * e], hi_bf(ck[i][e]) * rk * gk[i * 8 + 2 * e + 1]);
            *(u32x4*)(akv + tk * 136 + sub * 16 + i * 8) = o; }
    }
    bf16_t* Qb = (bf16_t*)(p.ws + WS_QB); bf16_t* Kb = (bf16_t*)(p.ws + WS_KB); bf16_t* Vt = (bf16_t*)(p.ws + WS_VT);
    {
        const int tk = tid >> 3, i0 = (tid & 7) * 4, seg = i0 >> 4, half = (i0 >> 3) & 1, f0 = i0 & 7;
        const bf16_t* pr = proj + (size_t)(r0 + tk) * PW + C_KR;
        const u32x2 me = *(const u32x2*)(pr + i0), pa = *(const u32x2*)(pr + (i0 ^ 8));
        float mv[4] = {lo_bf(me.x), hi_bf(me.x), lo_bf(me.y), hi_bf(me.y)}, pv[4] = {lo_bf(pa.x), hi_bf(pa.x), lo_bf(pa.y), hi_bf(pa.y)}, ov[4];
#pragma unroll
        for (int j = 0; j < 4; ++j) {
            if (lat) { float cs, sn; rope_cs_tab(rt, tl0 + tk, seg, f0 + j, cs, sn); ov[j] = half ? (pv[j] * sn + mv[j] * cs) : (mv[j] * cs - pv[j] * sn); }
            else ov[j] = mv[j]; }
        u32x2 o; o.x = pk2(ov[0], ov[1]); o.y = pk2(ov[2], ov[3]);
#pragma unroll
        for (int hh = 0; hh < 4; ++hh) *(u32x2*)(Kb + ((size_t)(b * 4 + hh) * KEYS + key0 + tk) * 96 + 64 + i0) = o;
    }
    __syncthreads();
    const bf16_t* WuqT = (const bf16_t*)(p.ws + WS_WUQ); const bf16_t* WukvT = (const bf16_t*)(p.ws + WS_WUKV);
    const float qs = 0.10206207261596577f * 1.4426950408889634f;
    for (int ct = w; ct < 24; ct += 8) {
        f32x4 acc[4];
#pragma unroll
        for (int tt = 0; tt < 4; ++tt) acc[tt] = (f32x4){0.f, 0.f, 0.f, 0.f};
        bf16x8 wa[8];
#pragma unroll
        for (int ks = 0; ks < 8; ++ks) wa[ks] = *(const bf16x8*)(WuqT + (size_t)(16 * ct + fr) * 256 + 32 * ks + 8 * fq);
#pragma unroll
        for (int kh = 0; kh < 4; ++kh) { bf16x8 bb[2][4];
#pragma unroll
            for (int k2 = 0; k2 < 2; ++k2)
#pragma unroll
                for (int tt = 0; tt < 4; ++tt) bb[k2][tt] = *(const bf16x8*)(aq + (16 * tt + fr) * 264 + 32 * (2 * kh + k2) + 8 * fq);
            __builtin_amdgcn_sched_barrier(0);
#pragma unroll
            for (int k2 = 0; k2 < 2; ++k2)
#pragma unroll
                for (int tt = 0; tt < 4; ++tt) acc[tt] = MFMA16(wa[2 * kh + k2], bb[k2][tt], acc[tt]); }
        const int hq = ct / 6, dt = ct % 6;
#pragma unroll
        for (int tt = 0; tt < 4; ++tt) { const int tk = 16 * tt + fr; f32x4 v = acc[tt];
            if (dt >= 4 && lat) { const int seg = dt - 4, half = fq >> 1;
#pragma unroll
                for (int j = 0; j < 4; ++j) { const float pa = __shfl_xor(v[j], 32); float cs, sn; rope_cs_tab(rt, tl0 + tk, seg, 4 * (fq & 1) + j, cs, sn);
                    v[j] = half ? (pa * sn + v[j] * cs) : (v[j] * cs - pa * sn); } }
            u32x2 o; o.x = pk2(v[0] * qs, v[1] * qs); o.y = pk2(v[2] * qs, v[3] * qs);
            *(u32x2*)(Qb + ((size_t)(b * 4 + hq) * KEYS + key0 + tk) * 96 + 16 * dt + 4 * fq) = o; }
    }
    for (int ct = w; ct < 40; ct += 8) {
        const int hk = ct / 10, dt = ct % 10;
        f32x4 acc[4];
#pragma unroll
        for (int tt = 0; tt < 4; ++tt) acc[tt] = (f32x4){0.f, 0.f, 0.f, 0.f};
        bf16x8 wa[4];
#pragma unroll
        for (int ks = 0; ks < 4; ++ks) wa[ks] = *(const bf16x8*)(WukvT + (size_t)(16 * ct + fr) * 128 + 32 * ks + 8 * fq);
#pragma unroll
        for (int kh = 0; kh < 2; ++kh) { bf16x8 bb[2][4];
#pragma unroll
            for (int k2 = 0; k2 < 2; ++k2)
#pragma unroll
                for (int tt = 0; tt < 4; ++tt) bb[k2][tt] = *(const bf16x8*)(akv + (16 * tt + fr) * 136 + 32 * (2 * kh + k2) + 8 * fq);
            __builtin_amdgcn_sched_barrier(0);
#pragma unroll
            for (int k2 = 0; k2 < 2; ++k2)
#pragma unroll
                for (int tt = 0; tt < 4; ++tt) acc[tt] = dt < 4 ? MFMA16(wa[2 * kh + k2], bb[k2][tt], acc[tt]) : MFMA16(bb[k2][tt], wa[2 * kh + k2], acc[tt]); }
#pragma unroll
        for (int tt = 0; tt < 4; ++tt) { const f32x4 v = acc[tt]; u32x2 o; o.x = pk2(v[0], v[1]); o.y = pk2(v[2], v[3]);
            if (dt < 4) *(u32x2*)(Kb + ((size_t)(b * 4 + hk) * KEYS + key0 + 16 * tt + fr) * 96 + 16 * dt + 4 * fq) = o;
            else *(u32x2*)(Vt + ((size_t)(b * 4 + hk) * 96 + 16 * (dt - 4) + fr) * KEYS + key0 + 32 * (tt >> 1) + 8 * fq + 4 * (tt & 1)) = o; }
    }
    __syncthreads();
}

template <int VAR>
__device__ __forceinline__ void attn_item(const KP& p, int item, unsigned char* shm) {
    const int tid = ltid(), w = tid >> 6, lane = tid & 63, fr = lane & 15, fq = lane >> 4;
    const int qb = item < 256 ? (item & 7) : 8, bh = item < 256 ? (item >> 3) : item - 256, b = bh >> 2, h = bh & 3;
    const int kbeg = qb < 8 ? 0 : SEQ, ntile = qb < 8 ? KEYS / 64 : CL / 64;
    const bf16_t* Qb = (const bf16_t*)(p.ws + WS_QB) + (size_t)bh * KEYS * 96;
    const bf16_t* Kb = (const bf16_t*)(p.ws + WS_KB) + (size_t)bh * KEYS * 96;
    const bf16_t* Vt = (const bf16_t*)(p.ws + WS_VT) + (size_t)bh * 96 * KEYS;
    const int q0 = qb * 256 + 32 * w;
    bf16x8 qf[2][3];
#pragma unroll
    for (int qt = 0; qt < 2; ++qt)
#pragma unroll
        for (int ks = 0; ks < 3; ++ks) qf[qt][ks] = *(const bf16x8*)(Qb + (size_t)(q0 + 16 * qt + fr) * 96 + 32 * ks + 8 * fq);
    f32x4 O[6][2];
#pragma unroll
    for (int dt = 0; dt < 6; ++dt) { O[dt][0] = (f32x4){0.f, 0.f, 0.f, 0.f}; O[dt][1] = (f32x4){0.f, 0.f, 0.f, 0.f}; }
    float mrow[2] = {-1e30f, -1e30f}, lrow[2] = {0.f, 0.f};
    u32x4 pre[6];
    constexpr int ABUF = (64 * 104 + 96 * 72) * 2;
    auto gload = [&](int kp) {
#pragma unroll
        for (int sub = 0; sub < 2; ++sub) { const int key0 = kbeg + (2 * kp + sub) * 64;
#pragma unroll
            for (int i = 0; i < 3; ++i) { const int c = tid + 512 * i;
                if (c < 768) pre[3 * sub + i] = *(const u32x4*)(Kb + (size_t)key0 * 96 + c * 8);
                else { const int cc = c - 768, dv = cc >> 3, part = cc & 7; pre[3 * sub + i] = *(const u32x4*)(Vt + (size_t)dv * KEYS + key0 + part * 8); } } }
    };
    auto lstore = [&](int buf) {
#pragma unroll
        for (int sub = 0; sub < 2; ++sub) { bf16_t* Kw = (bf16_t*)(shm + (2 * buf + sub) * ABUF); bf16_t* Vw = Kw + 64 * 104;
#pragma unroll
            for (int i = 0; i < 3; ++i) { const int c = tid + 512 * i;
                if (c < 768) { const int key = c / 12, part = c % 12; *(u32x4*)(Kw + key * 104 + part * 8) = pre[3 * sub + i]; }
                else { const int cc = c - 768, dv = cc >> 3, part = cc & 7; *(u32x4*)(Vw + dv * 72 + part * 8) = pre[3 * sub + i]; } } }
    };
    const int npair = ntile >> 1;
    gload(0);
    lstore(0);
    __syncthreads();
    if (npair > 1) gload(1);
    for (int kp = 0; kp < npair; ++kp) {
#pragma unroll
      for (int sub = 0; sub < 2; ++sub) {
        const bf16_t* Kc = (const bf16_t*)(shm + (2 * (kp & 1) + sub) * ABUF); const bf16_t* Vc = Kc + 64 * 104;
        bf16x8 kf[4][3];
#pragma unroll
        for (int kk = 0; kk < 4; ++kk)
#pragma unroll
            for (int ks = 0; ks < 3; ++ks) kf[kk][ks] = *(const bf16x8*)(Kc + (16 * kk + fr) * 104 + 32 * ks + 8 * fq);
        __builtin_amdgcn_sched_barrier(0);
        f32x4 S[4][2];
#pragma unroll
        for (int kk = 0; kk < 4; ++kk) { S[kk][0] = (f32x4){0.f, 0.f, 0.f, 0.f}; S[kk][1] = (f32x4){0.f, 0.f, 0.f, 0.f}; }
        bf16x8 P[2][2];
        auto softmax_qt = [&](const int qt) {
            float mx = S[0][qt][0];
#pragma unroll
            for (int kk = 0; kk < 4; ++kk)
#pragma unroll
                for (int j = 0; j < 4; ++j) mx = fmaxf(mx, S[kk][qt][j]);
            mx = max_over_fq(mx);
            if (__any(mx > mrow[qt] + 8.f)) {
                const float mnew = fmaxf(mrow[qt], mx), alpha = __builtin_amdgcn_exp2f(mrow[qt] - mnew); mrow[qt] = mnew;
                lrow[qt] *= alpha;
#pragma unroll
                for (int dt = 0; dt < 6; ++dt) O[dt][qt] *= alpha;
            }
            const float mn = mrow[qt];
            float ps = 0.f; unsigned pk[8];
#pragma unroll
            for (int kk = 0; kk < 4; ++kk) { const float e0 = __builtin_amdgcn_exp2f(S[kk][qt][0] - mn), e1 = __builtin_amdgcn_exp2f(S[kk][qt][1] - mn), e2 = __builtin_amdgcn_exp2f(S[kk][qt][2] - mn), e3 = __builtin_amdgcn_exp2f(S[kk][qt][3] - mn);
                ps += (e0 + e1) + (e2 + e3); pk[2 * kk] = pk2(e0, e1); pk[2 * kk + 1] = pk2(e2, e3); }
            lrow[qt] += ps;
            u32x4 t0 = {pk[0], pk[1], pk[2], pk[3]}, t1 = {pk[4], pk[5], pk[6], pk[7]};
            P[qt][0] = __builtin_bit_cast(bf16x8, t0); P[qt][1] = __builtin_bit_cast(bf16x8, t1);
        };
#pragma unroll
        for (int ks = 0; ks < 3; ++ks)
#pragma unroll
            for (int kk = 0; kk < 4; ++kk) S[kk][0] = MFMA16(kf[kk][ks], qf[0][ks], S[kk][0]);
        __builtin_amdgcn_sched_barrier(0);
#pragma unroll
        for (int ks = 0; ks < 3; ++ks)
#pragma unroll
            for (int kk = 0; kk < 4; ++kk) S[kk][1] = MFMA16(kf[kk][ks], qf[1][ks], S[kk][1]);
        softmax_qt(0);
        __builtin_amdgcn_sched_barrier(0);
        bf16x8 vf[6][2];
#pragma unroll
        for (int dt = 0; dt < 6; ++dt)
#pragma unroll
            for (int k2 = 0; k2 < 2; ++k2) vf[dt][k2] = *(const bf16x8*)(Vc + (16 * dt + fr) * 72 + 32 * k2 + 8 * fq);
        __builtin_amdgcn_sched_barrier(0);
#pragma unroll
        for (int dt = 0; dt < 6; ++dt)
#pragma unroll
            for (int k2 = 0; k2 < 2; ++k2) O[dt][0] = MFMA16(vf[dt][k2], P[0][k2], O[dt][0]);
        softmax_qt(1);
        __builtin_amdgcn_sched_barrier(0);
#pragma unroll
        for (int dt = 0; dt < 6; ++dt)
#pragma unroll
            for (int k2 = 0; k2 < 2; ++k2) O[dt][1] = MFMA16(vf[dt][k2], P[1][k2], O[dt][1]);
      }
        if (kp + 1 < npair) lstore((kp + 1) & 1);
        __syncthreads();
        if (kp + 2 < npair) gload(kp + 2);
    }
    bf16_t* mix = (bf16_t*)(p.ws + WS_MIX);
#pragma unroll
    for (int qt = 0; qt < 2; ++qt) { float lt = lrow[qt]; lt += __shfl_xor(lt, 16); lt += __shfl_xor(lt, 32); const float inv = 1.f / lt;
        const int q = q0 + 16 * qt + fr; const size_t row = q < SEQ ? (size_t)b * SEQ + q : (size_t)TL + b * CL + (q - SEQ);
#pragma unroll
        for (int dt = 0; dt < 6; ++dt) { const f32x4 v = O[dt][qt] * inv; u32x2 o; o.x = pk2(v[0], v[1]); o.y = pk2(v[2], v[3]);
            *(u32x2*)(mix + row * D + 640 + h * 96 + 16 * dt + 4 * fq) = o; } }
    __syncthreads();
}


#ifdef DIAG
__device__ __forceinline__ float block_max(float v, float* red) {
    const int tid = ltid();
#pragma unroll
    for (int o = 1; o < 64; o <<= 1) v = fmaxf(v, __shfl_xor(v, o));
    __syncthreads(); if ((tid & 63) == 0) red[tid >> 6] = v; __syncthreads();
    float r = red[0];
#pragma unroll
    for (int i = 1; i < 8; ++i) r = fmaxf(r, red[i]);
    __syncthreads(); return r;
}
__device__ __forceinline__ float block_sum(float v, float* red) {
    const int tid = ltid();
    v = wave_sum(v);
    __syncthreads(); if ((tid & 63) == 0) red[tid >> 6] = v; __syncthreads();
    float r = 0.f;
#pragma unroll
    for (int i = 0; i < 8; ++i) r += red[i];
    __syncthreads(); return r;
}
__device__ __forceinline__ float dg_conv(const KP& p, int l, int rbase, int slen, int t, int chg) {
    const bf16_t* proj = (const bf16_t*)(p.ws + WS_PROJ); float a = 0.f;
    for (int i = 0; i < 5; ++i) { const int tt = t - 2 + i; if (tt < 0 || tt >= slen) continue;
        a += bf2f(proj[(size_t)(rbase + tt) * PW + chg]) * p.in[I_CONV][(size_t)l * 5 * 768 + i * 768 + chg]; }
    return siluf(a);
}
__device__ __forceinline__ float diag_mlstm(const KP& p, int l, int b, int h, int tsel, unsigned char* shm) {
    const int tid = ltid();
    float* Ff = (float*)shm; float* Gb = Ff + 2304; float* If = Gb + 2304; float* Ib = If + 2304; float* Wf = Ib + 2304; float* Wb = Wf + 2304; float* qt = Wb + 2304; float* red = qt + 96; float* yr = red + 16;
    const float* gates = (const float*)(p.ws + WS_GATES); const float* bg = p.in[I_BG] + l * 16;
    const bf16_t* proj = (const bf16_t*)(p.ws + WS_PROJ);
    for (int pos = tid; pos < 2304; pos += 512) { const int row = pos < 256 ? TL + b * CL + pos : b * SEQ + (pos - 256); const float* gp = gates + (size_t)row * 16;
        const int pb = pos < 256 ? 2048 + pos : pos - 256;
        If[pos] = gp[h] + bg[h]; Ff[pos] = logsig(gp[4 + h] + bg[4 + h]); Ib[pb] = gp[8 + h] + bg[8 + h]; Gb[pb] = logsig(gp[12 + h] + bg[12 + h]); }
    __syncthreads();
    if (tid == 0) { float a = 0.f; for (int i = 0; i < 2304; ++i) { a += Ff[i]; Ff[i] = a; } a = 0.f; for (int i = 2303; i >= 0; --i) { a += Gb[i]; Gb[i] = a; } }
    if (tid < 96) qt[tid] = dg_conv(p, l, b * SEQ, SEQ, tsel, h * 96 + tid) * 0.10206207261596577f;
    __syncthreads();
    const int tf = 256 + tsel, tb = tsel;
    for (int pos = tid; pos < 2304; pos += 512) { const bool isc = pos < 256; const int rbase = isc ? TL + b * CL : b * SEQ, slen = isc ? CL : SEQ, t = isc ? pos : pos - 256;
        float dot = 0.f; for (int d = 0; d < 96; ++d) dot += qt[d] * dg_conv(p, l, rbase, slen, t, 384 + h * 96 + d);
        const int pb = isc ? 2048 + pos : pos - 256;
        Wf[pos] = pos <= tf ? dot * __expf(Ff[tf] - Ff[pos] + If[pos]) : 0.f;
        Wb[pos] = pb >= tb ? dot * __expf(Gb[tb] - Gb[pb] + Ib[pb]) : 0.f; }
    __syncthreads();
    float hv = 0.f;
    if (tid < 96) { float nf = 0.f, nb = 0.f, df = 0.f, db = 0.f;
        for (int pos = 0; pos < 2304; ++pos) { const int row = pos < 256 ? TL + b * CL + pos : b * SEQ + (pos - 256); const float v = bf2f(proj[(size_t)row * PW + C_MV + h * 96 + tid]);
            nf += Wf[pos] * v; nb += Wb[pos] * v; df += Wf[pos]; db += Wb[pos]; }
        hv = nf / fmaxf(fabsf(df), 1.f) + nb / fmaxf(fabsf(db), 1.f); }
    const float ss = block_sum(tid < 96 ? hv * hv : 0.f, red);
    float diff = 0.f;
    if (tid < 96) { const int row = b * SEQ + tsel; const float mo = bf2f(proj[(size_t)row * PW + C_MO + h * 96 + tid]);
        const float y = hv * rsqrtf(ss * (1.f / 96.f) + EPS) * p.in[I_GM][l * 384 + h * 96 + tid] / (1.f + __expf(-mo));
        const float yf = bf2f(((const bf16_t*)(p.ws + WS_MIX))[(size_t)row * D + 256 + h * 96 + tid]);
        diff = fabsf(y - yf); }
    return block_max(diff, red);
}
__device__ __forceinline__ float diag_attn(const KP& p, int l, int b, int h, int qsel, unsigned char* shm) {
    const int tid = ltid();
    float* sc = (float*)shm; float* qv = sc + 2304; float* red = qv + 96; float* nq = red + 16;
    float* Vs = (float*)(p.ws + WS_HID + 100000000);
    const bf16_t* proj = (const bf16_t*)(p.ws + WS_PROJ);
    const float* wuq = p.in[I_WUQ] + (size_t)l * 256 * 384; const float* wukv = p.in[I_WUKV] + (size_t)l * 128 * 640;
    const int qrow = b * SEQ + qsel;
    { float v = tid < 256 ? bf2f(proj[(size_t)qrow * PW + C_CQ + tid]) : 0.f; const float ss = block_sum(v * v, red);
      if (tid < 256) nq[tid] = v * rsqrtf(ss * (1.f / 256.f) + EPS) * p.in[I_GQN][l * 256 + tid]; }
    __syncthreads();
    if (tid < 96) { float a = 0.f; for (int k = 0; k < 256; ++k) a += nq[k] * wuq[(size_t)k * 384 + h * 96 + tid]; qv[tid] = a; }
    __syncthreads();
    if (tid < 16) {
        const int seg = tid >> 3, f = tid & 7; float cs, sn; rope_cs(qsel, seg, f, cs, sn);
        const float x1 = qv[64 + seg * 16 + f], x2 = qv[64 + seg * 16 + 8 + f]; qv[64 + seg * 16 + f] = x1 * cs - x2 * sn; qv[64 + seg * 16 + 8 + f] = x1 * sn + x2 * cs; }
    __syncthreads();
    for (int key = tid; key < 2304; key += 512) { const bool lat = key < SEQ; const int row = lat ? b * SEQ + key : TL + b * CL + (key - SEQ);
        const bf16_t* pr = proj + (size_t)row * PW;
        float ss = 0.f; for (int k = 0; k < 128; ++k) { const float v = bf2f(pr[C_CKV + k]); ss += v * v; }
        const float rk = rsqrtf(ss * (1.f / 128.f) + EPS);
        float s = 0.f;
        for (int c = 0; c < 160; ++c) { float a = 0.f; for (int k = 0; k < 128; ++k) a += bf2f(pr[C_CKV + k]) * rk * p.in[I_GKVN][l * 128 + k] * wukv[(size_t)k * 640 + h * 160 + c];
            if (c < 64) s += qv[c] * a; else Vs[(size_t)key * 96 + (c - 64)] = a; }
        for (int seg = 0; seg < 2; ++seg) for (int f = 0; f < 8; ++f) { float x1 = bf2f(pr[C_KR + seg * 16 + f]), x2 = bf2f(pr[C_KR + seg * 16 + 8 + f]);
            if (lat) { float cs, sn; rope_cs(key, seg, f, cs, sn); const float o1 = x1 * cs - x2 * sn, o2 = x1 * sn + x2 * cs; x1 = o1; x2 = o2; }
            s += qv[64 + seg * 16 + f] * x1 + qv[64 + seg * 16 + 8 + f] * x2; }
        sc[key] = s * 0.10206207261596577f; }
    __syncthreads();
    float mx = -1e30f; for (int key = tid; key < 2304; key += 512) mx = fmaxf(mx, sc[key]); mx = block_max(mx, red);
    float sm = 0.f; for (int key = tid; key < 2304; key += 512) { const float e = __expf(sc[key] - mx); sc[key] = e; sm += e; } sm = block_sum(sm, red);
    __threadfence(); __syncthreads();
    float diff = 0.f;
    if (tid < 96) { float a = 0.f; for (int key = 0; key < 2304; ++key) a += sc[key] * Vs[(size_t)key * 96 + tid]; a /= sm;
        const float yf = bf2f(((const bf16_t*)(p.ws + WS_MIX))[(size_t)qrow * D + 640 + h * 96 + tid]); diff = fabsf(a - yf); }
    return block_max(diff, red);
}

__device__ __forceinline__ float diag_fourier(const KP& p, int b, int g, unsigned char* shm) {
    const int tid = ltid();
    float* hrow = (float*)shm; float* red = hrow + 1024;
    float* pf = (float*)(p.ws + WS_HID + 100000000);
    const float* mod = (const float*)(p.ws + WS_MOD) + (size_t)b * 6144;
    for (int n = 0; n < 2048; ++n) {
        const float* xr = p.in[I_X] + ((size_t)b * SEQ + n) * D;
        const float x0 = xr[tid], x1 = xr[tid + 512];
        const float ss = block_sum(x0 * x0 + x1 * x1, red); const float rstd = rsqrtf(ss * (1.f / D) + EPS);
        hrow[tid] = x0 * rstd * p.in[I_G1][tid] * (1.f + mod[1024 + tid]) + mod[tid];
        hrow[tid + 512] = x1 * rstd * p.in[I_G1][tid + 512] * (1.f + mod[1024 + tid + 512]) + mod[tid + 512];
        __syncthreads();
        { const int c = tid & 63, ks = tid >> 6; float a = 0.f;
          for (int k = ks * 128; k < ks * 128 + 128; ++k) a += hrow[k] * p.in[I_WIN][(size_t)k * 2224 + g * 64 + c];
          red[16 + ks * 64 + c] = a; }
        __syncthreads();
        if (tid < 64) { float a = 0.f; for (int q = 0; q < 8; ++q) a += red[16 + q * 64 + tid]; pf[n * 64 + tid] = a; }
        __syncthreads();
    }
    __threadfence(); __syncthreads();
    float worst = 0.f;
#pragma unroll 1
    for (int i = 0; i < 6; ++i) { const int k = i == 0 ? 0 : i == 1 ? 1 : i == 2 ? 5 : i == 3 ? 1000 : i == 4 ? 1024 : 2047;
        const int cp = tid & 63, ns = tid >> 6; float a = 0.f;
        for (int n = ns * 256; n < ns * 256 + 256; ++n) for (int c = 0; c < 64; ++c) { const int idx = (k * n + 32 * c * cp) & 2047; a += pf[n * 64 + c] * cospif((float)idx * (1.f / 1024.f)); }
        __syncthreads(); red[16 + ns * 64 + cp] = a; __syncthreads();
        float diff = 0.f;
        if (tid < 64) { float y = 0.f; for (int q = 0; q < 8; ++q) y += red[16 + q * 64 + tid]; y *= 0.00276213586400995f;
            const float yf = bf2f(((const bf16_t*)(p.ws + WS_MIX))[((size_t)b * SEQ + k) * D + g * 64 + tid]); diff = fabsf(y - yf); }
        worst = fmaxf(worst, block_max(diff, red));
    }
    return worst;
}

__device__ __forceinline__ int dg_row(int i) { return i == 0 ? 0 : i == 1 ? 1 : i == 2 ? 255 : i == 3 ? 256 : i == 4 ? 5000 : i == 5 ? 16383 : i == 6 ? 16384 : 18431; }
__device__ __forceinline__ float diag_g2(const KP& p, int i, unsigned char* shm) {
    const int tid = ltid(); float* red = (float*)shm;
    const int r = dg_row(i), b = r < TL ? r >> 11 : 8;
    const bf16_t* mr = (const bf16_t*)(p.ws + WS_MIX) + (size_t)r * D;
    const float* xo = r < TL ? p.in[I_X] + (size_t)r * D : p.in[I_CTX] + (size_t)(r - TL) * D;
    const float* xn = r < TL ? p.out + (size_t)r * D : (const float*)(p.ws + WS_XCTX) + (size_t)(r - TL) * D;
    const float* mod = (const float*)(p.ws + WS_MOD);
    float diff = 0.f;
    for (int c = tid; c < 1024; c += 512) { float a = 0.f; for (int j = 0; j < 1024; ++j) a += bf2f(mr[j]) * p.in[I_WOUT][(size_t)j * 1024 + c];
        diff = fmaxf(diff, fabsf(xo[c] + mod[(size_t)b * 6144 + 2048 + c] * a - xn[c])); }
#ifdef DIAG_MODONLY
    diff = 0.f;
#endif
#ifndef DIAG_G2ONLY
    { const int l = i & 1, j = (37 * tid + 11 * i) % 6144; float a = 0.f;
      for (int k = 0; k < 1024; ++k) { const float cv = b < 8 ? p.in[I_C][b * 1024 + k] : p.in[I_CCTX][k]; a += siluf(cv) * p.in[I_WMOD][(size_t)l * 1024 * 6144 + (size_t)k * 6144 + j]; }
      a += p.in[I_BMOD][l * 6144 + j]; diff = fmaxf(diff, fabsf(a - mod[(size_t)(l * 9 + b) * 6144 + j])); }
#endif
    return block_max(diff, red);
}
__device__ __forceinline__ float diag_g3(const KP& p, int i, unsigned char* shm) {
    const int tid = ltid(); float* red = (float*)shm; float* hr = red + 16;
    const int r = dg_row(i), b = r < TL ? r >> 11 : 8;
    const float* xr = r < TL ? p.out + (size_t)r * D : (const float*)(p.ws + WS_XCTX) + (size_t)(r - TL) * D;
    const float* mod = (const float*)(p.ws + WS_MOD) + (size_t)b * 6144;
    const bf16_t* hb = (const bf16_t*)(p.ws + WS_HBUF) + (size_t)r * D;
    const float x0 = xr[tid], x1 = xr[tid + 512];
    const float ss = block_sum(x0 * x0 + x1 * x1, red); const float rstd = rsqrtf(ss * (1.f / D) + EPS);
    float diff = 0.f;
    { const float h0 = x0 * rstd * p.in[I_G2][tid] * (1.f + mod[4096 + tid]) + mod[3072 + tid], h1 = x1 * rstd * p.in[I_G2][tid + 512] * (1.f + mod[4096 + tid + 512]) + mod[3072 + tid + 512];
      diff = fmaxf(fabsf(h0 - bf2f(hb[tid])), fabsf(h1 - bf2f(hb[tid + 512]))); hr[tid] = bf2f(hb[tid]); hr[tid + 512] = bf2f(hb[tid + 512]); }
    __syncthreads();
    const bf16_t* hid = (const bf16_t*)(p.ws + WS_HID) + (size_t)r * 4096;
    for (int j = tid; j < 4096; j += 512) { float a = 0.f; for (int k = 0; k < 1024; ++k) a += hr[k] * p.in[I_WUP][(size_t)k * 4096 + j];
        a = fmaxf(a, 0.f); a = a * a; diff = fmaxf(diff, fabsf(a - bf2f(hid[j])) / (1.f + fabsf(a))); }
    return block_max(diff, red);
}
#endif


#define XB_TMO      128
#define XB_XCNT(j)  (256  + 64 * (j))
#define XB_XSUB(j)  (1280 + 64 * (j))
#define XB_XGEN(j)  (2304 + 64 * (j))
#define XB_TOP      3328
#define XB_TOPGEN   3392
#define XCD_BAR_WORDS 3456
#define XB_SPIN_CAP (1u << 18)
#define LAS __attribute__((address_space(3)))
__device__ __forceinline__ unsigned xb_ld(unsigned* p)              { return __hip_atomic_load(p, __ATOMIC_RELAXED, __HIP_MEMORY_SCOPE_AGENT); }
__device__ __forceinline__ unsigned xb_add(unsigned* p, unsigned v) { return __hip_atomic_fetch_add(p, v, __ATOMIC_RELAXED, __HIP_MEMORY_SCOPE_AGENT); }
__device__ __forceinline__ unsigned xb_xcc_id() { return (unsigned)__builtin_amdgcn_s_getreg((3 << 11) | 20) & 0xFu; }
#define XB_SPIN(cond, bar) do { unsigned _sp = 0; while (cond) { __builtin_amdgcn_s_sleep(1); \
    if ((++_sp & 255u) == 0u) { if (xb_ld(&(bar)[XB_TMO])) break; if (_sp > XB_SPIN_CAP) { atomicAdd(&(bar)[XB_TMO], 1u); break; } } } } while (0)
struct XcdBarrier { unsigned* bar; unsigned x; volatile LAS unsigned* st; };
__device__ __forceinline__ XcdBarrier xcd_barrier_post(unsigned* bar, volatile LAS unsigned* st) {
    XcdBarrier b; b.bar = bar; b.x = xb_xcc_id(); b.st = st;
    if (threadIdx.x == 0) (void)xb_add(&bar[XB_XCNT(b.x)], 1u);
    return b;
}
__device__ __forceinline__ void xcd_barrier_complete(unsigned* bar, unsigned x, unsigned& nloc, unsigned& nx) {
    const unsigned G = gridDim.x * gridDim.y * gridDim.z;
    unsigned sum, cnt, mine, sp = 0u;
    for (;;) {
        sum = 0u; cnt = 0u; mine = 0u;
#pragma unroll
        for (unsigned j = 0; j < 16; ++j) { const unsigned c = xb_ld(&bar[XB_XCNT(j)]); sum += c; cnt += (c > 0u) ? 1u : 0u; mine = (j == x) ? c : mine; }
        if (sum == G) break;
        __builtin_amdgcn_s_sleep(1);
        if ((++sp & 255u) == 0u) { if (xb_ld(&bar[XB_TMO])) break; if (sp > XB_SPIN_CAP) { atomicAdd(&bar[XB_TMO], 1u); break; } }
    }
    nloc = mine > 0u ? mine : 1u; nx = cnt > 0u ? cnt : 1u;
}
__device__ __forceinline__ void xcd_barrier(const XcdBarrier& b) {
    asm volatile("s_waitcnt vmcnt(0)" ::: "memory");
    __syncthreads();
    if (threadIdx.x == 0) {
        unsigned* bar = b.bar;
        __builtin_amdgcn_s_waitcnt(0);
        unsigned nloc = b.st[0], nx = b.st[1];
        if (nloc == 0u) { xcd_barrier_complete(bar, b.x, nloc, nx); b.st[0] = nloc; b.st[1] = nx; }
        const unsigned old = xb_add(&bar[XB_XSUB(b.x)], 1u);
        const unsigned gen = old / nloc;
        if (old + 1u == (gen + 1u) * nloc) {
            __builtin_amdgcn_fence(__ATOMIC_RELEASE, "agent");
            asm volatile("s_waitcnt vmcnt(0)" ::: "memory");
            const unsigned og = xb_add(&bar[XB_TOP], 1u);
            const unsigned tg = og / nx;
            if (og + 1u == (tg + 1u) * nx) xb_add(&bar[XB_TOPGEN], 1u);
            else XB_SPIN(xb_ld(&bar[XB_TOPGEN]) == tg, bar);
            __builtin_amdgcn_fence(__ATOMIC_ACQUIRE, "agent");
            xb_add(&bar[XB_XGEN(b.x)], 1u);
            asm volatile("s_waitcnt vmcnt(0)" ::: "memory");
        } else {
            XB_SPIN(xb_ld(&bar[XB_XGEN(b.x)]) == gen, bar);
            __builtin_amdgcn_fence(__ATOMIC_ACQUIRE, "agent");
            asm volatile("s_waitcnt vmcnt(0)" ::: "memory");
        }
    }
    __syncthreads();
}

__device__ __attribute__((noinline)) void grid_sync_fn() { cg::this_grid().sync(); }
__global__ __launch_bounds__(512, 2) void mega(KP p) {
    extern __shared__ __attribute__((aligned(16))) unsigned char shm[];
    volatile LAS unsigned* xst = (volatile LAS unsigned*)(LAS unsigned char*)(shm + LDS_BYTES - 16);
    if (threadIdx.x == 0) { xst[0] = 0u; xst[1] = 0u; }
    __syncthreads();
    if (p.ph_lo < 0) grid_sync_fn();
    const XcdBarrier xbar = xcd_barrier_post((unsigned*)(p.ws + WS_BAR), xst);
    for (int s = p.ph_lo; s < p.ph_hi; ++s) {
      if (s == 16) continue;
      const int nrep = (s >= 1 && s < 19 && ((REPMASK >> ((s - 1) % 9)) & 1)) ? 2 : 1;
      for (int rep = 0; rep < nrep; ++rep) {
        const int G = gridDim.x, bid = lbid();
        unsigned char* ws = p.ws; asm volatile("" : "+s"(ws));
        float* outp = p.out; asm volatile("" : "+s"(outp));
        if (s == 0) { if (PHMASK & 512) step_prep0(p, shm);
#ifdef REP_PREP
            xcd_barrier(xbar); step_prep0(p, shm);
#endif
        }
        else if (s == 19) { if (PHMASK & 1024) step_final(p); }
        else {
            const int l = (s - 1) / 9, ph = (s - 1) % 9; const bool last = l == 1;
            const float* modl = (const float*)(ws + WS_MOD) + (size_t)l * 9 * 6144;
            const float* xl = l == 0 ? p.in[I_X] : outp; const float* xc = l == 0 ? p.in[I_CTX] : (const float*)(ws + WS_XCTX);
            const int Mrows = last ? TL : TT;
            if (ph == 0) {
                if (PHMASK & 1) {
                if (l == 1) { float* tab = (float*)shm; prep_weights(p, 1, shm, tab, 2); }
                norm_rows(xl, xc, TT, p.in[I_G1] + l * D, modl, 0, 1024, (bf16_t*)(ws + WS_HBUF), l == 1 ? (const bf16_t*)(ws + WS_PART) : nullptr, (const float*)(ws + WS_MOD) + 8 * 6144 + 5120, nullptr, l == 1 ? TL : 0); }
            } else if (ph == 1) {
                if (PHMASK & 2) {
                EpiIn E; E.proj = (bf16_t*)(ws + WS_PROJ); E.gates = (float*)(ws + WS_GATES); E.zt = (bf16_t*)(ws + WS_ZT); E.ztc = (bf16_t*)(ws + WS_ZTC);
                run_gemm(shm, (const bf16_t*)(ws + WS_HBUF), (const bf16_t*)(ws + WS_WIN), TT, NIN, 1024, G, bid, E); }
            } else if (ph == 2) {
                if (PHMASK & 4) {
                    for (int it = bid; it < 32 * NCH + TT / 64; it += G) { if (it < 32 * NCH) mlstm_a_item(p, l, it, shm); else qkv_item(p, l, it - 32 * NCH, shm); }
                    {
                        const int nlong = (32 * NCH + TT / 64) % G, f0 = bid >= nlong ? bid - nlong : -1, fs = G - nlong;
                        if (f0 >= 0) for (int f = f0; f < 256; f += fs) zt_fold_item(p, f, shm);
                        __syncthreads(); }
                }
            } else if (ph == 3 || ph == 4) {
                if (PHMASK & 8) {
                const int nF = 64;
                if (ph == 3) mlstm_scan(p);
                {
                    int a0, a1, ast;
                    if (ph == 3) { a0 = bid; a1 = 256; ast = G; } else { a0 = (!last && bid >= nF + 8) ? 256 + (bid - nF - 8) : (1 << 30); a1 = 288; ast = G - nF - 8; }
                    for (int it = a0; it < a1; it += ast) {
                        const int item = it < 256 ? (((it & 7) * 4 + (it >> 6)) << 3) + ((it >> 3) & 7) : it;
                        attn_item<0>(p, item, shm); } }
                if (ph == 4) {
                if (bid < nF) {
                    for (int pass = 0; pass < (last ? 1 : 2); ++pass) {
                        const bool fl = pass == 0;
                        if (!fl && bid >= 8) break;
                        EpiFou E; E.mix = (bf16_t*)(ws + WS_MIX); E.rows_per_b = fl ? SEQ : CL; E.row_off = fl ? 0 : TL; E.scale = fl ? 0.00276213586400995f : 0.0078125f;
                        run_gemm(shm, (const bf16_t*)(ws + (fl ? WS_FDFT : WS_FDFTC)), (const bf16_t*)(ws + (fl ? WS_ZTF : WS_ZTC)), fl ? 2048 : 256, 2048, fl ? 2048 : 512, G, bid, E);
                    }
                } else {
                    const int vb = bid - nF, nb = G - nF, per = last ? 16 : NCH, nit = 32 * per;
                    for (int it = vb; it < nit; it += nb) { const int bh = it / per, jc = (last ? 2 : 0) + it % per; mlstm_c_item(p, l, bh >> 2, bh & 3, jc, shm); }
                } } }
            } else if (ph == 6) {
                if (PHMASK & 64) norm_rows(outp, l == 0 ? p.in[I_CTX] : (const float*)(ws + WS_XCTX), Mrows, p.in[I_G2] + l * D, modl, 3072, 4096, (bf16_t*)(ws + WS_HBUF),
                                           l == 0 ? (const bf16_t*)(ws + WS_PART) : nullptr, modl + 8 * 6144 + 2048, (float*)(ws + WS_XCTX), TL);
            } else if (ph == 7) {
                if (PHMASK & 128) {
                EpiUp E; E.hid = (bf16_t*)(ws + WS_HID);
                run_gemm(shm, (const bf16_t*)(ws + WS_HBUF), (const bf16_t*)(ws + WS_WUP), Mrows, 4096, 1024, G, bid, E); }
            } else {
                if (PHMASK & 32) {
                const bool g2 = ph == 5;
                {
                    const float* mod1 = (const float*)(ws + WS_MOD) + (size_t)9 * 6144;
                    EpiResNorm E; E.xo = g2 ? xl : outp; E.xn = outp; E.ga = modl + (g2 ? 2048 : 5120);
                    E.rss = (float*)(ws + WS_RSS) + (size_t)(2 * l + (g2 ? 0 : 1)) * TL; E.cnt = (unsigned*)(ws + WS_RCNT) + (2 * l + (g2 ? 0 : 1)) * 64 * 64;
                    E.mode = (!g2 && last) ? 1 : 0;
                    E.g = g2 ? p.in[I_G2] + l * D : (last ? p.in[I_GFIN] : p.in[I_G1] + D);
                    E.sc = g2 ? modl + 4096 : mod1 + 1024; E.sh = g2 ? modl + 3072 : mod1; E.hb = (bf16_t*)(ws + WS_HBUF);
                    pg8::Gemm gm; gm.A = (const bf16_t*)(ws + (g2 ? WS_MIX : WS_HID)); gm.Bt = (const bf16_t*)(ws + (g2 ? WS_WOUT : WS_WDOWN)); gm.M = TL; gm.N = 1024; gm.K = g2 ? 1024 : 4096; gm.ld = gm.K;
                    pg8::StaticOrder S; S.init(TL, 1024, G, bid);
                    pg8::gemm_phase<EpiResNorm, pg8::StaticOrder, false>((PG8_LAS unsigned char*)shm, gm, S, E, nullptr); }
                if (!last && !g2 && bid >= 128) { float* tab = (float*)shm; build_costab(tab); prep_weights(p, 1, shm, tab, 1, 128, G - 128); }
                if (!last) for (int su = bid; su < 128; su += G) {
                    const int ks = su >> 5, ui = su & 31, ld = g2 ? 1024 : 4096, Ks = ld >> 2;
                    EpiPart E; E.part = (bf16_t*)(ws + WS_PART) + (size_t)ks * TC * D;
                    run_gemm_ctx_split(shm, (const bf16_t*)(ws + (g2 ? WS_MIX : WS_HID)) + (size_t)TL * ld + ks * Ks, (const bf16_t*)(ws + (g2 ? WS_WOUT : WS_WDOWN)) + ks * Ks, Ks, ld, ui >> 2, ui & 3, E); }
                }
            }
        }
        if (s + 1 < p.ph_hi || rep + 1 < nrep) xcd_barrier(xbar);
      }
    }
#ifdef EXTRA_SYNCS
    for (int i = 0; i < EXTRA_SYNCS; ++i) xcd_barrier(xbar);
#endif
#ifdef DIAG
    grid_sync_fn();
    if (blockIdx.x == 0) {
        float worst = 0.f;
#pragma unroll 1
        for (int i = 0; i < 8; ++i) {
            const int tk = i == 0 ? 0 : i == 1 ? 1 : i == 2 ? 127 : i == 3 ? 128 : i == 4 ? 129 : i == 5 ? 1000 : i == 6 ? 2046 : 2047;
#if DIAG == 1
            const float d = diag_mlstm(p, 0, 3, 2, tk, shm);
#elif DIAG == 2
            const float d = diag_attn(p, 0, 3, 2, tk, shm);
#elif DIAG == 3
            const float d = i == 0 ? diag_fourier(p, 3, 2, shm) : 0.f;
#elif DIAG == 4
            const float d = fmaxf(diag_mlstm(p, 1, 5, 1, tk, shm), diag_attn(p, 1, 5, 1, tk, shm));
#elif DIAG == 5
            const float d = diag_g2(p, i, shm);
#else
            const float d = diag_g3(p, i, shm);
#endif
#ifdef DIAG_TOK
            if (i == DIAG_TOK) worst = d;
#else
            worst = fmaxf(worst, d);
#endif
        }
        if (threadIdx.x == 0) p.out[0] = 1e4f * worst;
    }
#endif
}

extern "C" void kernel_launch(void* const* d_in, const int* in_sizes, int n_in, void* d_out, int out_size, void* d_ws, size_t ws_size, hipStream_t stream) {
    static int grid_blocks = 0;
    if (grid_blocks == 0) {
        if (n_in != 20 || ws_size < WS_NEED) { fprintf(stderr, "kernel_launch: unexpected inputs (n_in %d, ws %zu, need %zu)\n", n_in, ws_size, (size_t)WS_NEED); grid_blocks = -1; return; }
        int dev = 0, cus = 0, per_cu = 0;
        hipGetDevice(&dev);
        hipDeviceGetAttribute(&cus, hipDeviceAttributeMultiprocessorCount, dev);
        hipFuncSetAttribute((const void*)mega, hipFuncAttributeMaxDynamicSharedMemorySize, LDS_BYTES);
        hipOccupancyMaxActiveBlocksPerMultiprocessor(&per_cu, (const void*)mega, 512, LDS_BYTES);
        if (per_cu < 1) per_cu = 1;
        grid_blocks = cus * per_cu;
        if (grid_blocks != 256) { fprintf(stderr, "kernel_launch: this build needs exactly 256 resident workgroups (got %d)\n", grid_blocks); grid_blocks = -1; (void)hipGetLastError(); return; }
        (void)hipGetLastError();
    }
    if (grid_blocks < 0) return;
    KP p{};
    for (int i = 0; i < 20; ++i) p.in[i] = (const float*)d_in[i];
    p.out = (float*)d_out; p.ws = (unsigned char*)d_ws; p.ph_lo = 0; p.ph_hi = 19;
#ifdef DIAG
    p.ph_hi = DIAG == 4 ? 15 : DIAG == 5 ? 7 : DIAG == 6 ? 9 : 6;
#endif
    (void)hipMemsetAsync((unsigned char*)d_ws + WS_BAR, 0, 16384, stream);
    void* args[] = {&p};
    hipError_t e = hipLaunchCooperativeKernel((const void*)mega, dim3(grid_blocks), dim3(512), args, LDS_BYTES, stream);
    if (e != hipSuccess) fprintf(stderr, "cooperative launch failed: %s (grid %d)\n", hipGetErrorString(e), grid_blocks);
}
```
